# Optimizing an MI355X kernel written in HIP

```python
import math
import jax, jax.numpy as jnp
from jax import lax
import numpy as np

D_MODEL = 1024
BATCH = 2
SEQ = 16384
DEPTH = 2

MIX_WIDTH = D_MODEL
S5_WIDTH = MIX_WIDTH // 2
S5_GROUP_DIM = 16
S5_GROUPS = S5_WIDTH // S5_GROUP_DIM
S5_STATE = 64
S5_DT_MIN = 1e-3
S5_DT_MAX = 1e-1
HG_WIDTH = MIX_WIDTH - S5_WIDTH
HG_HEADS = 4
HG_HEAD_DIM = HG_WIDTH // HG_HEADS
GLA_HEADS = 4
GLA_KEY_WIDTH = D_MODEL // 2
GLA_VALUE_WIDTH = D_MODEL
GLA_DK = GLA_KEY_WIDTH // GLA_HEADS
GLA_DV = GLA_VALUE_WIDTH // GLA_HEADS
GLA_GATE_RANK = 16
GLA_GATE_NORM = 16.0
CHUNK = 64
FFN_HIDDEN = -(-8 * D_MODEL // (3 * 256)) * 256
N_EVEN = (DEPTH + 1) // 2
N_ODD = DEPTH // 2
EVEN_IN = S5_WIDTH + 4 * HG_WIDTH
ODD_IN = 2 * GLA_KEY_WIDTH + 2 * GLA_VALUE_WIDTH
N_MOD = 6
EPS = 1e-6

kernel_name = "hybrid_s5_hgrn2_gla_adaln_block"


def rms_norm(x, g):
    xf = x.astype(jnp.float32)
    y = xf * lax.rsqrt(jnp.mean(xf * xf, axis=-1, keepdims=True) + EPS)
    return (y * g.astype(jnp.float32)).astype(x.dtype)


def modulate(h, shift, scale):
    return h * (1 + scale[:, None, :]) + shift[:, None, :]


def _linear_recurrence_combine(e_i, e_j):
    a_i, b_i = e_i
    a_j, b_j = e_j
    return a_j * a_i, a_j * b_i + b_j


def chunk_gated_linear(q, k, v, log_g):
    bsz, seq, heads, dk = q.shape
    dv = v.shape[-1]
    n_chunks = seq // CHUNK

    def to_chunks(t):
        t = t.astype(jnp.float32).reshape(bsz, n_chunks, CHUNK, heads, t.shape[-1])
        return t.transpose(1, 0, 3, 2, 4)

    causal = jnp.tril(jnp.ones((CHUNK, CHUNK), dtype=bool))

    def step(state, inp):
        qc, kc, vc, gc = inp
        cum = jnp.cumsum(gc, axis=2)
        o_inter = jnp.einsum('bhik,bhkv->bhiv', qc * jnp.exp(cum), state)
        diff = cum[:, :, :, None, :] - cum[:, :, None, :, :]
        decay = jnp.exp(jnp.where(causal[:, :, None], diff, -jnp.inf))
        scores = jnp.einsum('bhik,bhjk,bhijk->bhij', qc, kc, decay)
        o_intra = jnp.einsum('bhij,bhjv->bhiv', scores, vc)
        last = cum[:, :, -1:, :]
        new_state = (jnp.exp(last[:, :, 0, :])[..., None] * state
                     + jnp.einsum('bhjk,bhjv->bhkv', kc * jnp.exp(last - cum), vc))
        return new_state, o_inter + o_intra

    state0 = jnp.zeros((bsz, heads, dk, dv), jnp.float32)
    _, o = lax.scan(step, state0, (to_chunks(q), to_chunks(k), to_chunks(v), to_chunks(log_g)))
    return o.transpose(1, 0, 3, 2, 4).reshape(bsz, seq, heads, dv)


def s5_mixer(u, lam_re, lam_im, b_re, b_im, c_re, c_im, d_skip, log_step, w_glu, b_glu):
    f32 = jnp.float32
    bsz, seq, _ = u.shape
    uf = u.astype(f32).reshape(bsz, seq, S5_GROUPS, S5_GROUP_DIM)
    lam = lax.complex(lam_re.astype(f32), lam_im.astype(f32))
    delta = jnp.exp(log_step.astype(f32))[:, None]
    lam_bar = jnp.exp(lam * delta)
    b_mat = lax.complex(b_re.astype(f32), b_im.astype(f32))
    b_bar = ((lam_bar - 1.0) / lam)[:, :, None] * b_mat
    bu = jnp.einsum('gph,blgh->blgp', b_bar, uf)
    a = jnp.broadcast_to(lam_bar, (1, seq, S5_GROUPS, S5_STATE))
    _, states = lax.associative_scan(_linear_recurrence_combine, (a, bu), axis=1)
    c_mat = lax.complex(c_re.astype(f32), c_im.astype(f32))
    y = (jnp.einsum('ghp,blgp->blgh', c_mat, states).real
         + d_skip.astype(f32).reshape(S5_GROUPS, S5_GROUP_DIM) * uf)
    y = jax.nn.gelu(y.reshape(bsz, seq, S5_WIDTH))
    return y * jax.nn.sigmoid(y @ w_glu.astype(f32) + b_glu.astype(f32))


def hgrn2_mixer(q_raw, f_raw, i_raw, g_raw, lower_bound, norm_g):
    f32 = jnp.float32
    bsz, seq, _ = q_raw.shape
    shp = (bsz, seq, HG_HEADS, HG_HEAD_DIM)
    f_pre = f_raw.astype(f32)
    lb = lower_bound.astype(f32)
    forget = lb + (1 - lb) * jax.nn.sigmoid(f_pre)
    key = (1 - lb) * jax.nn.sigmoid(-f_pre)
    query = jax.nn.silu(q_raw.astype(f32))
    o = chunk_gated_linear(query.reshape(shp), key.reshape(shp), i_raw.reshape(shp),
                           jnp.log(forget).reshape(shp))
    o = rms_norm(o, norm_g) * jax.nn.silu(g_raw.astype(f32).reshape(shp))
    return o.reshape(bsz, seq, HG_WIDTH)


def gla_mixer(h, w_in, w_a1, w_a2, b_a, norm_g):
    f32 = jnp.float32
    bsz, seq, _ = h.shape
    kshp = (bsz, seq, GLA_HEADS, GLA_DK)
    vshp = (bsz, seq, GLA_HEADS, GLA_DV)
    z = h @ w_in
    q, k, v, r = jnp.split(z, [GLA_KEY_WIDTH, 2 * GLA_KEY_WIDTH, 2 * GLA_KEY_WIDTH + GLA_VALUE_WIDTH], axis=-1)
    log_a = jax.nn.log_sigmoid(((h @ w_a1) @ w_a2 + b_a).astype(f32)) / GLA_GATE_NORM
    o = chunk_gated_linear(q.astype(f32).reshape(kshp) * (GLA_DK ** -0.5), k.reshape(kshp),
                           v.reshape(vshp), log_a.reshape(kshp))
    o = rms_norm(o, norm_g) * jax.nn.silu(r.astype(f32).reshape(vshp))
    return o.reshape(bsz, seq, GLA_VALUE_WIDTH)


def swiglu(h, w1, w3, w2):
    return (jax.nn.silu(h @ w1) * (h @ w3)) @ w2


def setup_inputs(seed: int = 0) -> dict:
    key = jax.random.key(seed)
    keys = list(jax.random.split(key, 32))

    def nrm(shape, scale):
        return scale * jax.random.normal(keys.pop(), shape, jnp.float32)

    D = D_MODEL
    inp = {}
    inp['x'] = nrm((BATCH, SEQ, D), 1.0)
    inp['c'] = nrm((BATCH, D), 1.0)
    inp['ada_w'] = nrm((DEPTH, D, N_MOD * D), 0.5 * D ** -0.5)
    inp['ada_b'] = nrm((DEPTH, N_MOD * D), 0.02)
    inp['norm_mix_g'] = 1.0 + nrm((DEPTH, D), 0.02)
    inp['norm_ffn_g'] = 1.0 + nrm((DEPTH, D), 0.02)
    inp['ev_w_in'] = nrm((N_EVEN, D, EVEN_IN), D ** -0.5)
    inp['ev_w_out'] = nrm((N_EVEN, MIX_WIDTH, D), MIX_WIDTH ** -0.5)
    inp['s5_lam_re'] = -0.5 * (1.0 + nrm((N_EVEN, S5_GROUPS, S5_STATE), 0.01))
    n_idx = jnp.arange(S5_STATE, dtype=jnp.float32)
    inp['s5_lam_im'] = math.pi * n_idx * (1.0 + nrm((N_EVEN, S5_GROUPS, S5_STATE), 0.01))
    inp['s5_b_re'] = nrm((N_EVEN, S5_GROUPS, S5_STATE, S5_GROUP_DIM), (2 * S5_GROUP_DIM) ** -0.5)
    inp['s5_b_im'] = nrm((N_EVEN, S5_GROUPS, S5_STATE, S5_GROUP_DIM), (2 * S5_GROUP_DIM) ** -0.5)
    inp['s5_c_re'] = nrm((N_EVEN, S5_GROUPS, S5_GROUP_DIM, S5_STATE), S5_STATE ** -0.5)
    inp['s5_c_im'] = nrm((N_EVEN, S5_GROUPS, S5_GROUP_DIM, S5_STATE), S5_STATE ** -0.5)
    inp['s5_d'] = nrm((N_EVEN, S5_WIDTH), 1.0)
    inp['s5_log_step'] = jax.random.uniform(keys.pop(), (N_EVEN, S5_GROUPS), jnp.float32,
                                            minval=math.log(S5_DT_MIN), maxval=math.log(S5_DT_MAX))
    inp['s5_w_glu'] = nrm((N_EVEN, S5_WIDTH, S5_WIDTH), S5_WIDTH ** -0.5)
    inp['s5_b_glu'] = nrm((N_EVEN, S5_WIDTH), 0.02)
    inp['hg_lb_logits'] = nrm((DEPTH + 1, HG_WIDTH), 0.1)
    inp['hg_norm_g'] = 1.0 + nrm((N_EVEN, HG_HEAD_DIM), 0.02)
    inp['od_w_in'] = nrm((N_ODD, D, ODD_IN), D ** -0.5)
    inp['od_w_a1'] = nrm((N_ODD, D, GLA_GATE_RANK), D ** -0.5)
    inp['od_w_a2'] = nrm((N_ODD, GLA_GATE_RANK, GLA_KEY_WIDTH), GLA_GATE_RANK ** -0.5)
    inp['od_b_a'] = nrm((N_ODD, GLA_KEY_WIDTH), 0.02)
    inp['gla_norm_g'] = 1.0 + nrm((N_ODD, GLA_DV), 0.02)
    inp['od_w_out'] = nrm((N_ODD, GLA_VALUE_WIDTH, D), GLA_VALUE_WIDTH ** -0.5)
    inp['ffn_w1'] = nrm((DEPTH, D, FFN_HIDDEN), D ** -0.5)
    inp['ffn_w3'] = nrm((DEPTH, D, FFN_HIDDEN), D ** -0.5)
    inp['ffn_w2'] = nrm((DEPTH, FFN_HIDDEN, D), FFN_HIDDEN ** -0.5)
    inp['final_norm_g'] = 1.0 + nrm((D,), 0.02)
    return inp


def reference(x, c, ada_w, ada_b, norm_mix_g, norm_ffn_g, ev_w_in, ev_w_out,
              s5_lam_re, s5_lam_im, s5_b_re, s5_b_im, s5_c_re, s5_c_im, s5_d, s5_log_step,
              s5_w_glu, s5_b_glu, hg_lb_logits, hg_norm_g, od_w_in, od_w_a1, od_w_a2, od_b_a,
              gla_norm_g, od_w_out, ffn_w1, ffn_w3, ffn_w2, final_norm_g):
    lower_bounds = jnp.cumsum(jax.nn.softmax(hg_lb_logits.astype(jnp.float32), axis=0), axis=0)
    cond = jax.nn.silu(c)
    for layer in range(DEPTH):
        mod = cond @ ada_w[layer] + ada_b[layer]
        shift_m, scale_m, gate_m, shift_f, scale_f, gate_f = jnp.split(mod, N_MOD, axis=-1)
        h = modulate(rms_norm(x, norm_mix_g[layer]), shift_m, scale_m)
        if layer % 2 == 0:
            e = layer // 2
            z = h @ ev_w_in[e]
            u, hq, hf, hi, hg = jnp.split(
                z, [S5_WIDTH, S5_WIDTH + HG_WIDTH, S5_WIDTH + 2 * HG_WIDTH, S5_WIDTH + 3 * HG_WIDTH], axis=-1)
            y_a = s5_mixer(u, s5_lam_re[e], s5_lam_im[e], s5_b_re[e], s5_b_im[e], s5_c_re[e],
                           s5_c_im[e], s5_d[e], s5_log_step[e], s5_w_glu[e], s5_b_glu[e])
            y_b = hgrn2_mixer(hq, hf, hi, hg, lower_bounds[layer], hg_norm_g[e])
            mixed = jnp.concatenate([y_a, y_b], axis=-1).astype(x.dtype) @ ev_w_out[e]
        else:
            o = layer // 2
            y_c = gla_mixer(h, od_w_in[o], od_w_a1[o], od_w_a2[o], od_b_a[o], gla_norm_g[o])
            mixed = y_c.astype(x.dtype) @ od_w_out[o]
        x = x + gate_m[:, None, :] * mixed
        h = modulate(rms_norm(x, norm_ffn_g[layer]), shift_f, scale_f)
        x = x + gate_f[:, None, :] * swiglu(h, ffn_w1[layer], ffn_w3[layer], ffn_w2[layer])
    return rms_norm(x, final_norm_g)
```

```cpp
#include <hip/hip_runtime.h>
#include <cstdio>
#include <cstdint>
#include <cmath>
namespace pg8 {
#define PG8_LAS __attribute__((address_space(3)))
typedef unsigned short bf16_t;
typedef short bf16x8 __attribute__((ext_vector_type(8)));
typedef float f32x4 __attribute__((ext_vector_type(4)));
typedef unsigned u32x4 __attribute__((ext_vector_type(4)));
typedef unsigned u32x2 __attribute__((ext_vector_type(2)));
constexpr int BM = 256, BK = 64, HALF = 128, HTB = HALF * BK * 2  , STAGE_BYTES = 8 * HTB, NXCD = 8, WGM = 8;

__host__ __device__ __forceinline__ int lds_byte(int r, int c) { const int st = (r >> 4) * 2 + (c >> 5), rr = r & 15, cc = c & 31, ob = rr * 64 + cc * 2; return st * 1024 + (ob ^ (((ob >> 9) & 1) << 5)); }
__host__ __device__ __forceinline__ void stage_rc(int b, int& R, int& C) { const int st = b / 1024, sb = b % 1024, swz = sb ^ (((sb >> 9) & 1) << 5); R = (st >> 1) * 16 + swz / 64; C = (st & 1) * 32 + (swz % 64) / 2; }
__host__ __device__ __forceinline__ int perm32(int rho) { const int n = rho >> 4, i = rho & 15; return 8 * (i >> 2) + 4 * n + (i & 3); }

struct Unit { int pm, pn, g; size_t aoff, boff; };
struct Gemm { const bf16_t* A; const bf16_t* Bt; int lda, ldb, K; };

struct StaticOrder {
    int nM, nN, nwg, G, c, pm_per_batch; size_t bstride;
    __device__ void init(int M, int N, int G_, int c_, int pmpb, size_t bs) { nM = M / BM; nN = N / BM; nwg = nM * nN; G = G_; c = c_; pm_per_batch = pmpb; bstride = bs; }
    __device__ bool next(int i, Unit& u) const {
        const long L = (long)i * G + c; if (L >= nwg) return false;
        int wgid = (int)L; { const int q = nwg / NXCD, r = nwg % NXCD, xcd = wgid % NXCD, off = wgid / NXCD; wgid = (xcd < r ? xcd * (q + 1) : r * (q + 1) + (xcd - r) * q) + off; }
        const int nig = WGM * nN, gid = wgid / nig, fm = gid * WGM, gsz = (nM - fm) < WGM ? (nM - fm) : WGM;
        u.pm = fm + ((wgid % nig) % gsz); u.pn = (wgid % nig) / gsz; u.g = u.pm / pm_per_batch; u.aoff = 0; u.boff = (size_t)u.g * bstride; return true;
    }
};
struct GroupOrder {
    int nM, nN, ngroups, G, c; size_t astride, bstride;
    __device__ void init(int nM_, int nN_, int ng, int G_, int c_, size_t as, size_t bs) { nM = nM_; nN = nN_; ngroups = ng; G = G_; c = c_; astride = as; bstride = bs; }
    __device__ bool next(int i, Unit& u) const {
        const long L = (long)i * G + c; if (L >= (long)ngroups * nM * nN) return false;
        const int g = (int)(L / (nM * nN)), r = (int)(L % (nM * nN)); u.g = g; u.pm = r / nN; u.pn = r % nN; u.aoff = (size_t)g * astride; u.boff = (size_t)g * bstride; return true;
    }
};

__device__ __forceinline__ unsigned cvt_pk_bf16(float lo, float hi) { unsigned r; asm volatile("v_cvt_pk_bf16_f32 %0, %1, %2" : "=v"(r) : "v"(lo), "v"(hi)); return r; }
__device__ __forceinline__ float bf_lo(unsigned w) { return __uint_as_float(w << 16); }
__device__ __forceinline__ float bf_hi(unsigned w) { return __uint_as_float(w & 0xffff0000u); }
__device__ __forceinline__ float fsigmoid(float x) { return __builtin_amdgcn_rcpf(1.0f + __expf(-x)); }
__device__ __forceinline__ float fsilu(float x) { return x * fsigmoid(x); }
__device__ __forceinline__ float fgelu_tanh(float y) { return y * fsigmoid(1.5957691216f * (y + 0.044715f * y * y * y)); }
__device__ __forceinline__ float flogsigmoid(float x) { return fminf(x, 0.f) - __logf(1.0f + __expf(-fabsf(x))); }
__device__ __forceinline__ float row_rstd(const float* rowsq, int row) {
    const f32x4* p = (const f32x4*)(rowsq + (size_t)row * 16); const f32x4 a = p[0], b = p[1], c = p[2], d = p[3];
    const float s = ((a[0] + a[1]) + (a[2] + a[3])) + ((b[0] + b[1]) + (b[2] + b[3])) + ((c[0] + c[1]) + (c[2] + c[3])) + ((d[0] + d[1]) + (d[2] + d[3]));
    return 1.0f / sqrtf(s * (1.0f / 1024.0f) + 1e-6f);
}


struct EpiIn0 {
    static constexpr bool PERM = true, AFTER_DRAIN = false;
    const float* rowsq; const float* cvec; bf16_t* Ut; bf16_t* QFIG;
    __device__ __forceinline__ void operator()(const f32x4 (&acc)[2][2][4][2], const Unit& u, int wr, int wc, int fr, int fq) const {
        f32x4 cv[2][2];
#pragma unroll
        for (int bj = 0; bj < 2; ++bj)
#pragma unroll
            for (int n = 0; n < 2; ++n) cv[bj][n] = *(const f32x4*)(cvec + u.g * 2560 + u.pn * BM + bj * HALF + wc * 32 + 8 * fq + 4 * n);
#pragma unroll
        for (int ai = 0; ai < 2; ++ai)
#pragma unroll
        for (int m = 0; m < 4; ++m) { const int row = u.pm * BM + ai * HALF + wr * 64 + m * 16 + fr;
            const float rs = row_rstd(rowsq, row);
#pragma unroll
            for (int bj = 0; bj < 2; ++bj) { const int c0 = u.pn * BM + bj * HALF + wc * 32 + 8 * fq;
                const f32x4 v0 = acc[ai][bj][m][0] * rs + cv[bj][0], v1 = acc[ai][bj][m][1] * rs + cv[bj][1];
                u32x4 w; w.x = cvt_pk_bf16(v0[0], v0[1]); w.y = cvt_pk_bf16(v0[2], v0[3]); w.z = cvt_pk_bf16(v1[0], v1[1]); w.w = cvt_pk_bf16(v1[2], v1[3]);
                bf16_t* dst = (u.pn < 2) ? Ut + ((size_t)((c0 >> 4) * 1024 + (row >> 5)) * 640 + (row & 31) * 16 + (c0 & 15)) : QFIG + (size_t)row * 2048 + (c0 - 512);
                *(u32x4*)dst = w; }
        }
    }
};
struct EpiS5X {
    static constexpr bool PERM = false, AFTER_DRAIN = false;
    float* Xloc;
    __device__ __forceinline__ void operator()(const f32x4 (&acc)[2][2][4][2], const Unit& u, int wr, int wc, int fr, int fq) const {
#pragma unroll
        for (int ai = 0; ai < 2; ++ai)
#pragma unroll
        for (int m = 0; m < 4; ++m) { const int row = u.pm * BM + ai * HALF + wr * 64 + m * 16 + fr;
#pragma unroll
            for (int n = 0; n < 2; ++n) *(f32x4*)(Xloc + ((size_t)u.g * 1024 + row) * 128 + wc * 32 + 16 * n + 4 * fq) = acc[ai][0][m][n];
        }
    }
};
struct EpiS5Y {
    static constexpr bool PERM = true, AFTER_DRAIN = false;
    bf16_t* Y;
    __device__ __forceinline__ void operator()(const f32x4 (&acc)[2][2][4][2], const Unit& u, int wr, int wc, int fr, int fq) const {
#pragma unroll
        for (int ai = 0; ai < 2; ++ai)
#pragma unroll
        for (int m = 0; m < 4; ++m) { const int row = u.pm * BM + ai * HALF + wr * 64 + m * 16 + fr;
#pragma unroll
            for (int bj = 0; bj < 2; ++bj) { const int c0 = u.pn * BM + bj * HALF + wc * 32 + 8 * fq;
                const f32x4 a0 = acc[ai][bj][m][0], a1 = acc[ai][bj][m][1];
                u32x4 w; w.x = cvt_pk_bf16(fgelu_tanh(a0[0]), fgelu_tanh(a0[1])); w.y = cvt_pk_bf16(fgelu_tanh(a0[2]), fgelu_tanh(a0[3]));
                w.z = cvt_pk_bf16(fgelu_tanh(a1[0]), fgelu_tanh(a1[1])); w.w = cvt_pk_bf16(fgelu_tanh(a1[2]), fgelu_tanh(a1[3]));
                *(u32x4*)(Y + ((size_t)row * 32 + (c0 >> 4)) * 512 + u.g * 16 + (c0 & 15)) = w; }
        }
    }
};
struct EpiGlu {
    static constexpr bool PERM = true, AFTER_DRAIN = false;
    const bf16_t* Y; const float* bias; bf16_t* O; int ldo;
    __device__ __forceinline__ void operator()(const f32x4 (&acc)[2][2][4][2], const Unit& u, int wr, int wc, int fr, int fq) const {
        f32x4 bv[2][2];
#pragma unroll
        for (int bj = 0; bj < 2; ++bj)
#pragma unroll
            for (int n = 0; n < 2; ++n) bv[bj][n] = *(const f32x4*)(bias + u.pn * BM + bj * HALF + wc * 32 + 8 * fq + 4 * n);
#pragma unroll
        for (int ai = 0; ai < 2; ++ai)
#pragma unroll
        for (int m = 0; m < 4; ++m) { const int row = u.pm * BM + ai * HALF + wr * 64 + m * 16 + fr;
#pragma unroll
            for (int bj = 0; bj < 2; ++bj) { const int c0 = u.pn * BM + bj * HALF + wc * 32 + 8 * fq;
                const u32x4 yw = *(const u32x4*)(Y + (size_t)row * 512 + c0);
                const f32x4 a0 = acc[ai][bj][m][0] + bv[bj][0], a1 = acc[ai][bj][m][1] + bv[bj][1];
                u32x4 w; w.x = cvt_pk_bf16(bf_lo(yw.x) * fsigmoid(a0[0]), bf_hi(yw.x) * fsigmoid(a0[1])); w.y = cvt_pk_bf16(bf_lo(yw.y) * fsigmoid(a0[2]), bf_hi(yw.y) * fsigmoid(a0[3]));
                w.z = cvt_pk_bf16(bf_lo(yw.z) * fsigmoid(a1[0]), bf_hi(yw.z) * fsigmoid(a1[1])); w.w = cvt_pk_bf16(bf_lo(yw.w) * fsigmoid(a1[2]), bf_hi(yw.w) * fsigmoid(a1[3]));
                *(u32x4*)(O + (size_t)row * ldo + c0) = w; }
        }
    }
};
struct EpiResid {
    static constexpr bool PERM = true, AFTER_DRAIN = false;
    const float* xold; float* xnew; bf16_t* xb; float* rowsq; const float* gate; int gstride;
    __device__ __forceinline__ void operator()(const f32x4 (&acc)[2][2][4][2], const Unit& u, int wr, int wc, int fr, int fq) const {
        f32x4 gv[2][2];
#pragma unroll
        for (int bj = 0; bj < 2; ++bj)
#pragma unroll
            for (int n = 0; n < 2; ++n) gv[bj][n] = *(const f32x4*)(gate + u.g * gstride + u.pn * BM + bj * HALF + wc * 32 + 8 * fq + 4 * n);
#pragma unroll
        for (int ai = 0; ai < 2; ++ai)
#pragma unroll
        for (int m = 0; m < 4; ++m) { const int row = u.pm * BM + ai * HALF + wr * 64 + m * 16 + fr;
            float sq = 0.f;
#pragma unroll
            for (int bj = 0; bj < 2; ++bj) { const size_t off = (size_t)row * 1024 + u.pn * BM + bj * HALF + wc * 32 + 8 * fq;
                const f32x4 x0 = *(const f32x4*)(xold + off), x1 = *(const f32x4*)(xold + off + 4);
                const f32x4 v0 = x0 + gv[bj][0] * acc[ai][bj][m][0], v1 = x1 + gv[bj][1] * acc[ai][bj][m][1];
                *(f32x4*)(xnew + off) = v0; *(f32x4*)(xnew + off + 4) = v1;
                sq += (v0[0] * v0[0] + v0[1] * v0[1]) + (v0[2] * v0[2] + v0[3] * v0[3]) + (v1[0] * v1[0] + v1[1] * v1[1]) + (v1[2] * v1[2] + v1[3] * v1[3]);
                u32x4 w; w.x = cvt_pk_bf16(v0[0], v0[1]); w.y = cvt_pk_bf16(v0[2], v0[3]); w.z = cvt_pk_bf16(v1[0], v1[1]); w.w = cvt_pk_bf16(v1[2], v1[3]);
                *(u32x4*)(xb + off) = w; }
            sq += __shfl_xor(sq, 16); sq += __shfl_xor(sq, 32);
            if (fq == 0) rowsq[(size_t)row * 16 + u.pn * 4 + wc] = sq;
        }
    }
};
struct EpiFfnUp {
    static constexpr bool PERM = true, AFTER_DRAIN = false;
    const float* rowsq; const float* cvec; bf16_t* H;
    __device__ __forceinline__ void operator()(const f32x4 (&acc)[2][2][4][2], const Unit& u, int wr, int wc, int fr, int fq) const {
        f32x4 cv[2][2];
#pragma unroll
        for (int bj = 0; bj < 2; ++bj)
#pragma unroll
            for (int n = 0; n < 2; ++n) cv[bj][n] = *(const f32x4*)(cvec + u.g * 5632 + u.pn * BM + bj * HALF + wc * 32 + 8 * fq + 4 * n);
#pragma unroll
        for (int ai = 0; ai < 2; ++ai)
#pragma unroll
        for (int m = 0; m < 4; ++m) { const int row = u.pm * BM + ai * HALF + wr * 64 + m * 16 + fr;
            const float rs = row_rstd(rowsq, row);
            const f32x4 a0 = acc[ai][0][m][0] * rs + cv[0][0], a1 = acc[ai][0][m][1] * rs + cv[0][1], b0 = acc[ai][1][m][0] * rs + cv[1][0], b1 = acc[ai][1][m][1] * rs + cv[1][1];
            u32x4 w; w.x = cvt_pk_bf16(fsilu(a0[0]) * b0[0], fsilu(a0[1]) * b0[1]); w.y = cvt_pk_bf16(fsilu(a0[2]) * b0[2], fsilu(a0[3]) * b0[3]);
            w.z = cvt_pk_bf16(fsilu(a1[0]) * b1[0], fsilu(a1[1]) * b1[1]); w.w = cvt_pk_bf16(fsilu(a1[2]) * b1[2], fsilu(a1[3]) * b1[3]);
            *(u32x4*)(H + (size_t)row * 2816 + u.pn * HALF + wc * 32 + 8 * fq) = w;
        }
    }
};
struct EpiIn1 {
    static constexpr bool PERM = true, AFTER_DRAIN = false;
    const float* rowsq; const float* cvec; const float* ba; bf16_t* Z;
    __device__ __forceinline__ void operator()(const f32x4 (&acc)[2][2][4][2], const Unit& u, int wr, int wc, int fr, int fq) const {
        f32x4 cv[2][2];
#pragma unroll
        for (int bj = 0; bj < 2; ++bj)
#pragma unroll
            for (int n = 0; n < 2; ++n) { const int c = u.pn * BM + bj * HALF + wc * 32 + 8 * fq + 4 * n; cv[bj][n] = *(const f32x4*)(cvec + u.g * 3584 + c); if (u.pn >= 12) cv[bj][n] += *(const f32x4*)(ba + c - 3072); }
#pragma unroll
        for (int ai = 0; ai < 2; ++ai)
#pragma unroll
        for (int m = 0; m < 4; ++m) { const int row = u.pm * BM + ai * HALF + wr * 64 + m * 16 + fr;
            const float rs = row_rstd(rowsq, row);
#pragma unroll
            for (int bj = 0; bj < 2; ++bj) { const int c0 = u.pn * BM + bj * HALF + wc * 32 + 8 * fq;
                f32x4 v0 = acc[ai][bj][m][0] * rs + cv[bj][0], v1 = acc[ai][bj][m][1] * rs + cv[bj][1];
                if (u.pn < 2) { v0 = v0 * 0.08838834764831845f; v1 = v1 * 0.08838834764831845f; }
                if (u.pn >= 12) {
#pragma unroll
                    for (int e = 0; e < 4; ++e) { v0[e] = flogsigmoid(v0[e]); v1[e] = flogsigmoid(v1[e]); } }
                u32x4 w; w.x = cvt_pk_bf16(v0[0], v0[1]); w.y = cvt_pk_bf16(v0[2], v0[3]); w.z = cvt_pk_bf16(v1[0], v1[1]); w.w = cvt_pk_bf16(v1[2], v1[3]);
                *(u32x4*)(Z + (size_t)row * 3584 + c0) = w; }
        }
    }
};

template <class Epi, class Sched, bool ALIGN_EPI>
__device__ __forceinline__ void gemm_phase(PG8_LAS unsigned char* lds, const Gemm g, const Sched& S, const Epi& E) {
    const int tid = threadIdx.x, wid = __builtin_amdgcn_readfirstlane(tid >> 6), lane = tid & 63, wr = wid >> 2, wc = wid & 3, fr = lane & 15, fq = lane >> 4;
    const int K = g.K, nt = K / BK;
    unsigned voffA[2], voffB[2];
#pragma unroll
    for (int i = 0; i < 2; ++i) { int R, C; stage_rc(tid * 16 + i * 8192, R, C); const int Rb = Epi::PERM ? ((R & ~31) + perm32(R & 31)) : R;
        voffA[i] = (unsigned)(R * g.lda + C) * 2u; voffB[i] = (unsigned)(Rb * g.ldb + C) * 2u; }
    const size_t kstep = (size_t)(BK * 2);
    const size_t hstepA = (size_t)HALF * g.lda * 2, hstepB = (size_t)HALF * g.ldb * 2;
    const unsigned ldsw = (unsigned)wid * 1024u;
    const int aoff = lds_byte(wr * 64 + fr, fq * 8), boff = lds_byte(wc * 32 + fr, fq * 8);
#define PG8_SA(b, h) (((b) * 2 + (h)) * HTB)
#define PG8_SB(b, h) ((4 + (b) * 2 + (h)) * HTB)
#define PG8_STAGE(bufoff, gbase, voff) do { _Pragma("unroll") for (int _i = 0; _i < 2; ++_i) \
        __builtin_amdgcn_global_load_lds((const unsigned*)((const char*)(gbase) + (voff)[_i]), (PG8_LAS unsigned*)(lds + (bufoff) + ldsw + _i * 8192), 16, 0, 0); } while (0)
#define PG8_LDA(dst, b, h) do { _Pragma("unroll") for (int m = 0; m < 4; ++m) _Pragma("unroll") for (int k = 0; k < 2; ++k) dst[m][k] = *(const PG8_LAS bf16x8*)(lds + PG8_SA(b, h) + aoff + m * 2048 + k * 1024); } while (0)
#define PG8_LDB(dst, b, h) do { _Pragma("unroll") for (int n = 0; n < 2; ++n) _Pragma("unroll") for (int k = 0; k < 2; ++k) dst[n][k] = *(const PG8_LAS bf16x8*)(lds + PG8_SB(b, h) + boff + n * 2048 + k * 1024); } while (0)
#define PG8_MMA(ai, bj, At, Bt) do { __builtin_amdgcn_s_setprio(1); _Pragma("unroll") for (int m = 0; m < 4; ++m) _Pragma("unroll") for (int n = 0; n < 2; ++n) _Pragma("unroll") for (int k = 0; k < 2; ++k) \
        acc[ai][bj][m][n] = __builtin_amdgcn_mfma_f32_16x16x32_bf16(Bt[n][k], At[m][k], acc[ai][bj][m][n], 0, 0, 0); __builtin_amdgcn_s_setprio(0); } while (0)
#define PG8_WAIT_V(n) asm volatile("s_waitcnt vmcnt(" #n ")" ::: "memory")
#define PG8_WAIT_L(n) asm volatile("s_waitcnt lgkmcnt(" #n ")" ::: "memory")
#define PG8_BAR __builtin_amdgcn_s_barrier()
#define PG8_SCHED __builtin_amdgcn_sched_barrier(0)
    Unit cur, nxt; int ui = 0;
    if (!S.next(0, cur)) return;
    f32x4 acc[2][2][4][2];
#pragma unroll
    for (int a = 0; a < 2; ++a)
#pragma unroll
        for (int b = 0; b < 2; ++b)
#pragma unroll
            for (int m = 0; m < 4; ++m)
#pragma unroll
                for (int n = 0; n < 2; ++n) acc[a][b][m][n] = (f32x4){0.f, 0.f, 0.f, 0.f};
    bf16x8 At[4][2], B0[2][2], B1[2][2];
    const char* cA = (const char*)g.A + cur.aoff + (size_t)cur.pm * 2 * hstepA; const char* cB = (const char*)g.Bt + cur.boff + (size_t)cur.pn * 2 * hstepB;
    PG8_STAGE(PG8_SB(0, 0), cB, voffB); PG8_STAGE(PG8_SB(0, 1), cB + hstepB, voffB); PG8_STAGE(PG8_SA(0, 0), cA, voffA); PG8_STAGE(PG8_SA(0, 1), cA + hstepA, voffA);
    if (wr == 1) PG8_BAR;
    PG8_WAIT_V(2); PG8_BAR;
    PG8_STAGE(PG8_SB(1, 0), cB + kstep, voffB); PG8_STAGE(PG8_SA(1, 0), cA + kstep, voffA); PG8_STAGE(PG8_SB(1, 1), cB + hstepB + kstep, voffB);
    PG8_WAIT_V(6); PG8_BAR;
    for (;;) {
        const bool has_next = S.next(ui + 1, nxt);
        const char* nA = has_next ? (const char*)g.A + nxt.aoff + (size_t)nxt.pm * 2 * hstepA : cA; const char* nB = has_next ? (const char*)g.Bt + nxt.boff + (size_t)nxt.pn * 2 * hstepB : cB;
        for (int t = 0; t < nt; t += 2) {
            const bool last = (t == nt - 2);
            const char* a1 = cA + (size_t)(t + 1) * kstep;
            const char* a2 = last ? nA : cA + (size_t)(t + 2) * kstep; const char* b2 = last ? nB : cB + (size_t)(t + 2) * kstep;
            const char* a3 = a2 + kstep; const char* b3 = b2 + kstep;
            PG8_LDB(B0, 0, 0); PG8_LDB(B1, 0, 1); PG8_SCHED; PG8_LDA(At, 0, 0); PG8_STAGE(PG8_SA(1, 1), a1 + hstepA, voffA);
            PG8_WAIT_V(8); PG8_WAIT_L(0); PG8_BAR; PG8_MMA(0, 0, At, B0); PG8_MMA(0, 1, At, B1); PG8_BAR; PG8_SCHED;
            PG8_LDA(At, 0, 1); PG8_STAGE(PG8_SB(0, 0), b2, voffB); PG8_STAGE(PG8_SB(0, 1), b2 + hstepB, voffB); PG8_STAGE(PG8_SA(0, 0), a2, voffA);
            PG8_WAIT_V(8); PG8_WAIT_L(0); PG8_BAR; PG8_MMA(1, 0, At, B0); PG8_MMA(1, 1, At, B1); PG8_BAR; PG8_SCHED;
            PG8_LDB(B0, 1, 0); PG8_LDB(B1, 1, 1); PG8_SCHED; PG8_LDA(At, 1, 0); PG8_STAGE(PG8_SA(0, 1), a2 + hstepA, voffA);
            PG8_WAIT_V(8); PG8_WAIT_L(0); PG8_BAR; PG8_MMA(0, 0, At, B0); PG8_MMA(0, 1, At, B1); PG8_BAR; PG8_SCHED;
            PG8_LDA(At, 1, 1); PG8_STAGE(PG8_SB(1, 0), b3, voffB); PG8_STAGE(PG8_SB(1, 1), b3 + hstepB, voffB); PG8_STAGE(PG8_SA(1, 0), a3, voffA);
            PG8_WAIT_V(8); PG8_WAIT_L(0); PG8_BAR; PG8_MMA(1, 0, At, B0); PG8_MMA(1, 1, At, B1); PG8_BAR; PG8_SCHED;
        }
        if constexpr (ALIGN_EPI) { if (wr == 0) PG8_BAR; }
        E(acc, cur, wr, wc, fr, fq);
        if (!has_next) break;
#pragma unroll
        for (int a = 0; a < 2; ++a)
#pragma unroll
            for (int b = 0; b < 2; ++b)
#pragma unroll
                for (int m = 0; m < 4; ++m)
#pragma unroll
                    for (int n = 0; n < 2; ++n) acc[a][b][m][n] = (f32x4){0.f, 0.f, 0.f, 0.f};
        cur = nxt; cA = nA; cB = nB; ++ui;
        if constexpr (ALIGN_EPI) { if (wr == 1) PG8_BAR; }
    }
    PG8_WAIT_V(0);
    if constexpr (!ALIGN_EPI) { if (wr == 0) PG8_BAR; }
    PG8_BAR;
#undef PG8_SA
#undef PG8_SB
#undef PG8_STAGE
#undef PG8_LDA
#undef PG8_LDB
#undef PG8_MMA
#undef PG8_WAIT_V
#undef PG8_WAIT_L
#undef PG8_BAR
#undef PG8_SCHED
}
}
constexpr int NWAVES = 8;
constexpr int BATCH = 2, SEQ = 16384, D = 1024, T = BATCH * SEQ;
constexpr int FF = 2816, S5W = 512, S5G = 32, S5P = 64, LC = 32, NCH = T / LC  , UTP = LC * 16 + 128  ;
constexpr int N_IN0 = 2560, N_IN1 = 3584, N_UP = 5632;
constexpr float EPS = 1e-6f;
constexpr size_t MiB = 1u << 20;
constexpr size_t WS_CTL = 0, CTL_ZERO_BYTES = 1 * MiB;
constexpr size_t WS_MOD = 1 * MiB;
constexpr size_t WS_CV = 1 * MiB + 128 * 1024;
constexpr int CV_IN0 = 0, CV_UP0 = 2 * N_IN0, CV_IN1 = CV_UP0 + 2 * N_UP, CV_UP1 = CV_IN1 + 2 * N_IN1;
constexpr size_t WS_S5LAM = 1 * MiB + 512 * 1024;
constexpr size_t WS_WIN0 = 2 * MiB, WS_WOUT0 = 12 * MiB, WS_WGLU = 14 * MiB, WS_S5F = 15 * MiB, WS_S5T = 23 * MiB, WS_W13_0 = 43 * MiB, WS_W2_0 = 65 * MiB,
                 WS_WIN1 = 71 * MiB, WS_WOUT1 = 85 * MiB, WS_W13_1 = 87 * MiB, WS_W2_1 = 109 * MiB;
constexpr size_t WS_ROWSQ = 115 * MiB, WS_XB = 117 * MiB, WS_POOL = 181 * MiB, WS_END = 512 * MiB;
constexpr size_t WS_UT = WS_POOL, WS_QFIG = 221 * MiB, WS_XLOC = 349 * MiB, WS_YGELU = 365 * MiB, WS_MIXED = 397 * MiB, WS_HGA = 461 * MiB, WS_HGS = 477 * MiB, WS_HGD = 493 * MiB;
constexpr size_t WS_OBUF0 = 461 * MiB;
constexpr size_t WS_HID = WS_POOL;
constexpr size_t WS_Z1 = WS_POOL, WS_GLA_A = 405 * MiB, WS_GLA_S = 437 * MiB, WS_GLA_D = 469 * MiB;
constexpr size_t WS_OBUF1 = 405 * MiB;
static_assert(WS_WIN0 + (size_t)2 * N_IN0 * D * 2 <= WS_WOUT0 && WS_S5F + (size_t)S5G * 256 * 512 * 2 <= WS_S5T && WS_S5T + (size_t)S5G * 512 * UTP * 2 <= WS_W13_0 && WS_W13_0 + (size_t)2 * N_UP * D * 2 <= WS_W2_0 &&
              WS_W2_0 + (size_t)D * FF * 2 <= WS_WIN1 && WS_WIN1 + (size_t)2 * N_IN1 * D * 2 <= WS_WOUT1 && WS_W13_1 + (size_t)2 * N_UP * D * 2 <= WS_W2_1 && WS_W2_1 + (size_t)D * FF * 2 <= WS_ROWSQ, "weights map");
static_assert(WS_UT + (size_t)S5G * NCH * UTP * 2 <= WS_QFIG && WS_QFIG + (size_t)T * 2048 * 2 <= WS_XLOC && WS_XLOC + (size_t)S5G * NCH * 128 * 4 <= WS_YGELU && WS_YGELU + (size_t)T * 512 * 2 <= WS_MIXED &&
              WS_MIXED + (size_t)T * D * 2 <= WS_HGA && WS_HID + (size_t)T * FF * 2 <= WS_END && WS_Z1 + (size_t)T * N_IN1 * 2 <= WS_GLA_A && WS_OBUF1 + (size_t)T * D * 2 <= WS_END && WS_OBUF0 + (size_t)T * 512 * 2 <= WS_END, "pool map");
constexpr int CW_BAR = 4096;

constexpr int RING_OFF = 0, RING_BYTES = 131072;
constexpr int LDSCTL_OFF = RING_BYTES, MISC_OFF = LDSCTL_OFF + 320;
constexpr int LDS_BYTES = 147456;
static_assert(MISC_OFF + 128 <= LDS_BYTES, "LDS map");

#define GAS __attribute__((address_space(1)))
#define LAS __attribute__((address_space(3)))
typedef unsigned short bf16;
typedef unsigned v4u __attribute__((ext_vector_type(4)));
typedef unsigned v2u __attribute__((ext_vector_type(2)));
typedef float f32x4 __attribute__((ext_vector_type(4)));
typedef GAS unsigned gu32;
#define RLX_AGENT __ATOMIC_RELAXED, __HIP_MEMORY_SCOPE_AGENT
#define LDS_WAIT() asm volatile("s_waitcnt lgkmcnt(0)" ::: "memory")
#define VM_WAIT() asm volatile("s_waitcnt vmcnt(0)" ::: "memory")
__device__ __forceinline__ unsigned f2bf(float f) { unsigned u = __builtin_bit_cast(unsigned, f); return (u + 0x7fffu + ((u >> 16) & 1u)) >> 16; }
__device__ __forceinline__ unsigned pk2(float lo, float hi) { return f2bf(lo) | (f2bf(hi) << 16); }
__device__ __forceinline__ float bf2f(bf16 v) { return __uint_as_float((unsigned)v << 16); }

#define XB_TMO      128
#define XB_XCNT(j)  (256  + 64 * (j))
#define XB_XSUB(j)  (1280 + 64 * (j))
#define XB_XGEN(j)  (2304 + 64 * (j))
#define XB_TOP      3328
#define XB_TOPGEN   3392
#define XCD_BAR_WORDS 3456
#define XB_SPIN_CAP (1u << 18)
__device__ __forceinline__ unsigned xb_ld(unsigned* p)              { return __hip_atomic_load(p, __ATOMIC_RELAXED, __HIP_MEMORY_SCOPE_AGENT); }
__device__ __forceinline__ unsigned xb_add(unsigned* p, unsigned v) { return __hip_atomic_fetch_add(p, v, __ATOMIC_RELAXED, __HIP_MEMORY_SCOPE_AGENT); }
__device__ __forceinline__ unsigned xb_xcc_id() { return (unsigned)__builtin_amdgcn_s_getreg((3 << 11) | 20) & 0xFu; }
#define XB_SPIN(cond, bar) do { unsigned _sp = 0; while (cond) { __builtin_amdgcn_s_sleep(1); \
    if ((++_sp & 255u) == 0u) { if (xb_ld(&(bar)[XB_TMO])) break; if (_sp > XB_SPIN_CAP) { atomicAdd(&(bar)[XB_TMO], 1u); break; } } } } while (0)
struct XcdBarrier { unsigned* bar; unsigned x; volatile LAS unsigned* st; };
__device__ __forceinline__ XcdBarrier xcd_barrier_post(unsigned* bar, volatile LAS unsigned* st) {
    XcdBarrier b; b.bar = bar; b.x = xb_xcc_id(); b.st = st;
    if (threadIdx.x == 0) (void)xb_add(&bar[XB_XCNT(b.x)], 1u);
    return b;
}
__device__ __forceinline__ void xcd_barrier_complete(unsigned* bar, unsigned x, unsigned& nloc, unsigned& nx) {
    const unsigned G = gridDim.x * gridDim.y * gridDim.z;
    unsigned sum, cnt, mine, sp = 0u;
    for (;;) {
        sum = 0u; cnt = 0u; mine = 0u;
#pragma unroll
        for (unsigned j = 0; j < 16; ++j) { const unsigned c = xb_ld(&bar[XB_XCNT(j)]); sum += c; cnt += (c > 0u) ? 1u : 0u; mine = (j == x) ? c : mine; }
        if (sum == G) break;
        __builtin_amdgcn_s_sleep(1);
        if ((++sp & 255u) == 0u) { if (xb_ld(&bar[XB_TMO])) break; if (sp > XB_SPIN_CAP) { atomicAdd(&bar[XB_TMO], 1u); break; } }
    }
    nloc = mine > 0u ? mine : 1u; nx = cnt > 0u ? cnt : 1u;
}
__device__ __forceinline__ void xcd_barrier(const XcdBarrier& b) {
    asm volatile("s_waitcnt vmcnt(0)" ::: "memory");
    __syncthreads();
    if (threadIdx.x == 0) {
        unsigned* bar = b.bar;
        __builtin_amdgcn_s_waitcnt(0);
        unsigned nloc = b.st[0], nx = b.st[1];
        if (nloc == 0u) { xcd_barrier_complete(bar, b.x, nloc, nx); b.st[0] = nloc; b.st[1] = nx; }
        const unsigned old = xb_add(&bar[XB_XSUB(b.x)], 1u);
        const unsigned gen = old / nloc;
        if (old + 1u == (gen + 1u) * nloc) {
            __builtin_amdgcn_fence(__ATOMIC_RELEASE, "agent");
            asm volatile("s_waitcnt vmcnt(0)" ::: "memory");
            const unsigned og = xb_add(&bar[XB_TOP], 1u);
            const unsigned tg = og / nx;
            if (og + 1u == (tg + 1u) * nx) xb_add(&bar[XB_TOPGEN], 1u);
            else XB_SPIN(xb_ld(&bar[XB_TOPGEN]) == tg, bar);
            __builtin_amdgcn_fence(__ATOMIC_ACQUIRE, "agent");
            xb_add(&bar[XB_XGEN(b.x)], 1u);
            asm volatile("s_waitcnt vmcnt(0)" ::: "memory");
        } else {
            XB_SPIN(xb_ld(&bar[XB_XGEN(b.x)]) == gen, bar);
            __builtin_amdgcn_fence(__ATOMIC_ACQUIRE, "agent");
            asm volatile("s_waitcnt vmcnt(0)" ::: "memory");
        }
    }
    __syncthreads();
}

struct Args { const float* in[30]; float* out; unsigned char* ws; int ph_lo, ph_hi; };
enum InIdx { I_X = 0, I_C, I_ADAW, I_ADAB, I_NMG, I_NFG, I_EVWIN, I_EVWOUT, I_LAMRE, I_LAMIM, I_BRE, I_BIM, I_CRE, I_CIM, I_S5D, I_LOGSTEP, I_WGLU, I_BGLU, I_LBLOG, I_HGNORM,
             I_ODWIN, I_ODWA1, I_ODWA2, I_ODBA, I_GLANORM, I_ODWOUT, I_W1, I_W3, I_W2, I_FNORM };
struct Frame {
    LAS unsigned char* lds;
    volatile LAS unsigned* MISC;
    gu32* ctl;
    int tid, lane, wave, vcu, G;
    const float* const* in; float* out; unsigned char* ws;
};
__device__ __forceinline__ float wave_sum(float v) {
#pragma unroll
    for (int o = 1; o < 64; o <<= 1) v += __shfl_xor(v, o);
    return v;
}
__device__ __forceinline__ float dsilu(float x) { return x / (1.0f + expf(-x)); }

__device__ __forceinline__ void tile_store(const LAS float* scr, bf16* dst  , int ldk, const float* sc  , int lane) {
    const int c = lane & 7;
    float s8[8];
#pragma unroll
    for (int j = 0; j < 8; ++j) s8[j] = sc ? sc[8 * c + j] : 1.0f;
#pragma unroll
    for (int j = 0; j < 4; ++j) { const int n = (lane >> 3) + 8 * j; const LAS float* s = scr + (8 * c) * 33 + n;
        v4u o; o.x = pk2(s[0 * 33] * s8[0], s[1 * 33] * s8[1]); o.y = pk2(s[2 * 33] * s8[2], s[3 * 33] * s8[3]); o.z = pk2(s[4 * 33] * s8[4], s[5 * 33] * s8[5]); o.w = pk2(s[6 * 33] * s8[6], s[7 * 33] * s8[7]);
        *(GAS v4u*)(dst + (size_t)n * ldk + 8 * c) = o; }
}
__device__ __forceinline__ void tile_load(const float* W  , int ldw, LAS float* scr, int lane) {
#pragma unroll 8
    for (int i = 0; i < 32; ++i) { const int kk = 2 * i + (lane >> 5); scr[kk * 33 + (lane & 31)] = W[(size_t)kk * ldw + (lane & 31)]; }
}
__device__ __forceinline__ void p_transpose_item(const float* W, int K, int N, bf16* WT, LAS float* scr, int item, int lane) {
    const int nblk = N / 32, kb = item / nblk, nb = item % nblk, k0 = 64 * kb, n0 = 32 * nb;
    tile_load(W + (size_t)k0 * N + n0, N, scr, lane);
    LDS_WAIT(); asm volatile("" ::: "memory");
    tile_store(scr, WT + (size_t)n0 * K + k0, K, nullptr, lane);
    LDS_WAIT(); asm volatile("" ::: "memory");
}

__device__ __forceinline__ void s5_constants(Frame& F, int g) {
    LAS float* PW = (LAS float*)(F.lds + RING_OFF);
    LAS float* BB = (LAS float*)(F.lds + RING_OFF + 17408);
    LAS float* CC = (LAS float*)(F.lds + RING_OFF + 25600);
    LAS float* KD = (LAS float*)(F.lds + RING_OFF + 33792);
    const float* lam_re = F.in[I_LAMRE] + g * 64; const float* lam_im = F.in[I_LAMIM] + g * 64;
    const float* b_re = F.in[I_BRE] + g * 1024; const float* b_im = F.in[I_BIM] + g * 1024;
    const float* c_re = F.in[I_CRE] + g * 1024; const float* c_im = F.in[I_CIM] + g * 1024;
    const double dl = exp((double)F.in[I_LOGSTEP][g]);
    for (int idx = F.tid; idx < 33 * 64; idx += NWAVES * 64) { const int d = idx >> 6, p = idx & 63;
        const double mag = exp((double)lam_re[p] * dl * d); double sn, cs; sincos((double)lam_im[p] * dl * d, &sn, &cs);
        PW[idx * 2] = (float)(mag * cs); PW[idx * 2 + 1] = (float)(mag * sn); }
    for (int idx = F.tid; idx < 1024; idx += NWAVES * 64) { const int p = idx >> 4;
        const double lr = lam_re[p], li = lam_im[p]; const double mag = exp(lr * dl); double sn, cs; sincos(li * dl, &sn, &cs);
        const double nr = mag * cs - 1.0, ni = mag * sn, den = lr * lr + li * li;
        const double qr = (nr * lr + ni * li) / den, qi = (ni * lr - nr * li) / den;
        const double br = b_re[idx], bi = b_im[idx];
        BB[idx * 2] = (float)(qr * br - qi * bi); BB[idx * 2 + 1] = (float)(qr * bi + qi * br);
        CC[idx * 2] = c_re[idx]; CC[idx * 2 + 1] = c_im[idx]; }
    __syncthreads();
    for (int idx = F.tid; idx < 32 * 256; idx += NWAVES * 64) { const int d = idx >> 8, ho = (idx >> 4) & 15, hi = idx & 15; float s = 0.f;
        for (int p = 0; p < 64; ++p) { const float cr = CC[(ho * 64 + p) * 2], ci = CC[(ho * 64 + p) * 2 + 1], pr = PW[(d * 64 + p) * 2], pi = PW[(d * 64 + p) * 2 + 1];
            const float xr = cr * pr - ci * pi, xi = cr * pi + ci * pr; s += xr * BB[(p * 16 + hi) * 2] - xi * BB[(p * 16 + hi) * 2 + 1]; }
        if (d == 0 && ho == hi) s += F.in[I_S5D][g * 16 + ho];
        KD[idx] = s; }
    __syncthreads();
    bf16* Tg = (bf16*)(F.ws + WS_S5T) + (size_t)g * 512 * UTP;
    for (int idx = F.tid; idx < 512 * 64; idx += NWAVES * 64) { const int n = idx >> 6, kc = idx & 63, l = n >> 4, ho = n & 15, j = kc >> 1, hi0 = (kc & 1) * 8;
        v4u o = (v4u){0u, 0u, 0u, 0u};
        if (j <= l) { const LAS float* k = KD + ((l - j) * 16 + ho) * 16 + hi0; o.x = pk2(k[0], k[1]); o.y = pk2(k[2], k[3]); o.z = pk2(k[4], k[5]); o.w = pk2(k[6], k[7]); }
        *(GAS v4u*)(Tg + (size_t)n * UTP + kc * 8) = o; }
    for (int idx = F.tid; idx < 512 * 16; idx += NWAVES * 64) { const int n = idx >> 4, pc = idx & 15, l = n >> 4, ho = n & 15, im = pc >> 3, p0 = (pc & 7) * 8; float v[8];
#pragma unroll
        for (int e = 0; e < 8; ++e) { const int p = p0 + e; const float cr = CC[(ho * 64 + p) * 2], ci = CC[(ho * 64 + p) * 2 + 1], pr = PW[((l + 1) * 64 + p) * 2], pi = PW[((l + 1) * 64 + p) * 2 + 1];
            v[e] = im ? -(cr * pi + ci * pr) : (cr * pr - ci * pi); }
        v4u o; o.x = pk2(v[0], v[1]); o.y = pk2(v[2], v[3]); o.z = pk2(v[4], v[5]); o.w = pk2(v[6], v[7]);
        *(GAS v4u*)(Tg + (size_t)n * UTP + 512 + pc * 8) = o; }
    bf16* Fg = (bf16*)(F.ws + WS_S5F) + (size_t)g * 256 * 512;
    for (int idx = F.tid; idx < 256 * 64; idx += NWAVES * 64) { const int r = idx >> 6, kc = idx & 63, j = kc >> 1, hi0 = (kc & 1) * 8;
        v4u o = (v4u){0u, 0u, 0u, 0u};
        if (r < 128) { const int p = r & 63, im = r >> 6; const float pr = PW[((LC - 1 - j) * 64 + p) * 2], pi = PW[((LC - 1 - j) * 64 + p) * 2 + 1]; float v[8];
#pragma unroll
            for (int e = 0; e < 8; ++e) { const float br = BB[(p * 16 + hi0 + e) * 2], bi = BB[(p * 16 + hi0 + e) * 2 + 1]; v[e] = im ? (pr * bi + pi * br) : (pr * br - pi * bi); }
            o.x = pk2(v[0], v[1]); o.y = pk2(v[2], v[3]); o.z = pk2(v[4], v[5]); o.w = pk2(v[6], v[7]); }
        *(GAS v4u*)(Fg + (size_t)r * 512 + kc * 8) = o; }
    if (F.tid < 64) { float* L = (float*)(F.ws + WS_S5LAM) + (g * 64 + F.tid) * 2; L[0] = PW[(LC * 64 + F.tid) * 2]; L[1] = PW[(LC * 64 + F.tid) * 2 + 1]; }
    __syncthreads();
}
template <class WF, class VF> __device__ __forceinline__ void gemv64(Frame& F, WF wf, VF vf, float& o0, float& o1) {
    LAS float* red = (LAS float*)(F.lds + RING_OFF);
    float a0 = 0.f, a1 = 0.f; const int kb = F.wave * 128;
#pragma unroll 8
    for (int k = 0; k < 128; ++k) { const float w = wf(kb + k); a0 += vf(0, kb + k) * w; a1 += vf(1, kb + k) * w; }
    red[(F.wave * 2 + 0) * 64 + F.lane] = a0; red[(F.wave * 2 + 1) * 64 + F.lane] = a1;
    __syncthreads();
    o0 = 0.f; o1 = 0.f;
    if (F.wave == 0) {
#pragma unroll
        for (int w = 0; w < 8; ++w) { o0 += red[(w * 2 + 0) * 64 + F.lane]; o1 += red[(w * 2 + 1) * 64 + F.lane]; } }
    __syncthreads();
}
__device__ __forceinline__ void p0_prologue_a(Frame& F) {
    if (F.vcu < 32) s5_constants(F, F.vcu);
    else if (F.vcu < 32 + 192) {
        const int task = F.vcu - 32, l = task / 96, n = (task % 96) * 64 + F.lane;
        const float* W = F.in[I_ADAW] + (size_t)l * 1024 * 6144 + n; const float* cc = F.in[I_C];
        float o0, o1;
        gemv64(F, [&](int k) { return W[(size_t)k * 6144]; }, [&](int b, int k) { return dsilu(cc[b * 1024 + k]); }, o0, o1);
        if (F.wave == 0) { const float bb = F.in[I_ADAB][l * 6144 + n]; float* mod = (float*)(F.ws + WS_MOD) + l * 2 * 6144; mod[n] = o0 + bb; mod[6144 + n] = o1 + bb; }
    }
    LAS float* scr = (LAS float*)(F.lds + RING_OFF + 4096 + F.wave * 12288);
    const int gw = F.vcu * NWAVES + F.wave, NGW = F.G * NWAVES;
    constexpr int I_O = (D / 64) * (D / 32), I_G = (512 / 64) * (512 / 32), I_2 = (FF / 64) * (D / 32);
    constexpr int NITEMS = 2 * I_O + I_G + 2 * I_2;
    for (int it = NGW - 1 - gw; it < NITEMS; it += NGW) {
        int r = it;
        if (r < I_O) { p_transpose_item(F.in[I_EVWOUT], D, D, (bf16*)(F.ws + WS_WOUT0), scr, r, F.lane); continue; } r -= I_O;
        if (r < I_O) { p_transpose_item(F.in[I_ODWOUT], D, D, (bf16*)(F.ws + WS_WOUT1), scr, r, F.lane); continue; } r -= I_O;
        if (r < I_G) { p_transpose_item(F.in[I_WGLU], 512, 512, (bf16*)(F.ws + WS_WGLU), scr, r, F.lane); continue; } r -= I_G;
        if (r < I_2) { p_transpose_item(F.in[I_W2], FF, D, (bf16*)(F.ws + WS_W2_0), scr, r, F.lane); continue; } r -= I_2;
        p_transpose_item(F.in[I_W2] + (size_t)FF * D, FF, D, (bf16*)(F.ws + WS_W2_1), scr, r, F.lane);
    }
    const float* x = F.in[I_X]; bf16* xb = (bf16*)(F.ws + WS_XB); float* rowsq = (float*)(F.ws + WS_ROWSQ);
    for (int m = NGW - 1 - gw; m < T; m += NGW) {
        const GAS f32x4* xr = (const GAS f32x4*)(x + (size_t)m * D) + F.lane; f32x4 v[4]; float s = 0.f;
#pragma unroll
        for (int j = 0; j < 4; ++j) { v[j] = xr[64 * j]; s += (v[j].x * v[j].x + v[j].y * v[j].y) + (v[j].z * v[j].z + v[j].w * v[j].w); }
        s = wave_sum(s);
        GAS unsigned long long* o8 = (GAS unsigned long long*)(xb + (size_t)m * D) + F.lane;
#pragma unroll
        for (int j = 0; j < 4; ++j) o8[64 * j] = (unsigned long long)pk2(v[j].x, v[j].y) | ((unsigned long long)pk2(v[j].z, v[j].w) << 32);
        if (F.lane < 16) rowsq[(size_t)m * 16 + F.lane] = F.lane == 0 ? s : 0.f;
    }
}

struct FusedSrc { const float* p; int ld; bool lowrank; int nlr; };
__device__ __forceinline__ FusedSrc fused_src(Frame& F, int mat, int R0) {
    FusedSrc s; s.lowrank = false; s.nlr = 0;
    if (mat == 0) { s.p = F.in[I_EVWIN] + R0; s.ld = N_IN0; }
    else if (mat == 2) { if (R0 < 3072) { s.p = F.in[I_ODWIN] + R0; s.ld = 3072; } else { s.p = nullptr; s.ld = 0; s.lowrank = true; s.nlr = R0 - 3072; } }
    else { const int l = mat >> 1, pn = R0 >> 8, half = (R0 >> 7) & 1, i0 = R0 & 127; s.p = (half ? F.in[I_W3] : F.in[I_W1]) + (size_t)l * D * FF + 128 * pn + i0; s.ld = FF; }
    return s;
}
__device__ __forceinline__ float lowrank_val(Frame& F, int k, int n) { const float* a1 = F.in[I_ODWA1] + k * 16; const float* a2 = F.in[I_ODWA2] + n; float s = 0.f;
#pragma unroll
    for (int r = 0; r < 16; ++r) s += a1[r] * a2[r * 512]; return s; }
__device__ __forceinline__ void p1_prologue_b(Frame& F) {
    const float* mod = (const float*)(F.ws + WS_MOD);
    for (int task = F.vcu; task < 272; task += F.G) {
        int mat, nb = task; if (nb < 40) mat = 0; else if ((nb -= 40) < 88) mat = 1; else if ((nb -= 88) < 56) mat = 2; else { nb -= 56; mat = 3; }
        const int l = mat >> 1, sh = (mat & 1) ? 3072 : 0, R = nb * 64 + F.lane; const FusedSrc s = fused_src(F, mat, nb * 64);
        float o0, o1;
        gemv64(F, [&](int k) { return s.lowrank ? lowrank_val(F, k, s.nlr + F.lane) : s.p[(size_t)k * s.ld + F.lane]; }, [&](int b, int k) { return mod[(l * 2 + b) * 6144 + sh + k]; }, o0, o1);
        if (F.wave == 0) { const int Ns[4] = {N_IN0, N_UP, N_IN1, N_UP}; const int offs[4] = {CV_IN0, CV_UP0, CV_IN1, CV_UP1};
            float* cv = (float*)(F.ws + WS_CV) + offs[mat]; cv[R] = o0; cv[Ns[mat] + R] = o1; }
    }
    LAS float* scr = (LAS float*)(F.lds + RING_OFF + 4096 + F.wave * 12288);
    LAS float* scl = scr + 64 * 33;
    const int gw = F.vcu * NWAVES + F.wave, NGW = F.G * NWAVES;
    constexpr int IT0 = 16 * (N_IN0 / 32), IT1 = 16 * (N_UP / 32), IT2 = 16 * (N_IN1 / 32);
    for (int it = NGW - 1 - gw; it < IT0 + 2 * IT1 + IT2; it += NGW) {
        int mat, r = it; if (r < IT0) mat = 0; else if ((r -= IT0) < IT1) mat = 1; else if ((r -= IT1) < IT2) mat = 2; else { r -= IT2; mat = 3; }
        const int Ns[4] = {N_IN0, N_UP, N_IN1, N_UP}; const size_t wso[4] = {WS_WIN0, WS_W13_0, WS_WIN1, WS_W13_1};
        const int N = Ns[mat], nblk = N / 32, kb = r / nblk, nb = r % nblk, k0 = 64 * kb, R0 = 32 * nb, l = mat >> 1;
        const FusedSrc s = fused_src(F, mat, R0);
        if (s.lowrank) {
#pragma unroll 4
            for (int i = 0; i < 32; ++i) { const int kk = 2 * i + (F.lane >> 5); scr[kk * 33 + (F.lane & 31)] = lowrank_val(F, k0 + kk, s.nlr + (F.lane & 31)); }
        } else tile_load(s.p + (size_t)k0 * s.ld, s.ld, scr, F.lane);
        { const int k = k0 + F.lane; const float gn = (mat & 1) ? F.in[I_NFG][l * 1024 + k] : F.in[I_NMG][l * 1024 + k]; const int so = (mat & 1) ? 4096 : 1024;
          scl[F.lane] = gn * (1.0f + mod[(l * 2 + 0) * 6144 + so + k]); scl[64 + F.lane] = gn * (1.0f + mod[(l * 2 + 1) * 6144 + so + k]); }
        LDS_WAIT(); asm volatile("" ::: "memory");
        bf16* dst = (bf16*)(F.ws + wso[mat]) + (size_t)R0 * D + k0;
        float sc0[64 / 8 * 0 + 8], sc1[8];
#pragma unroll
        for (int j = 0; j < 8; ++j) { sc0[j] = scl[8 * (F.lane & 7) + j]; sc1[j] = scl[64 + 8 * (F.lane & 7) + j]; }
        const int c = F.lane & 7;
#pragma unroll
        for (int j = 0; j < 4; ++j) { const int n = (F.lane >> 3) + 8 * j; const LAS float* sp = scr + (8 * c) * 33 + n;
            float v[8];
#pragma unroll
            for (int e = 0; e < 8; ++e) v[e] = sp[e * 33];
            v4u o; o.x = pk2(v[0] * sc0[0], v[1] * sc0[1]); o.y = pk2(v[2] * sc0[2], v[3] * sc0[3]); o.z = pk2(v[4] * sc0[4], v[5] * sc0[5]); o.w = pk2(v[6] * sc0[6], v[7] * sc0[7]);
            *(GAS v4u*)(dst + (size_t)n * D + 8 * c) = o;
            o.x = pk2(v[0] * sc1[0], v[1] * sc1[1]); o.y = pk2(v[2] * sc1[2], v[3] * sc1[3]); o.z = pk2(v[4] * sc1[4], v[5] * sc1[5]); o.w = pk2(v[6] * sc1[6], v[7] * sc1[7]);
            *(GAS v4u*)(dst + (size_t)N * D + (size_t)n * D + 8 * c) = o; }
        LDS_WAIT(); asm volatile("" ::: "memory");
    }
}

__device__ __forceinline__ void s5_carry(Frame& F) {
    for (int task = F.vcu; task < 64; task += F.G) {
        const int b = task >> 5, g = task & 31, p = F.tid & 63, seg = F.tid >> 6;
        const float* X = (const float*)(F.ws + WS_XLOC) + ((size_t)g * NCH + b * 512 + seg * 64) * 128 + p;
        const float* L = (const float*)(F.ws + WS_S5LAM) + (g * 64 + p) * 2; const float lr = L[0], li = L[1];
        float ar = 0.f, ai = 0.f;
#pragma unroll 8
        for (int c = 0; c < 64; ++c) { const float xr = X[(size_t)c * 128], xi = X[(size_t)c * 128 + 64]; const float nr = lr * ar - li * ai + xr, ni = lr * ai + li * ar + xi; ar = nr; ai = ni; }
        float sr = lr, si = li;
#pragma unroll
        for (int q = 0; q < 6; ++q) { const float nr = sr * sr - si * si, ni = 2.f * sr * si; sr = nr; si = ni; }
        LAS float* agg = (LAS float*)(F.lds + RING_OFF);
        agg[(seg * 64 + p) * 2] = ar; agg[(seg * 64 + p) * 2 + 1] = ai;
        __syncthreads();
        float cr = 0.f, ci = 0.f;
        for (int s = 0; s < seg; ++s) { const float xr = agg[(s * 64 + p) * 2], xi = agg[(s * 64 + p) * 2 + 1]; const float nr = sr * cr - si * ci + xr, ni = sr * ci + si * cr + xi; cr = nr; ci = ni; }
        bf16* U = (bf16*)(F.ws + WS_UT) + ((size_t)g * NCH + b * 512 + seg * 64) * UTP + 512 + p;
#pragma unroll 8
        for (int c = 0; c < 64; ++c) { U[(size_t)c * UTP] = (bf16)f2bf(cr); U[(size_t)c * UTP + 64] = (bf16)f2bf(ci);
            const float xr = X[(size_t)c * 128], xi = X[(size_t)c * 128 + 64]; const float nr = lr * cr - li * ci + xr, ni = lr * ci + li * cr + xi; cr = nr; ci = ni; }
        __syncthreads();
    }
}

__device__ __forceinline__ void final_norm(Frame& F) {
    const int gw = F.vcu * NWAVES + F.wave, NGW = F.G * NWAVES; const float* gn = F.in[I_FNORM];
    f32x4 gv[4];
#pragma unroll
    for (int j = 0; j < 4; ++j) gv[j] = ((const f32x4*)gn)[F.lane + 64 * j];
    for (int m = gw; m < T; m += NGW) {
        GAS f32x4* xr = (GAS f32x4*)(F.out + (size_t)m * D) + F.lane; f32x4 v[4]; float s = 0.f;
#pragma unroll
        for (int j = 0; j < 4; ++j) { v[j] = xr[64 * j]; s += (v[j].x * v[j].x + v[j].y * v[j].y) + (v[j].z * v[j].z + v[j].w * v[j].w); }
        const float rs = 1.0f / sqrtf(wave_sum(s) * (1.0f / D) + EPS);
#pragma unroll
        for (int j = 0; j < 4; ++j) xr[64 * j] = v[j] * rs * gv[j];
    }
}
constexpr int N_PHASES = 18;
__global__ void __launch_bounds__(NWAVES * 64, 2) mk_fwd(Args args) {
    extern __shared__ __attribute__((aligned(16))) unsigned char lds[];
    Frame F;
    F.lds = (LAS unsigned char*)lds;
    F.MISC = (volatile LAS unsigned*)(F.lds + MISC_OFF);
    F.tid = threadIdx.x; F.lane = F.tid & 63; F.wave = __builtin_amdgcn_readfirstlane(F.tid >> 6);
    F.G = gridDim.x; { const int bx = blockIdx.x; F.vcu = (F.G % 8 == 0) ? (bx % 8) * (F.G / 8) + bx / 8 : bx; }
    F.in = args.in; F.out = args.out; F.ws = args.ws;
    F.ctl = (gu32*)(args.ws + WS_CTL);
    for (int u = F.tid; u < (LDS_BYTES - LDSCTL_OFF) / 4; u += NWAVES * 64) ((LAS unsigned*)(F.lds + LDSCTL_OFF))[u] = 0u;
    __syncthreads();
    const int lo = args.ph_lo, hi = args.ph_hi;
    XcdBarrier bar; bar.bar = (unsigned*)(F.ctl + CW_BAR); bar.x = 0; bar.st = nullptr;
    if (hi - lo > 1) bar = xcd_barrier_post((unsigned*)(F.ctl + CW_BAR), F.MISC + 8);
#define IN(k) (lo <= (k) && (k) < hi)
#define SEAM(k) do { if (IN(k) && IN((k) + 1)) xcd_barrier(bar); } while (0)
    unsigned char* ws = args.ws;
    float* rowsq = (float*)(ws + WS_ROWSQ); bf16* xb = (bf16*)(ws + WS_XB); const float* mod = (const float*)(ws + WS_MOD); const float* cv = (const float*)(ws + WS_CV);
    const int bid = (int)blockIdx.x;

    if (IN(0)) { p0_prologue_a(F); } SEAM(0);
    if (IN(1)) { p1_prologue_b(F); } SEAM(1);
    if (IN(2)) {
        pg8::Gemm g{xb, (const bf16*)(ws + WS_WIN0), D, D, D}; pg8::StaticOrder S; S.init(T, N_IN0, F.G, bid, 64, (size_t)N_IN0 * D * 2);
        pg8::EpiIn0 E{rowsq, cv + CV_IN0, (bf16*)(ws + WS_UT), (bf16*)(ws + WS_QFIG)};
        pg8::gemm_phase<pg8::EpiIn0, pg8::StaticOrder, true>(F.lds + RING_OFF, g, S, E);
    } SEAM(2);
    if (IN(3)) {
        pg8::Gemm g{(const bf16*)(ws + WS_UT), (const bf16*)(ws + WS_S5F), UTP, 512, 512}; pg8::GroupOrder S; S.init(4, 1, S5G, F.G, F.vcu, (size_t)NCH * UTP * 2, (size_t)256 * 512 * 2);
        pg8::EpiS5X E{(float*)(ws + WS_XLOC)};
        pg8::gemm_phase<pg8::EpiS5X, pg8::GroupOrder, true>(F.lds + RING_OFF, g, S, E);
    } SEAM(3);
    if (IN(4)) { s5_carry(F); } SEAM(4);
    if (IN(5)) {
        pg8::Gemm g{(const bf16*)(ws + WS_UT), (const bf16*)(ws + WS_S5T), UTP, UTP, UTP}; pg8::GroupOrder S; S.init(4, 2, S5G, F.G, F.vcu, (size_t)NCH * UTP * 2, (size_t)512 * UTP * 2);
        pg8::EpiS5Y E{(bf16*)(ws + WS_YGELU)};
        pg8::gemm_phase<pg8::EpiS5Y, pg8::GroupOrder, true>(F.lds + RING_OFF, g, S, E);
    } SEAM(5);
    if (IN(6)) {
        pg8::Gemm g{(const bf16*)(ws + WS_YGELU), (const bf16*)(ws + WS_WGLU), 512, 512, 512}; pg8::StaticOrder S; S.init(T, 512, F.G, bid, 64, 0);
        pg8::EpiGlu E{(const bf16*)(ws + WS_YGELU), F.in[I_BGLU], (bf16*)(ws + WS_MIXED), D};
        pg8::gemm_phase<pg8::EpiGlu, pg8::StaticOrder, true>(F.lds + RING_OFF, g, S, E);
    } SEAM(6);
    if (IN(7)) {
        pg8::Gemm g{(const bf16*)(ws + WS_MIXED), (const bf16*)(ws + WS_WOUT0), D, D, D}; pg8::StaticOrder S; S.init(T, D, F.G, bid, 64, 0);
        pg8::EpiResid E{F.in[I_X], F.out, xb, rowsq, mod + 2048, 6144};
        pg8::gemm_phase<pg8::EpiResid, pg8::StaticOrder, true>(F.lds + RING_OFF, g, S, E);
    } SEAM(7);
    if (IN(8)) {
        pg8::Gemm g{xb, (const bf16*)(ws + WS_W13_0), D, D, D}; pg8::StaticOrder S; S.init(T, N_UP, F.G, bid, 64, (size_t)N_UP * D * 2);
        pg8::EpiFfnUp E{rowsq, cv + CV_UP0, (bf16*)(ws + WS_HID)};
        pg8::gemm_phase<pg8::EpiFfnUp, pg8::StaticOrder, true>(F.lds + RING_OFF, g, S, E);
    } SEAM(8);
    if (IN(9)) {
        pg8::Gemm g{(const bf16*)(ws + WS_HID), (const bf16*)(ws + WS_W2_0), FF, FF, FF}; pg8::StaticOrder S; S.init(T, D, F.G, bid, 64, 0);
        pg8::EpiResid E{F.out, F.out, xb, rowsq, mod + 5120, 6144};
        pg8::gemm_phase<pg8::EpiResid, pg8::StaticOrder, true>(F.lds + RING_OFF, g, S, E);
    } SEAM(9);
    if (IN(10)) {
        pg8::Gemm g{xb, (const bf16*)(ws + WS_WIN1), D, D, D}; pg8::StaticOrder S; S.init(T, N_IN1, F.G, bid, 64, (size_t)N_IN1 * D * 2);
        pg8::EpiIn1 E{rowsq, cv + CV_IN1, F.in[I_ODBA], (bf16*)(ws + WS_Z1)};
        pg8::gemm_phase<pg8::EpiIn1, pg8::StaticOrder, true>(F.lds + RING_OFF, g, S, E);
    } SEAM(10);
    SEAM(11); SEAM(12); SEAM(13);
    if (IN(14)) {
        pg8::Gemm g{(const bf16*)(ws + WS_OBUF1), (const bf16*)(ws + WS_WOUT1), D, D, D}; pg8::StaticOrder S; S.init(T, D, F.G, bid, 64, 0);
        pg8::EpiResid E{F.out, F.out, xb, rowsq, mod + 2 * 6144 + 2048, 6144};
        pg8::gemm_phase<pg8::EpiResid, pg8::StaticOrder, true>(F.lds + RING_OFF, g, S, E);
    } SEAM(14);
    if (IN(15)) {
        pg8::Gemm g{xb, (const bf16*)(ws + WS_W13_1), D, D, D}; pg8::StaticOrder S; S.init(T, N_UP, F.G, bid, 64, (size_t)N_UP * D * 2);
        pg8::EpiFfnUp E{rowsq, cv + CV_UP1, (bf16*)(ws + WS_HID)};
        pg8::gemm_phase<pg8::EpiFfnUp, pg8::StaticOrder, true>(F.lds + RING_OFF, g, S, E);
    } SEAM(15);
    if (IN(16)) {
        pg8::Gemm g{(const bf16*)(ws + WS_HID), (const bf16*)(ws + WS_W2_1), FF, FF, FF}; pg8::StaticOrder S; S.init(T, D, F.G, bid, 64, 0);
        pg8::EpiResid E{F.out, F.out, xb, rowsq, mod + 2 * 6144 + 5120, 6144};
        pg8::gemm_phase<pg8::EpiResid, pg8::StaticOrder, true>(F.lds + RING_OFF, g, S, E);
    } SEAM(16);
    if (IN(17)) { final_norm(F); }
#undef IN
#undef SEAM
}

__global__ void __launch_bounds__(64) naive_hg(Args args) {
    __shared__ float qs[32 * 128], fs[32 * 128];
    const int blk = blockIdx.x, b = blk >> 3, h = (blk >> 1) & 3, vs = blk & 1, tid = threadIdx.x;
    const bf16* Z = (const bf16*)(args.ws + WS_QFIG) + (size_t)b * SEQ * 2048; bf16* O = (bf16*)(args.ws + WS_OBUF0) + (size_t)b * SEQ * 512;
    const float* lbl = args.in[I_LBLOG];
    float S[128];
#pragma unroll
    for (int k = 0; k < 128; ++k) S[k] = 0.f;
    for (int t0 = 0; t0 < SEQ; t0 += 32) {
        __syncthreads();
        for (int i = 0; i < 64; ++i) { const int idx = i * 64 + tid, tt = idx >> 7, ch = idx & 127, c = h * 128 + ch;
            const float l0 = lbl[c], l1 = lbl[512 + c], l2 = lbl[1024 + c], mx = fmaxf(l0, fmaxf(l1, l2)); const float e0 = expf(l0 - mx), e1 = expf(l1 - mx), e2 = expf(l2 - mx), lb = e0 / (e0 + e1 + e2);
            const float q = bf2f(Z[(size_t)(t0 + tt) * 2048 + c]), f = bf2f(Z[(size_t)(t0 + tt) * 2048 + 512 + c]);
            qs[idx] = q / (1.f + expf(-q)); fs[idx] = lb + (1.f - lb) / (1.f + expf(-f)); }
        __syncthreads();
        float vr[32];
#pragma unroll
        for (int tt = 0; tt < 32; ++tt) vr[tt] = bf2f(Z[(size_t)(t0 + tt) * 2048 + 1024 + h * 128 + vs * 64 + tid]);
#pragma unroll
        for (int tt = 0; tt < 32; ++tt) {
            const float v = vr[tt]; float o = 0.f;
#pragma unroll
            for (int k = 0; k < 128; ++k) { const float f = fs[tt * 128 + k]; S[k] = S[k] * f + (1.f - f) * v; o += qs[tt * 128 + k] * S[k]; }
            O[(size_t)(t0 + tt) * 512 + h * 128 + vs * 64 + tid] = (bf16)f2bf(o);
        }
    }
}
__global__ void __launch_bounds__(256) post_hg(Args args) {
    const int w = blockIdx.x * 4 + (threadIdx.x >> 6), lane = threadIdx.x & 63, t = w >> 2, h = w & 3;
    const bf16* O = (const bf16*)(args.ws + WS_OBUF0) + (size_t)t * 512 + h * 128; const bf16* Gr = (const bf16*)(args.ws + WS_QFIG) + (size_t)t * 2048 + 1536 + h * 128;
    bf16* M = (bf16*)(args.ws + WS_MIXED) + (size_t)t * D + 512 + h * 128; const float* ng = args.in[I_HGNORM];
    const float o0 = bf2f(O[2 * lane]), o1 = bf2f(O[2 * lane + 1]); const float ss = wave_sum(o0 * o0 + o1 * o1); const float rs = 1.0f / sqrtf(ss * (1.0f / 128.0f) + EPS);
    const float g0 = bf2f(Gr[2 * lane]), g1 = bf2f(Gr[2 * lane + 1]);
    M[2 * lane] = (bf16)f2bf(o0 * rs * ng[2 * lane] * dsilu(g0)); M[2 * lane + 1] = (bf16)f2bf(o1 * rs * ng[2 * lane + 1] * dsilu(g1));
}
__global__ void __launch_bounds__(64) naive_gla(Args args) {
    __shared__ float qs[32 * 128], ks[32 * 128], as[32 * 128];
    const int blk = blockIdx.x, b = blk >> 4, h = (blk >> 2) & 3, vs = blk & 3, tid = threadIdx.x;
    const bf16* Z = (const bf16*)(args.ws + WS_Z1) + (size_t)b * SEQ * N_IN1; bf16* O = (bf16*)(args.ws + WS_OBUF1) + (size_t)b * SEQ * D;
    float S[128];
#pragma unroll
    for (int k = 0; k < 128; ++k) S[k] = 0.f;
    for (int t0 = 0; t0 < SEQ; t0 += 32) {
        __syncthreads();
        for (int i = 0; i < 64; ++i) { const int idx = i * 64 + tid, tt = idx >> 7, ch = idx & 127, c = h * 128 + ch; const bf16* zr = Z + (size_t)(t0 + tt) * N_IN1;
            qs[idx] = bf2f(zr[c]); ks[idx] = bf2f(zr[512 + c]); as[idx] = expf(bf2f(zr[3072 + c]) * (1.0f / 16.0f)); }
        __syncthreads();
        float vr[32];
#pragma unroll
        for (int tt = 0; tt < 32; ++tt) vr[tt] = bf2f(Z[(size_t)(t0 + tt) * N_IN1 + 1024 + h * 256 + vs * 64 + tid]);
#pragma unroll
        for (int tt = 0; tt < 32; ++tt) {
            const float v = vr[tt]; float o = 0.f;
#pragma unroll
            for (int k = 0; k < 128; ++k) { S[k] = S[k] * as[tt * 128 + k] + ks[tt * 128 + k] * v; o += qs[tt * 128 + k] * S[k]; }
            O[(size_t)(t0 + tt) * D + h * 256 + vs * 64 + tid] = (bf16)f2bf(o);
        }
    }
}
__global__ void __launch_bounds__(256) post_gla(Args args) {
    const int w = blockIdx.x * 4 + (threadIdx.x >> 6), lane = threadIdx.x & 63, t = w >> 2, h = w & 3;
    bf16* O = (bf16*)(args.ws + WS_OBUF1) + (size_t)t * D + h * 256; const bf16* R = (const bf16*)(args.ws + WS_Z1) + (size_t)t * N_IN1 + 2048 + h * 256; const float* ng = args.in[I_GLANORM];
    float o[4], ss = 0.f;
#pragma unroll
    for (int e = 0; e < 4; ++e) { o[e] = bf2f(O[4 * lane + e]); ss += o[e] * o[e]; }
    ss = wave_sum(ss); const float rs = 1.0f / sqrtf(ss * (1.0f / 256.0f) + EPS);
#pragma unroll
    for (int e = 0; e < 4; ++e) O[4 * lane + e] = (bf16)f2bf(o[e] * rs * ng[4 * lane + e] * dsilu(bf2f(R[4 * lane + e])));
}

extern "C" void kernel_launch(void* const* d_in, const int* in_sizes, int n_in, void* d_out, int out_size, void* d_ws, size_t ws_size, hipStream_t stream) {
    static int grid = 0;
    if (grid == 0) {
        if (n_in != 30 || in_sizes[0] != T * D || out_size != T * D || ws_size < WS_END) { fprintf(stderr, "kernel_launch: unexpected shapes: n_in %d in0 %d out %d ws %zu (need %zu)\n", n_in, n_in > 0 ? in_sizes[0] : -1, out_size, ws_size, (size_t)WS_END); grid = -1; return; }
        int dev = 0, cus = 0, per_cu = 0;
        if (hipGetDevice(&dev) != hipSuccess || hipDeviceGetAttribute(&cus, hipDeviceAttributeMultiprocessorCount, dev) != hipSuccess) { fprintf(stderr, "kernel_launch: device query failed\n"); grid = -1; return; }
        if (hipFuncSetAttribute((const void*)mk_fwd, hipFuncAttributeMaxDynamicSharedMemorySize, LDS_BYTES) != hipSuccess) { fprintf(stderr, "kernel_launch: hipFuncSetAttribute failed\n"); grid = -1; return; }
        if (hipOccupancyMaxActiveBlocksPerMultiprocessor(&per_cu, (const void*)mk_fwd, NWAVES * 64, LDS_BYTES) != hipSuccess || per_cu < 1) fprintf(stderr, "kernel_launch: occupancy query reports %d per CU\n", per_cu);
        (void)hipGetLastError();
        grid = cus;
    }
    if (grid < 0) return;
    (void)hipMemsetAsync((char*)d_ws + WS_CTL, 0, CTL_ZERO_BYTES, stream);
    Args a{};
    for (int i = 0; i < 30; ++i) a.in[i] = (const float*)d_in[i];
    a.out = (float*)d_out; a.ws = (unsigned char*)d_ws;
    auto run = [&](int lo, int hi) { a.ph_lo = lo; a.ph_hi = hi; hipLaunchKernelGGL(mk_fwd, dim3(grid), dim3(NWAVES * 64), LDS_BYTES, stream, a); };
    for (int p = 0; p <= 5; ++p) run(p, p + 1);
    hipLaunchKernelGGL(naive_hg, dim3(16), dim3(64), 0, stream, a);
    hipLaunchKernelGGL(post_hg, dim3(T), dim3(256), 0, stream, a);
    for (int p = 6; p <= 10; ++p) run(p, p + 1);
    hipLaunchKernelGGL(naive_gla, dim3(32), dim3(64), 0, stream, a);
    hipLaunchKernelGGL(post_gla, dim3(T), dim3(256), 0, stream, a);
    for (int p = 14; p <= 17; ++p) run(p, p + 1);
}
```

```cpp
#include <hip/hip_runtime.h>
#include <cstdio>
#include <cstdint>
#include <cmath>
namespace pg8 {
#define PG8_LAS __attribute__((address_space(3)))
typedef unsigned short bf16_t;
typedef short bf16x8 __attribute__((ext_vector_type(8)));
typedef float f32x4 __attribute__((ext_vector_type(4)));
typedef unsigned u32x4 __attribute__((ext_vector_type(4)));
typedef unsigned u32x2 __attribute__((ext_vector_type(2)));
constexpr int BM = 256, BK = 64, HALF = 128, HTB = HALF * BK * 2  , STAGE_BYTES = 8 * HTB, NXCD = 8, WGM = 8;

__host__ __device__ __forceinline__ int lds_byte(int r, int c) { const int st = (r >> 4) * 2 + (c >> 5), rr = r & 15, cc = c & 31, ob = rr * 64 + cc * 2; return st * 1024 + (ob ^ (((ob >> 9) & 1) << 5)); }
__host__ __device__ __forceinline__ void stage_rc(int b, int& R, int& C) { const int st = b / 1024, sb = b % 1024, swz = sb ^ (((sb >> 9) & 1) << 5); R = (st >> 1) * 16 + swz / 64; C = (st & 1) * 32 + (swz % 64) / 2; }
__host__ __device__ __forceinline__ int perm32(int rho) { const int n = rho >> 4, i = rho & 15; return 8 * (i >> 2) + 4 * n + (i & 3); }

struct Unit { int pm, pn, g; size_t aoff, boff; };
struct Gemm { const bf16_t* A; const bf16_t* Bt; int lda, ldb, K; };

struct StaticOrder {
    int nM, nN, nwg, G, c, pm_per_batch; size_t bstride;
    __device__ void init(int M, int N, int G_, int c_, int pmpb, size_t bs) { nM = M / BM; nN = N / BM; nwg = nM * nN; G = G_; c = c_; pm_per_batch = pmpb; bstride = bs; }
    __device__ bool next(int i, Unit& u) const {
        const long L = (long)i * G + c; if (L >= nwg) return false;
        int wgid = (int)L; { const int q = nwg / NXCD, r = nwg % NXCD, xcd = wgid % NXCD, off = wgid / NXCD; wgid = (xcd < r ? xcd * (q + 1) : r * (q + 1) + (xcd - r) * q) + off; }
        const int nig = WGM * nN, gid = wgid / nig, fm = gid * WGM, gsz = (nM - fm) < WGM ? (nM - fm) : WGM;
        u.pm = fm + ((wgid % nig) % gsz); u.pn = (wgid % nig) / gsz; u.g = u.pm / pm_per_batch; u.aoff = 0; u.boff = (size_t)u.g * bstride; return true;
    }
};
struct GroupOrder {
    int nM, nN, ngroups, G, c; size_t astride, bstride;
    __device__ void init(int nM_, int nN_, int ng, int G_, int c_, size_t as, size_t bs) { nM = nM_; nN = nN_; ngroups = ng; G = G_; c = c_; astride = as; bstride = bs; }
    __device__ bool next(int i, Unit& u) const {
        const long L = (long)i * G + c; if (L >= (long)ngroups * nM * nN) return false;
        const int g = (int)(L / (nM * nN)), r = (int)(L % (nM * nN)); u.g = g; u.pm = r / nN; u.pn = r % nN; u.aoff = (size_t)g * astride; u.boff = (size_t)g * bstride; return true;
    }
};

__device__ __forceinline__ unsigned cvt_pk_bf16(float lo, float hi) { unsigned r; asm volatile("v_cvt_pk_bf16_f32 %0, %1, %2" : "=v"(r) : "v"(lo), "v"(hi)); return r; }
__device__ __forceinline__ float bf_lo(unsigned w) { return __uint_as_float(w << 16); }
__device__ __forceinline__ float bf_hi(unsigned w) { return __uint_as_float(w & 0xffff0000u); }
__device__ __forceinline__ float fsigmoid(float x) { return __builtin_amdgcn_rcpf(1.0f + __expf(-x)); }
__device__ __forceinline__ float fsilu(float x) { return x * fsigmoid(x); }
__device__ __forceinline__ float fgelu_tanh(float y) { return y * fsigmoid(1.5957691216f * (y + 0.044715f * y * y * y)); }
__device__ __forceinline__ float flogsigmoid(float x) { return fminf(x, 0.f) - __logf(1.0f + __expf(-fabsf(x))); }
__device__ __forceinline__ float row_rstd(const float* rowsq, int row) {
    const f32x4* p = (const f32x4*)(rowsq + (size_t)row * 16); const f32x4 a = p[0], b = p[1], c = p[2], d = p[3];
    const float s = ((a[0] + a[1]) + (a[2] + a[3])) + ((b[0] + b[1]) + (b[2] + b[3])) + ((c[0] + c[1]) + (c[2] + c[3])) + ((d[0] + d[1]) + (d[2] + d[3]));
    return 1.0f / sqrtf(s * (1.0f / 1024.0f) + 1e-6f);
}


struct EpiIn0 {
    static constexpr bool PERM = true, AFTER_DRAIN = false;
    const float* rowsq; const float* cvec; bf16_t* Ut; bf16_t* QFG; bf16_t* VT;
    __device__ __forceinline__ void operator()(const f32x4 (&acc)[2][2][4][2], const Unit& u, int wr, int wc, int fr, int fq) const {
        f32x4 cv[2][2];
#pragma unroll
        for (int bj = 0; bj < 2; ++bj)
#pragma unroll
            for (int n = 0; n < 2; ++n) cv[bj][n] = *(const f32x4*)(cvec + u.g * 2560 + u.pn * BM + bj * HALF + wc * 32 + 8 * fq + 4 * n);
#pragma unroll
        for (int ai = 0; ai < 2; ++ai)
#pragma unroll
        for (int m = 0; m < 4; ++m) { const int row = u.pm * BM + ai * HALF + wr * 64 + m * 16 + fr;
            const float rs = row_rstd(rowsq, row);
#pragma unroll
            for (int bj = 0; bj < 2; ++bj) { const int c0 = u.pn * BM + bj * HALF + wc * 32 + 8 * fq;
                const f32x4 v0 = acc[ai][bj][m][0] * rs + cv[bj][0], v1 = acc[ai][bj][m][1] * rs + cv[bj][1];
                u32x4 w; w.x = cvt_pk_bf16(v0[0], v0[1]); w.y = cvt_pk_bf16(v0[2], v0[3]); w.z = cvt_pk_bf16(v1[0], v1[1]); w.w = cvt_pk_bf16(v1[2], v1[3]);
                if (u.pn == 6 || u.pn == 7) { bf16_t* d = VT + ((size_t)(row >> 6) * 512 + (c0 - 1536)) * 64 + (row & 63);
                    d[0] = (bf16_t)w.x; d[64] = (bf16_t)(w.x >> 16); d[128] = (bf16_t)w.y; d[192] = (bf16_t)(w.y >> 16); d[256] = (bf16_t)w.z; d[320] = (bf16_t)(w.z >> 16); d[384] = (bf16_t)w.w; d[448] = (bf16_t)(w.w >> 16); }
                else { bf16_t* dst = (u.pn < 2) ? Ut + ((size_t)((c0 >> 4) * 1024 + (row >> 5)) * 640 + (row & 31) * 16 + (c0 & 15)) : QFG + (size_t)row * 1536 + (u.pn < 6 ? c0 - 512 : c0 - 1024);
                    *(u32x4*)dst = w; } }
        }
    }
};
struct EpiS5X {
    static constexpr bool PERM = false, AFTER_DRAIN = false;
    float* Xloc;
    __device__ __forceinline__ void operator()(const f32x4 (&acc)[2][2][4][2], const Unit& u, int wr, int wc, int fr, int fq) const {
#pragma unroll
        for (int ai = 0; ai < 2; ++ai)
#pragma unroll
        for (int m = 0; m < 4; ++m) { const int row = u.pm * BM + ai * HALF + wr * 64 + m * 16 + fr;
#pragma unroll
            for (int n = 0; n < 2; ++n) *(f32x4*)(Xloc + ((size_t)u.g * 1024 + row) * 128 + wc * 32 + 16 * n + 4 * fq) = acc[ai][0][m][n];
        }
    }
};
struct EpiS5Y {
    static constexpr bool PERM = true, AFTER_DRAIN = false;
    bf16_t* Y;
    __device__ __forceinline__ void operator()(const f32x4 (&acc)[2][2][4][2], const Unit& u, int wr, int wc, int fr, int fq) const {
#pragma unroll
        for (int ai = 0; ai < 2; ++ai)
#pragma unroll
        for (int m = 0; m < 4; ++m) { const int row = u.pm * BM + ai * HALF + wr * 64 + m * 16 + fr;
#pragma unroll
            for (int bj = 0; bj < 2; ++bj) { const int c0 = u.pn * BM + bj * HALF + wc * 32 + 8 * fq;
                const f32x4 a0 = acc[ai][bj][m][0], a1 = acc[ai][bj][m][1];
                u32x4 w; w.x = cvt_pk_bf16(fgelu_tanh(a0[0]), fgelu_tanh(a0[1])); w.y = cvt_pk_bf16(fgelu_tanh(a0[2]), fgelu_tanh(a0[3]));
                w.z = cvt_pk_bf16(fgelu_tanh(a1[0]), fgelu_tanh(a1[1])); w.w = cvt_pk_bf16(fgelu_tanh(a1[2]), fgelu_tanh(a1[3]));
                *(u32x4*)(Y + ((size_t)row * 32 + (c0 >> 4)) * 512 + u.g * 16 + (c0 & 15)) = w; }
        }
    }
};
struct EpiGlu {
    static constexpr bool PERM = true, AFTER_DRAIN = false;
    const bf16_t* Y; const float* bias; bf16_t* O; int ldo;
    __device__ __forceinline__ void operator()(const f32x4 (&acc)[2][2][4][2], const Unit& u, int wr, int wc, int fr, int fq) const {
        f32x4 bv[2][2];
#pragma unroll
        for (int bj = 0; bj < 2; ++bj)
#pragma unroll
            for (int n = 0; n < 2; ++n) bv[bj][n] = *(const f32x4*)(bias + u.pn * BM + bj * HALF + wc * 32 + 8 * fq + 4 * n);
#pragma unroll
        for (int ai = 0; ai < 2; ++ai)
#pragma unroll
        for (int m = 0; m < 4; ++m) { const int row = u.pm * BM + ai * HALF + wr * 64 + m * 16 + fr;
#pragma unroll
            for (int bj = 0; bj < 2; ++bj) { const int c0 = u.pn * BM + bj * HALF + wc * 32 + 8 * fq;
                const u32x4 yw = *(const u32x4*)(Y + (size_t)row * 512 + c0);
                const f32x4 a0 = acc[ai][bj][m][0] + bv[bj][0], a1 = acc[ai][bj][m][1] + bv[bj][1];
                u32x4 w; w.x = cvt_pk_bf16(bf_lo(yw.x) * fsigmoid(a0[0]), bf_hi(yw.x) * fsigmoid(a0[1])); w.y = cvt_pk_bf16(bf_lo(yw.y) * fsigmoid(a0[2]), bf_hi(yw.y) * fsigmoid(a0[3]));
                w.z = cvt_pk_bf16(bf_lo(yw.z) * fsigmoid(a1[0]), bf_hi(yw.z) * fsigmoid(a1[1])); w.w = cvt_pk_bf16(bf_lo(yw.w) * fsigmoid(a1[2]), bf_hi(yw.w) * fsigmoid(a1[3]));
                *(u32x4*)(O + (size_t)row * ldo + c0) = w; }
        }
    }
};
struct EpiResid {
    static constexpr bool PERM = true, AFTER_DRAIN = false;
    const float* xold; float* xnew; bf16_t* xb; float* rowsq; const float* gate; int gstride;
    __device__ __forceinline__ void operator()(const f32x4 (&acc)[2][2][4][2], const Unit& u, int wr, int wc, int fr, int fq) const {
        f32x4 gv[2][2];
#pragma unroll
        for (int bj = 0; bj < 2; ++bj)
#pragma unroll
            for (int n = 0; n < 2; ++n) gv[bj][n] = *(const f32x4*)(gate + u.g * gstride + u.pn * BM + bj * HALF + wc * 32 + 8 * fq + 4 * n);
#pragma unroll
        for (int ai = 0; ai < 2; ++ai)
#pragma unroll
        for (int m = 0; m < 4; ++m) { const int row = u.pm * BM + ai * HALF + wr * 64 + m * 16 + fr;
            float sq = 0.f;
#pragma unroll
            for (int bj = 0; bj < 2; ++bj) { const size_t off = (size_t)row * 1024 + u.pn * BM + bj * HALF + wc * 32 + 8 * fq;
                const f32x4 x0 = *(const f32x4*)(xold + off), x1 = *(const f32x4*)(xold + off + 4);
                const f32x4 v0 = x0 + gv[bj][0] * acc[ai][bj][m][0], v1 = x1 + gv[bj][1] * acc[ai][bj][m][1];
                *(f32x4*)(xnew + off) = v0; *(f32x4*)(xnew + off + 4) = v1;
                sq += (v0[0] * v0[0] + v0[1] * v0[1]) + (v0[2] * v0[2] + v0[3] * v0[3]) + (v1[0] * v1[0] + v1[1] * v1[1]) + (v1[2] * v1[2] + v1[3] * v1[3]);
                u32x4 w; w.x = cvt_pk_bf16(v0[0], v0[1]); w.y = cvt_pk_bf16(v0[2], v0[3]); w.z = cvt_pk_bf16(v1[0], v1[1]); w.w = cvt_pk_bf16(v1[2], v1[3]);
                *(u32x4*)(xb + off) = w; }
            sq += __shfl_xor(sq, 16); sq += __shfl_xor(sq, 32);
            if (fq == 0) rowsq[(size_t)row * 16 + u.pn * 4 + wc] = sq;
        }
    }
};
struct EpiFfnUp {
    static constexpr bool PERM = true, AFTER_DRAIN = false;
    const float* rowsq; const float* cvec; bf16_t* H;
    __device__ __forceinline__ void operator()(const f32x4 (&acc)[2][2][4][2], const Unit& u, int wr, int wc, int fr, int fq) const {
        f32x4 cv[2][2];
#pragma unroll
        for (int bj = 0; bj < 2; ++bj)
#pragma unroll
            for (int n = 0; n < 2; ++n) cv[bj][n] = *(const f32x4*)(cvec + u.g * 5632 + u.pn * BM + bj * HALF + wc * 32 + 8 * fq + 4 * n);
#pragma unroll
        for (int ai = 0; ai < 2; ++ai)
#pragma unroll
        for (int m = 0; m < 4; ++m) { const int row = u.pm * BM + ai * HALF + wr * 64 + m * 16 + fr;
            const float rs = row_rstd(rowsq, row);
            const f32x4 a0 = acc[ai][0][m][0] * rs + cv[0][0], a1 = acc[ai][0][m][1] * rs + cv[0][1], b0 = acc[ai][1][m][0] * rs + cv[1][0], b1 = acc[ai][1][m][1] * rs + cv[1][1];
            u32x4 w; w.x = cvt_pk_bf16(fsilu(a0[0]) * b0[0], fsilu(a0[1]) * b0[1]); w.y = cvt_pk_bf16(fsilu(a0[2]) * b0[2], fsilu(a0[3]) * b0[3]);
            w.z = cvt_pk_bf16(fsilu(a1[0]) * b1[0], fsilu(a1[1]) * b1[1]); w.w = cvt_pk_bf16(fsilu(a1[2]) * b1[2], fsilu(a1[3]) * b1[3]);
            *(u32x4*)(H + (size_t)row * 2816 + u.pn * HALF + wc * 32 + 8 * fq) = w;
        }
    }
};
struct EpiIn1 {
    static constexpr bool PERM = true, AFTER_DRAIN = false;
    const float* rowsq; const float* cvec; const float* ba; bf16_t* Z; bf16_t* VT;
    __device__ __forceinline__ void operator()(const f32x4 (&acc)[2][2][4][2], const Unit& u, int wr, int wc, int fr, int fq) const {
        f32x4 cv[2][2];
#pragma unroll
        for (int bj = 0; bj < 2; ++bj)
#pragma unroll
            for (int n = 0; n < 2; ++n) { const int c = u.pn * BM + bj * HALF + wc * 32 + 8 * fq + 4 * n; cv[bj][n] = *(const f32x4*)(cvec + u.g * 3584 + c); if (u.pn >= 12) cv[bj][n] += *(const f32x4*)(ba + c - 3072); }
#pragma unroll
        for (int ai = 0; ai < 2; ++ai)
#pragma unroll
        for (int m = 0; m < 4; ++m) { const int row = u.pm * BM + ai * HALF + wr * 64 + m * 16 + fr;
            const float rs = row_rstd(rowsq, row);
#pragma unroll
            for (int bj = 0; bj < 2; ++bj) { const int c0 = u.pn * BM + bj * HALF + wc * 32 + 8 * fq;
                f32x4 v0 = acc[ai][bj][m][0] * rs + cv[bj][0], v1 = acc[ai][bj][m][1] * rs + cv[bj][1];
                if (u.pn < 2) { v0 = v0 * 0.08838834764831845f; v1 = v1 * 0.08838834764831845f; }
                if (u.pn >= 12) {
#pragma unroll
                    for (int e = 0; e < 4; ++e) { v0[e] = flogsigmoid(v0[e]); v1[e] = flogsigmoid(v1[e]); } }
                u32x4 w; w.x = cvt_pk_bf16(v0[0], v0[1]); w.y = cvt_pk_bf16(v0[2], v0[3]); w.z = cvt_pk_bf16(v1[0], v1[1]); w.w = cvt_pk_bf16(v1[2], v1[3]);
                if (u.pn >= 4 && u.pn < 8) { bf16_t* d = VT + ((size_t)(row >> 6) * 1024 + (c0 - 1024)) * 64 + (row & 63);
                    d[0] = (bf16_t)w.x; d[64] = (bf16_t)(w.x >> 16); d[128] = (bf16_t)w.y; d[192] = (bf16_t)(w.y >> 16); d[256] = (bf16_t)w.z; d[320] = (bf16_t)(w.z >> 16); d[384] = (bf16_t)w.w; d[448] = (bf16_t)(w.w >> 16); }
                else *(u32x4*)(Z + (size_t)row * 2560 + (u.pn < 4 ? c0 : c0 - 1024)) = w; }
        }
    }
};

template <class Epi, class Sched, bool ALIGN_EPI>
__device__ __forceinline__ void gemm_phase(PG8_LAS unsigned char* lds, const Gemm g, const Sched& S, const Epi& E) {
    const int tid = threadIdx.x, wid = __builtin_amdgcn_readfirstlane(tid >> 6), lane = tid & 63, wr = wid >> 2, wc = wid & 3, fr = lane & 15, fq = lane >> 4;
    const int K = g.K, nt = K / BK;
    unsigned voffA[2], voffB[2];
#pragma unroll
    for (int i = 0; i < 2; ++i) { int R, C; stage_rc(tid * 16 + i * 8192, R, C); const int Rb = Epi::PERM ? ((R & ~31) + perm32(R & 31)) : R;
        voffA[i] = (unsigned)(R * g.lda + C) * 2u; voffB[i] = (unsigned)(Rb * g.ldb + C) * 2u; }
    const size_t kstep = (size_t)(BK * 2);
    const size_t hstepA = (size_t)HALF * g.lda * 2, hstepB = (size_t)HALF * g.ldb * 2;
    const unsigned ldsw = (unsigned)wid * 1024u;
    const int aoff = lds_byte(wr * 64 + fr, fq * 8), boff = lds_byte(wc * 32 + fr, fq * 8);
#define PG8_SA(b, h) (((b) * 2 + (h)) * HTB)
#define PG8_SB(b, h) ((4 + (b) * 2 + (h)) * HTB)
#define PG8_STAGE(bufoff, gbase, voff) do { _Pragma("unroll") for (int _i = 0; _i < 2; ++_i) \
        __builtin_amdgcn_global_load_lds((const unsigned*)((const char*)(gbase) + (voff)[_i]), (PG8_LAS unsigned*)(lds + (bufoff) + ldsw + _i * 8192), 16, 0, 0); } while (0)
#define PG8_LDA(dst, b, h) do { _Pragma("unroll") for (int m = 0; m < 4; ++m) _Pragma("unroll") for (int k = 0; k < 2; ++k) dst[m][k] = *(const PG8_LAS bf16x8*)(lds + PG8_SA(b, h) + aoff + m * 2048 + k * 1024); } while (0)
#define PG8_LDB(dst, b, h) do { _Pragma("unroll") for (int n = 0; n < 2; ++n) _Pragma("unroll") for (int k = 0; k < 2; ++k) dst[n][k] = *(const PG8_LAS bf16x8*)(lds + PG8_SB(b, h) + boff + n * 2048 + k * 1024); } while (0)
#define PG8_MMA(ai, bj, At, Bt) do { __builtin_amdgcn_s_setprio(1); _Pragma("unroll") for (int m = 0; m < 4; ++m) _Pragma("unroll") for (int n = 0; n < 2; ++n) _Pragma("unroll") for (int k = 0; k < 2; ++k) \
        acc[ai][bj][m][n] = __builtin_amdgcn_mfma_f32_16x16x32_bf16(Bt[n][k], At[m][k], acc[ai][bj][m][n], 0, 0, 0); __builtin_amdgcn_s_setprio(0); } while (0)
#define PG8_WAIT_V(n) asm volatile("s_waitcnt vmcnt(" #n ")" ::: "memory")
#define PG8_WAIT_L(n) asm volatile("s_waitcnt lgkmcnt(" #n ")" ::: "memory")
#define PG8_BAR __builtin_amdgcn_s_barrier()
#define PG8_SCHED __builtin_amdgcn_sched_barrier(0)
    Unit cur, nxt; int ui = 0;
    if (!S.next(0, cur)) return;
    f32x4 acc[2][2][4][2];
#pragma unroll
    for (int a = 0; a < 2; ++a)
#pragma unroll
        for (int b = 0; b < 2; ++b)
#pragma unroll
            for (int m = 0; m < 4; ++m)
#pragma unroll
                for (int n = 0; n < 2; ++n) acc[a][b][m][n] = (f32x4){0.f, 0.f, 0.f, 0.f};
    bf16x8 At[4][2], B0[2][2], B1[2][2];
    const char* cA = (const char*)g.A + cur.aoff + (size_t)cur.pm * 2 * hstepA; const char* cB = (const char*)g.Bt + cur.boff + (size_t)cur.pn * 2 * hstepB;
    PG8_STAGE(PG8_SB(0, 0), cB, voffB); PG8_STAGE(PG8_SB(0, 1), cB + hstepB, voffB); PG8_STAGE(PG8_SA(0, 0), cA, voffA); PG8_STAGE(PG8_SA(0, 1), cA + hstepA, voffA);
    if (wr == 1) PG8_BAR;
    PG8_WAIT_V(2); PG8_BAR;
    PG8_STAGE(PG8_SB(1, 0), cB + kstep, voffB); PG8_STAGE(PG8_SA(1, 0), cA + kstep, voffA); PG8_STAGE(PG8_SB(1, 1), cB + hstepB + kstep, voffB);
    PG8_WAIT_V(6); PG8_BAR;
    for (;;) {
        const bool has_next = S.next(ui + 1, nxt);
        const char* nA = has_next ? (const char*)g.A + nxt.aoff + (size_t)nxt.pm * 2 * hstepA : cA; const char* nB = has_next ? (const char*)g.Bt + nxt.boff + (size_t)nxt.pn * 2 * hstepB : cB;
        for (int t = 0; t < nt; t += 2) {
            const bool last = (t == nt - 2);
            const char* a1 = cA + (size_t)(t + 1) * kstep;
            const char* a2 = last ? nA : cA + (size_t)(t + 2) * kstep; const char* b2 = last ? nB : cB + (size_t)(t + 2) * kstep;
            const char* a3 = a2 + kstep; const char* b3 = b2 + kstep;
            PG8_LDB(B0, 0, 0); PG8_LDB(B1, 0, 1); PG8_SCHED; PG8_LDA(At, 0, 0); PG8_STAGE(PG8_SA(1, 1), a1 + hstepA, voffA);
            PG8_WAIT_V(8); PG8_WAIT_L(0); PG8_BAR; PG8_MMA(0, 0, At, B0); PG8_MMA(0, 1, At, B1); PG8_BAR; PG8_SCHED;
            PG8_LDA(At, 0, 1); PG8_STAGE(PG8_SB(0, 0), b2, voffB); PG8_STAGE(PG8_SB(0, 1), b2 + hstepB, voffB); PG8_STAGE(PG8_SA(0, 0), a2, voffA);
            PG8_WAIT_V(8); PG8_WAIT_L(0); PG8_BAR; PG8_MMA(1, 0, At, B0); PG8_MMA(1, 1, At, B1); PG8_BAR; PG8_SCHED;
            PG8_LDB(B0, 1, 0); PG8_LDB(B1, 1, 1); PG8_SCHED; PG8_LDA(At, 1, 0); PG8_STAGE(PG8_SA(0, 1), a2 + hstepA, voffA);
            PG8_WAIT_V(8); PG8_WAIT_L(0); PG8_BAR; PG8_MMA(0, 0, At, B0); PG8_MMA(0, 1, At, B1); PG8_BAR; PG8_SCHED;
            PG8_LDA(At, 1, 1); PG8_STAGE(PG8_SB(1, 0), b3, voffB); PG8_STAGE(PG8_SB(1, 1), b3 + hstepB, voffB); PG8_STAGE(PG8_SA(1, 0), a3, voffA);
            PG8_WAIT_V(8); PG8_WAIT_L(0); PG8_BAR; PG8_MMA(1, 0, At, B0); PG8_MMA(1, 1, At, B1); PG8_BAR; PG8_SCHED;
        }
        if constexpr (ALIGN_EPI) { if (wr == 0) PG8_BAR; }
        E(acc, cur, wr, wc, fr, fq);
        if (!has_next) break;
#pragma unroll
        for (int a = 0; a < 2; ++a)
#pragma unroll
            for (int b = 0; b < 2; ++b)
#pragma unroll
                for (int m = 0; m < 4; ++m)
#pragma unroll
                    for (int n = 0; n < 2; ++n) acc[a][b][m][n] = (f32x4){0.f, 0.f, 0.f, 0.f};
        cur = nxt; cA = nA; cB = nB; ++ui;
        if constexpr (ALIGN_EPI) { if (wr == 1) PG8_BAR; }
    }
    PG8_WAIT_V(0);
    if constexpr (!ALIGN_EPI) { if (wr == 0) PG8_BAR; }
    PG8_BAR;
#undef PG8_SA
#undef PG8_SB
#undef PG8_STAGE
#undef PG8_LDA
#undef PG8_LDB
#undef PG8_MMA
#undef PG8_WAIT_V
#undef PG8_WAIT_L
#undef PG8_BAR
#undef PG8_SCHED
}
}
constexpr int NWAVES = 8;
constexpr int BATCH = 2, SEQ = 16384, D = 1024, T = BATCH * SEQ;
constexpr int FF = 2816, S5W = 512, S5G = 32, S5P = 64, LC = 32, NCH = T / LC  , UTP = LC * 16 + 128  ;
constexpr int N_IN0 = 2560, N_IN1 = 3584, N_UP = 5632;
constexpr float EPS = 1e-6f;
constexpr size_t MiB = 1u << 20;
constexpr size_t WS_CTL = 0, CTL_ZERO_BYTES = 1 * MiB;
constexpr size_t WS_MOD = 1 * MiB;
constexpr size_t WS_CV = 1 * MiB + 128 * 1024;
constexpr int CV_IN0 = 0, CV_UP0 = 2 * N_IN0, CV_IN1 = CV_UP0 + 2 * N_UP, CV_UP1 = CV_IN1 + 2 * N_IN1;
constexpr size_t WS_S5LAM = 1 * MiB + 512 * 1024;
constexpr size_t WS_WIN0 = 2 * MiB, WS_WOUT0 = 12 * MiB, WS_WGLU = 14 * MiB, WS_S5F = 15 * MiB, WS_S5T = 23 * MiB, WS_W13_0 = 43 * MiB, WS_W2_0 = 65 * MiB,
                 WS_WIN1 = 71 * MiB, WS_WOUT1 = 85 * MiB, WS_W13_1 = 87 * MiB, WS_W2_1 = 109 * MiB;
constexpr size_t WS_ROWSQ = 115 * MiB, WS_XB = 117 * MiB, WS_POOL = 181 * MiB, WS_END = 512 * MiB;
constexpr size_t WS_UT = WS_POOL, WS_QFG = 221 * MiB, WS_VT0 = 317 * MiB, WS_XLOC = 349 * MiB, WS_YGELU = 365 * MiB, WS_MIXED = 397 * MiB, WS_HGA = 461 * MiB, WS_HGD = 477 * MiB;
constexpr size_t WS_HID = WS_POOL;
constexpr size_t WS_Z1 = WS_POOL, WS_VT1 = 341 * MiB, WS_MIXED2 = 405 * MiB, WS_GLA_A = 469 * MiB, WS_GLA_D = 501 * MiB;
static_assert(WS_WIN0 + (size_t)2 * N_IN0 * D * 2 <= WS_WOUT0 && WS_S5F + (size_t)S5G * 256 * 512 * 2 <= WS_S5T && WS_S5T + (size_t)S5G * 512 * UTP * 2 <= WS_W13_0 && WS_W13_0 + (size_t)2 * N_UP * D * 2 <= WS_W2_0 &&
              WS_W2_0 + (size_t)D * FF * 2 <= WS_WIN1 && WS_WIN1 + (size_t)2 * N_IN1 * D * 2 <= WS_WOUT1 && WS_W13_1 + (size_t)2 * N_UP * D * 2 <= WS_W2_1 && WS_W2_1 + (size_t)D * FF * 2 <= WS_ROWSQ, "weights map");
static_assert(WS_UT + (size_t)S5G * NCH * UTP * 2 <= WS_QFG && WS_QFG + (size_t)T * 1536 * 2 <= WS_VT0 && WS_VT0 + (size_t)T * 512 * 2 <= WS_XLOC && WS_XLOC + (size_t)S5G * NCH * 128 * 4 <= WS_YGELU && WS_YGELU + (size_t)T * 512 * 2 <= WS_MIXED &&
              WS_MIXED + (size_t)T * D * 2 <= WS_HGA && WS_HGA + (size_t)8 * 32 * 128 * 128 * 4 <= WS_HGD && WS_HID + (size_t)T * FF * 2 <= WS_END && WS_Z1 + (size_t)T * 2560 * 2 <= WS_VT1 && WS_VT1 + (size_t)T * D * 2 <= WS_MIXED2 &&
              WS_MIXED2 + (size_t)T * D * 2 <= WS_GLA_A && WS_GLA_A + (size_t)8 * 32 * 128 * 256 * 4 <= WS_GLA_D && WS_GLA_D + 8 * 32 * 128 * 4 <= WS_END, "pool map");
constexpr int CW_BAR = 4096;

constexpr int RING_OFF = 0, RING_BYTES = 131072;
constexpr int LDSCTL_OFF = RING_BYTES, MISC_OFF = LDSCTL_OFF + 320;
constexpr int LDS_BYTES = 147456;
static_assert(MISC_OFF + 128 <= LDS_BYTES, "LDS map");

#define GAS __attribute__((address_space(1)))
#define LAS __attribute__((address_space(3)))
typedef unsigned short bf16;
typedef unsigned v4u __attribute__((ext_vector_type(4)));
typedef unsigned v2u __attribute__((ext_vector_type(2)));
typedef float f32x4 __attribute__((ext_vector_type(4)));
typedef GAS unsigned gu32;
#define RLX_AGENT __ATOMIC_RELAXED, __HIP_MEMORY_SCOPE_AGENT
#define LDS_WAIT() asm volatile("s_waitcnt lgkmcnt(0)" ::: "memory")
#define VM_WAIT() asm volatile("s_waitcnt vmcnt(0)" ::: "memory")
__device__ __forceinline__ unsigned f2bf(float f) { unsigned u = __builtin_bit_cast(unsigned, f); return (u + 0x7fffu + ((u >> 16) & 1u)) >> 16; }
__device__ __forceinline__ unsigned pk2(float lo, float hi) { return f2bf(lo) | (f2bf(hi) << 16); }
__device__ __forceinline__ float bf2f(bf16 v) { return __uint_as_float((unsigned)v << 16); }

#define XB_TMO      128
#define XB_XCNT(j)  (256  + 64 * (j))
#define XB_XSUB(j)  (1280 + 64 * (j))
#define XB_XGEN(j)  (2304 + 64 * (j))
#define XB_TOP      3328
#define XB_TOPGEN   3392
#define XCD_BAR_WORDS 3456
#define XB_SPIN_CAP (1u << 18)
__device__ __forceinline__ unsigned xb_ld(unsigned* p)              { return __hip_atomic_load(p, __ATOMIC_RELAXED, __HIP_MEMORY_SCOPE_AGENT); }
__device__ __forceinline__ unsigned xb_add(unsigned* p, unsigned v) { return __hip_atomic_fetch_add(p, v, __ATOMIC_RELAXED, __HIP_MEMORY_SCOPE_AGENT); }
__device__ __forceinline__ unsigned xb_xcc_id() { return (unsigned)__builtin_amdgcn_s_getreg((3 << 11) | 20) & 0xFu; }
#define XB_SPIN(cond, bar) do { unsigned _sp = 0; while (cond) { __builtin_amdgcn_s_sleep(1); \
    if ((++_sp & 255u) == 0u) { if (xb_ld(&(bar)[XB_TMO])) break; if (_sp > XB_SPIN_CAP) { atomicAdd(&(bar)[XB_TMO], 1u); break; } } } } while (0)
struct XcdBarrier { unsigned* bar; unsigned x; volatile LAS unsigned* st; };
__device__ __forceinline__ XcdBarrier xcd_barrier_post(unsigned* bar, volatile LAS unsigned* st) {
    XcdBarrier b; b.bar = bar; b.x = xb_xcc_id(); b.st = st;
    if (threadIdx.x == 0) (void)xb_add(&bar[XB_XCNT(b.x)], 1u);
    return b;
}
__device__ __forceinline__ void xcd_barrier_complete(unsigned* bar, unsigned x, unsigned& nloc, unsigned& nx) {
    const unsigned G = gridDim.x * gridDim.y * gridDim.z;
    unsigned sum, cnt, mine, sp = 0u;
    for (;;) {
        sum = 0u; cnt = 0u; mine = 0u;
#pragma unroll
        for (unsigned j = 0; j < 16; ++j) { const unsigned c = xb_ld(&bar[XB_XCNT(j)]); sum += c; cnt += (c > 0u) ? 1u : 0u; mine = (j == x) ? c : mine; }
        if (sum == G) break;
        __builtin_amdgcn_s_sleep(1);
        if ((++sp & 255u) == 0u) { if (xb_ld(&bar[XB_TMO])) break; if (sp > XB_SPIN_CAP) { atomicAdd(&bar[XB_TMO], 1u); break; } }
    }
    nloc = mine > 0u ? mine : 1u; nx = cnt > 0u ? cnt : 1u;
}
__device__ __forceinline__ void xcd_barrier(const XcdBarrier& b) {
    asm volatile("s_waitcnt vmcnt(0)" ::: "memory");
    __syncthreads();
    if (threadIdx.x == 0) {
        unsigned* bar = b.bar;
        __builtin_amdgcn_s_waitcnt(0);
        unsigned nloc = b.st[0], nx = b.st[1];
        if (nloc == 0u) { xcd_barrier_complete(bar, b.x, nloc, nx); b.st[0] = nloc; b.st[1] = nx; }
        const unsigned old = xb_add(&bar[XB_XSUB(b.x)], 1u);
        const unsigned gen = old / nloc;
        if (old + 1u == (gen + 1u) * nloc) {
            __builtin_amdgcn_fence(__ATOMIC_RELEASE, "agent");
            asm volatile("s_waitcnt vmcnt(0)" ::: "memory");
            const unsigned og = xb_add(&bar[XB_TOP], 1u);
            const unsigned tg = og / nx;
            if (og + 1u == (tg + 1u) * nx) xb_add(&bar[XB_TOPGEN], 1u);
            else XB_SPIN(xb_ld(&bar[XB_TOPGEN]) == tg, bar);
            __builtin_amdgcn_fence(__ATOMIC_ACQUIRE, "agent");
            xb_add(&bar[XB_XGEN(b.x)], 1u);
            asm volatile("s_waitcnt vmcnt(0)" ::: "memory");
        } else {
            XB_SPIN(xb_ld(&bar[XB_XGEN(b.x)]) == gen, bar);
            __builtin_amdgcn_fence(__ATOMIC_ACQUIRE, "agent");
            asm volatile("s_waitcnt vmcnt(0)" ::: "memory");
        }
    }
    __syncthreads();
}

struct Args { const float* in[30]; float* out; unsigned char* ws; int ph_lo, ph_hi; };
enum InIdx { I_X = 0, I_C, I_ADAW, I_ADAB, I_NMG, I_NFG, I_EVWIN, I_EVWOUT, I_LAMRE, I_LAMIM, I_BRE, I_BIM, I_CRE, I_CIM, I_S5D, I_LOGSTEP, I_WGLU, I_BGLU, I_LBLOG, I_HGNORM,
             I_ODWIN, I_ODWA1, I_ODWA2, I_ODBA, I_GLANORM, I_ODWOUT, I_W1, I_W3, I_W2, I_FNORM };
struct Frame {
    LAS unsigned char* lds;
    volatile LAS unsigned* MISC;
    gu32* ctl;
    int tid, lane, wave, vcu, G;
    const float* const* in; float* out; unsigned char* ws;
};
__device__ __forceinline__ float wave_sum(float v) {
#pragma unroll
    for (int o = 1; o < 64; o <<= 1) v += __shfl_xor(v, o);
    return v;
}
__device__ __forceinline__ float dsilu(float x) { return x / (1.0f + expf(-x)); }

__device__ __forceinline__ void tile_store(const LAS float* scr, bf16* dst  , int ldk, const float* sc  , int lane) {
    const int c = lane & 7;
    float s8[8];
#pragma unroll
    for (int j = 0; j < 8; ++j) s8[j] = sc ? sc[8 * c + j] : 1.0f;
#pragma unroll
    for (int j = 0; j < 4; ++j) { const int n = (lane >> 3) + 8 * j; const LAS float* s = scr + (8 * c) * 33 + n;
        v4u o; o.x = pk2(s[0 * 33] * s8[0], s[1 * 33] * s8[1]); o.y = pk2(s[2 * 33] * s8[2], s[3 * 33] * s8[3]); o.z = pk2(s[4 * 33] * s8[4], s[5 * 33] * s8[5]); o.w = pk2(s[6 * 33] * s8[6], s[7 * 33] * s8[7]);
        *(GAS v4u*)(dst + (size_t)n * ldk + 8 * c) = o; }
}
__device__ __forceinline__ void tile_load(const float* W  , int ldw, LAS float* scr, int lane) {
#pragma unroll 8
    for (int i = 0; i < 32; ++i) { const int kk = 2 * i + (lane >> 5); scr[kk * 33 + (lane & 31)] = W[(size_t)kk * ldw + (lane & 31)]; }
}
__device__ __forceinline__ void p_transpose_item(const float* W, int K, int N, bf16* WT, LAS float* scr, int item, int lane) {
    const int nblk = N / 32, kb = item / nblk, nb = item % nblk, k0 = 64 * kb, n0 = 32 * nb;
    tile_load(W + (size_t)k0 * N + n0, N, scr, lane);
    LDS_WAIT(); asm volatile("" ::: "memory");
    tile_store(scr, WT + (size_t)n0 * K + k0, K, nullptr, lane);
    LDS_WAIT(); asm volatile("" ::: "memory");
}

__device__ __forceinline__ void s5_constants(Frame& F, int g) {
    LAS float* PW = (LAS float*)(F.lds + RING_OFF);
    LAS float* BB = (LAS float*)(F.lds + RING_OFF + 17408);
    LAS float* CC = (LAS float*)(F.lds + RING_OFF + 25600);
    LAS float* KD = (LAS float*)(F.lds + RING_OFF + 33792);
    const float* lam_re = F.in[I_LAMRE] + g * 64; const float* lam_im = F.in[I_LAMIM] + g * 64;
    const float* b_re = F.in[I_BRE] + g * 1024; const float* b_im = F.in[I_BIM] + g * 1024;
    const float* c_re = F.in[I_CRE] + g * 1024; const float* c_im = F.in[I_CIM] + g * 1024;
    const double dl = exp((double)F.in[I_LOGSTEP][g]);
    for (int idx = F.tid; idx < 33 * 64; idx += NWAVES * 64) { const int d = idx >> 6, p = idx & 63;
        const double mag = exp((double)lam_re[p] * dl * d); double sn, cs; sincos((double)lam_im[p] * dl * d, &sn, &cs);
        PW[idx * 2] = (float)(mag * cs); PW[idx * 2 + 1] = (float)(mag * sn); }
    for (int idx = F.tid; idx < 1024; idx += NWAVES * 64) { const int p = idx >> 4;
        const double lr = lam_re[p], li = lam_im[p]; const double mag = exp(lr * dl); double sn, cs; sincos(li * dl, &sn, &cs);
        const double nr = mag * cs - 1.0, ni = mag * sn, den = lr * lr + li * li;
        const double qr = (nr * lr + ni * li) / den, qi = (ni * lr - nr * li) / den;
        const double br = b_re[idx], bi = b_im[idx];
        BB[idx * 2] = (float)(qr * br - qi * bi); BB[idx * 2 + 1] = (float)(qr * bi + qi * br);
        CC[idx * 2] = c_re[idx]; CC[idx * 2 + 1] = c_im[idx]; }
    __syncthreads();
    for (int idx = F.tid; idx < 32 * 256; idx += NWAVES * 64) { const int d = idx >> 8, ho = (idx >> 4) & 15, hi = idx & 15; float s = 0.f;
        for (int p = 0; p < 64; ++p) { const float cr = CC[(ho * 64 + p) * 2], ci = CC[(ho * 64 + p) * 2 + 1], pr = PW[(d * 64 + p) * 2], pi = PW[(d * 64 + p) * 2 + 1];
            const float xr = cr * pr - ci * pi, xi = cr * pi + ci * pr; s += xr * BB[(p * 16 + hi) * 2] - xi * BB[(p * 16 + hi) * 2 + 1]; }
        if (d == 0 && ho == hi) s += F.in[I_S5D][g * 16 + ho];
        KD[idx] = s; }
    __syncthreads();
    bf16* Tg = (bf16*)(F.ws + WS_S5T) + (size_t)g * 512 * UTP;
    for (int idx = F.tid; idx < 512 * 64; idx += NWAVES * 64) { const int n = idx >> 6, kc = idx & 63, l = n >> 4, ho = n & 15, j = kc >> 1, hi0 = (kc & 1) * 8;
        v4u o = (v4u){0u, 0u, 0u, 0u};
        if (j <= l) { const LAS float* k = KD + ((l - j) * 16 + ho) * 16 + hi0; o.x = pk2(k[0], k[1]); o.y = pk2(k[2], k[3]); o.z = pk2(k[4], k[5]); o.w = pk2(k[6], k[7]); }
        *(GAS v4u*)(Tg + (size_t)n * UTP + kc * 8) = o; }
    for (int idx = F.tid; idx < 512 * 16; idx += NWAVES * 64) { const int n = idx >> 4, pc = idx & 15, l = n >> 4, ho = n & 15, im = pc >> 3, p0 = (pc & 7) * 8; float v[8];
#pragma unroll
        for (int e = 0; e < 8; ++e) { const int p = p0 + e; const float cr = CC[(ho * 64 + p) * 2], ci = CC[(ho * 64 + p) * 2 + 1], pr = PW[((l + 1) * 64 + p) * 2], pi = PW[((l + 1) * 64 + p) * 2 + 1];
            v[e] = im ? -(cr * pi + ci * pr) : (cr * pr - ci * pi); }
        v4u o; o.x = pk2(v[0], v[1]); o.y = pk2(v[2], v[3]); o.z = pk2(v[4], v[5]); o.w = pk2(v[6], v[7]);
        *(GAS v4u*)(Tg + (size_t)n * UTP + 512 + pc * 8) = o; }
    bf16* Fg = (bf16*)(F.ws + WS_S5F) + (size_t)g * 256 * 512;
    for (int idx = F.tid; idx < 256 * 64; idx += NWAVES * 64) { const int r = idx >> 6, kc = idx & 63, j = kc >> 1, hi0 = (kc & 1) * 8;
        v4u o = (v4u){0u, 0u, 0u, 0u};
        if (r < 128) { const int p = r & 63, im = r >> 6; const float pr = PW[((LC - 1 - j) * 64 + p) * 2], pi = PW[((LC - 1 - j) * 64 + p) * 2 + 1]; float v[8];
#pragma unroll
            for (int e = 0; e < 8; ++e) { const float br = BB[(p * 16 + hi0 + e) * 2], bi = BB[(p * 16 + hi0 + e) * 2 + 1]; v[e] = im ? (pr * bi + pi * br) : (pr * br - pi * bi); }
            o.x = pk2(v[0], v[1]); o.y = pk2(v[2], v[3]); o.z = pk2(v[4], v[5]); o.w = pk2(v[6], v[7]); }
        *(GAS v4u*)(Fg + (size_t)r * 512 + kc * 8) = o; }
    if (F.tid < 64) { float* L = (float*)(F.ws + WS_S5LAM) + (g * 64 + F.tid) * 2; L[0] = PW[(LC * 64 + F.tid) * 2]; L[1] = PW[(LC * 64 + F.tid) * 2 + 1]; }
    __syncthreads();
}
template <class WF, class VF> __device__ __forceinline__ void gemv64(Frame& F, WF wf, VF vf, float& o0, float& o1) {
    LAS float* red = (LAS float*)(F.lds + RING_OFF);
    float a0 = 0.f, a1 = 0.f; const int kb = F.wave * 128;
#pragma unroll 8
    for (int k = 0; k < 128; ++k) { const float w = wf(kb + k); a0 += vf(0, kb + k) * w; a1 += vf(1, kb + k) * w; }
    red[(F.wave * 2 + 0) * 64 + F.lane] = a0; red[(F.wave * 2 + 1) * 64 + F.lane] = a1;
    __syncthreads();
    o0 = 0.f; o1 = 0.f;
    if (F.wave == 0) {
#pragma unroll
        for (int w = 0; w < 8; ++w) { o0 += red[(w * 2 + 0) * 64 + F.lane]; o1 += red[(w * 2 + 1) * 64 + F.lane]; } }
    __syncthreads();
}
__device__ __forceinline__ void p0_prologue_a(Frame& F) {
    if (F.vcu < 32) s5_constants(F, F.vcu);
    else if (F.vcu < 32 + 192) {
        const int task = F.vcu - 32, l = task / 96, n = (task % 96) * 64 + F.lane;
        const float* W = F.in[I_ADAW] + (size_t)l * 1024 * 6144 + n; const float* cc = F.in[I_C];
        float o0, o1;
        gemv64(F, [&](int k) { return W[(size_t)k * 6144]; }, [&](int b, int k) { return dsilu(cc[b * 1024 + k]); }, o0, o1);
        if (F.wave == 0) { const float bb = F.in[I_ADAB][l * 6144 + n]; float* mod = (float*)(F.ws + WS_MOD) + l * 2 * 6144; mod[n] = o0 + bb; mod[6144 + n] = o1 + bb; }
    }
    LAS float* scr = (LAS float*)(F.lds + RING_OFF + 4096 + F.wave * 12288);
    const int gw = F.vcu * NWAVES + F.wave, NGW = F.G * NWAVES;
    constexpr int I_O = (D / 64) * (D / 32), I_G = (512 / 64) * (512 / 32), I_2 = (FF / 64) * (D / 32);
    constexpr int NITEMS = 2 * I_O + I_G + 2 * I_2;
    for (int it = NGW - 1 - gw; it < NITEMS; it += NGW) {
        int r = it;
        if (r < I_O) { p_transpose_item(F.in[I_EVWOUT], D, D, (bf16*)(F.ws + WS_WOUT0), scr, r, F.lane); continue; } r -= I_O;
        if (r < I_O) { p_transpose_item(F.in[I_ODWOUT], D, D, (bf16*)(F.ws + WS_WOUT1), scr, r, F.lane); continue; } r -= I_O;
        if (r < I_G) { p_transpose_item(F.in[I_WGLU], 512, 512, (bf16*)(F.ws + WS_WGLU), scr, r, F.lane); continue; } r -= I_G;
        if (r < I_2) { p_transpose_item(F.in[I_W2], FF, D, (bf16*)(F.ws + WS_W2_0), scr, r, F.lane); continue; } r -= I_2;
        p_transpose_item(F.in[I_W2] + (size_t)FF * D, FF, D, (bf16*)(F.ws + WS_W2_1), scr, r, F.lane);
    }
    const float* x = F.in[I_X]; bf16* xb = (bf16*)(F.ws + WS_XB); float* rowsq = (float*)(F.ws + WS_ROWSQ);
    for (int m = NGW - 1 - gw; m < T; m += NGW) {
        const GAS f32x4* xr = (const GAS f32x4*)(x + (size_t)m * D) + F.lane; f32x4 v[4]; float s = 0.f;
#pragma unroll
        for (int j = 0; j < 4; ++j) { v[j] = xr[64 * j]; s += (v[j].x * v[j].x + v[j].y * v[j].y) + (v[j].z * v[j].z + v[j].w * v[j].w); }
        s = wave_sum(s);
        GAS unsigned long long* o8 = (GAS unsigned long long*)(xb + (size_t)m * D) + F.lane;
#pragma unroll
        for (int j = 0; j < 4; ++j) o8[64 * j] = (unsigned long long)pk2(v[j].x, v[j].y) | ((unsigned long long)pk2(v[j].z, v[j].w) << 32);
        if (F.lane < 16) rowsq[(size_t)m * 16 + F.lane] = F.lane == 0 ? s : 0.f;
    }
}

struct FusedSrc { const float* p; int ld; bool lowrank; int nlr; };
__device__ __forceinline__ FusedSrc fused_src(Frame& F, int mat, int R0) {
    FusedSrc s; s.lowrank = false; s.nlr = 0;
    if (mat == 0) { s.p = F.in[I_EVWIN] + R0; s.ld = N_IN0; }
    else if (mat == 2) { if (R0 < 3072) { s.p = F.in[I_ODWIN] + R0; s.ld = 3072; } else { s.p = nullptr; s.ld = 0; s.lowrank = true; s.nlr = R0 - 3072; } }
    else { const int l = mat >> 1, pn = R0 >> 8, half = (R0 >> 7) & 1, i0 = R0 & 127; s.p = (half ? F.in[I_W3] : F.in[I_W1]) + (size_t)l * D * FF + 128 * pn + i0; s.ld = FF; }
    return s;
}
__device__ __forceinline__ float lowrank_val(Frame& F, int k, int n) { const float* a1 = F.in[I_ODWA1] + k * 16; const float* a2 = F.in[I_ODWA2] + n; float s = 0.f;
#pragma unroll
    for (int r = 0; r < 16; ++r) s += a1[r] * a2[r * 512]; return s; }
__device__ __forceinline__ void p1_prologue_b(Frame& F) {
    const float* mod = (const float*)(F.ws + WS_MOD);
    for (int task = F.vcu; task < 272; task += F.G) {
        int mat, nb = task; if (nb < 40) mat = 0; else if ((nb -= 40) < 88) mat = 1; else if ((nb -= 88) < 56) mat = 2; else { nb -= 56; mat = 3; }
        const int l = mat >> 1, sh = (mat & 1) ? 3072 : 0, R = nb * 64 + F.lane; const FusedSrc s = fused_src(F, mat, nb * 64);
        float o0, o1;
        gemv64(F, [&](int k) { return s.lowrank ? lowrank_val(F, k, s.nlr + F.lane) : s.p[(size_t)k * s.ld + F.lane]; }, [&](int b, int k) { return mod[(l * 2 + b) * 6144 + sh + k]; }, o0, o1);
        if (F.wave == 0) { const int Ns[4] = {N_IN0, N_UP, N_IN1, N_UP}; const int offs[4] = {CV_IN0, CV_UP0, CV_IN1, CV_UP1};
            float* cv = (float*)(F.ws + WS_CV) + offs[mat]; cv[R] = o0; cv[Ns[mat] + R] = o1; }
    }
    LAS float* scr = (LAS float*)(F.lds + RING_OFF + 4096 + F.wave * 12288);
    LAS float* scl = scr + 64 * 33;
    const int gw = F.vcu * NWAVES + F.wave, NGW = F.G * NWAVES;
    constexpr int IT0 = 16 * (N_IN0 / 32), IT1 = 16 * (N_UP / 32), IT2 = 16 * (N_IN1 / 32);
    for (int it = NGW - 1 - gw; it < IT0 + 2 * IT1 + IT2; it += NGW) {
        int mat, r = it; if (r < IT0) mat = 0; else if ((r -= IT0) < IT1) mat = 1; else if ((r -= IT1) < IT2) mat = 2; else { r -= IT2; mat = 3; }
        const int Ns[4] = {N_IN0, N_UP, N_IN1, N_UP}; const size_t wso[4] = {WS_WIN0, WS_W13_0, WS_WIN1, WS_W13_1};
        const int N = Ns[mat], nblk = N / 32, kb = r / nblk, nb = r % nblk, k0 = 64 * kb, R0 = 32 * nb, l = mat >> 1;
        const FusedSrc s = fused_src(F, mat, R0);
        if (s.lowrank) {
#pragma unroll 4
            for (int i = 0; i < 32; ++i) { const int kk = 2 * i + (F.lane >> 5); scr[kk * 33 + (F.lane & 31)] = lowrank_val(F, k0 + kk, s.nlr + (F.lane & 31)); }
        } else tile_load(s.p + (size_t)k0 * s.ld, s.ld, scr, F.lane);
        { const int k = k0 + F.lane; const float gn = (mat & 1) ? F.in[I_NFG][l * 1024 + k] : F.in[I_NMG][l * 1024 + k]; const int so = (mat & 1) ? 4096 : 1024;
          scl[F.lane] = gn * (1.0f + mod[(l * 2 + 0) * 6144 + so + k]); scl[64 + F.lane] = gn * (1.0f + mod[(l * 2 + 1) * 6144 + so + k]); }
        LDS_WAIT(); asm volatile("" ::: "memory");
        bf16* dst = (bf16*)(F.ws + wso[mat]) + (size_t)R0 * D + k0;
        float sc0[8], sc1[8];
#pragma unroll
        for (int j = 0; j < 8; ++j) { sc0[j] = scl[8 * (F.lane & 7) + j]; sc1[j] = scl[64 + 8 * (F.lane & 7) + j]; }
        const int c = F.lane & 7;
#pragma unroll
        for (int j = 0; j < 4; ++j) { const int n = (F.lane >> 3) + 8 * j; const LAS float* sp = scr + (8 * c) * 33 + n;
            float v[8];
#pragma unroll
            for (int e = 0; e < 8; ++e) v[e] = sp[e * 33];
            v4u o; o.x = pk2(v[0] * sc0[0], v[1] * sc0[1]); o.y = pk2(v[2] * sc0[2], v[3] * sc0[3]); o.z = pk2(v[4] * sc0[4], v[5] * sc0[5]); o.w = pk2(v[6] * sc0[6], v[7] * sc0[7]);
            *(GAS v4u*)(dst + (size_t)n * D + 8 * c) = o;
            o.x = pk2(v[0] * sc1[0], v[1] * sc1[1]); o.y = pk2(v[2] * sc1[2], v[3] * sc1[3]); o.z = pk2(v[4] * sc1[4], v[5] * sc1[5]); o.w = pk2(v[6] * sc1[6], v[7] * sc1[7]);
            *(GAS v4u*)(dst + (size_t)N * D + (size_t)n * D + 8 * c) = o; }
        LDS_WAIT(); asm volatile("" ::: "memory");
    }
}

__device__ __forceinline__ void s5_carry(Frame& F) {
    for (int task = F.vcu; task < 64; task += F.G) {
        const int b = task >> 5, g = task & 31, p = F.tid & 63, seg = F.tid >> 6;
        const float* X = (const float*)(F.ws + WS_XLOC) + ((size_t)g * NCH + b * 512 + seg * 64) * 128 + p;
        const float* L = (const float*)(F.ws + WS_S5LAM) + (g * 64 + p) * 2; const float lr = L[0], li = L[1];
        float ar = 0.f, ai = 0.f;
#pragma unroll 8
        for (int c = 0; c < 64; ++c) { const float xr = X[(size_t)c * 128], xi = X[(size_t)c * 128 + 64]; const float nr = lr * ar - li * ai + xr, ni = lr * ai + li * ar + xi; ar = nr; ai = ni; }
        float sr = lr, si = li;
#pragma unroll
        for (int q = 0; q < 6; ++q) { const float nr = sr * sr - si * si, ni = 2.f * sr * si; sr = nr; si = ni; }
        LAS float* agg = (LAS float*)(F.lds + RING_OFF);
        agg[(seg * 64 + p) * 2] = ar; agg[(seg * 64 + p) * 2 + 1] = ai;
        __syncthreads();
        float cr = 0.f, ci = 0.f;
        for (int s = 0; s < seg; ++s) { const float xr = agg[(s * 64 + p) * 2], xi = agg[(s * 64 + p) * 2 + 1]; const float nr = sr * cr - si * ci + xr, ni = sr * ci + si * cr + xi; cr = nr; ci = ni; }
        bf16* U = (bf16*)(F.ws + WS_UT) + ((size_t)g * NCH + b * 512 + seg * 64) * UTP + 512 + p;
#pragma unroll 8
        for (int c = 0; c < 64; ++c) { U[(size_t)c * UTP] = (bf16)f2bf(cr); U[(size_t)c * UTP + 64] = (bf16)f2bf(ci);
            const float xr = X[(size_t)c * 128], xi = X[(size_t)c * 128 + 64]; const float nr = lr * cr - li * ci + xr, ni = lr * ci + li * cr + xi; cr = nr; ci = ni; }
        __syncthreads();
    }
}

__device__ __forceinline__ void final_norm(Frame& F) {
    const int gw = F.vcu * NWAVES + F.wave, NGW = F.G * NWAVES; const float* gn = F.in[I_FNORM];
    f32x4 gv[4];
#pragma unroll
    for (int j = 0; j < 4; ++j) gv[j] = ((const f32x4*)gn)[F.lane + 64 * j];
    for (int m = gw; m < T; m += NGW) {
        GAS f32x4* xr = (GAS f32x4*)(F.out + (size_t)m * D) + F.lane; f32x4 v[4]; float s = 0.f;
#pragma unroll
        for (int j = 0; j < 4; ++j) { v[j] = xr[64 * j]; s += (v[j].x * v[j].x + v[j].y * v[j].y) + (v[j].z * v[j].z + v[j].w * v[j].w); }
        const float rs = 1.0f / sqrtf(wave_sum(s) * (1.0f / D) + EPS);
#pragma unroll
        for (int j = 0; j < 4; ++j) xr[64 * j] = v[j] * rs * gv[j];
    }
}
namespace gl {
typedef short bf16x8 __attribute__((ext_vector_type(8)));
typedef short bf16x4 __attribute__((ext_vector_type(4)));
typedef float f32x16 __attribute__((ext_vector_type(16)));
constexpr int P136 = 272, P72 = 144;
constexpr int L_QE = 0, L_QI = 17408, L_KI = 34816, L_KLT = 52224, L_VT = 70656, L_P = 107520, L_TOT = 116736, L_DEC = 120832, L_END = 121344;
static_assert(L_END <= RING_BYTES, "mixer LDS map");
__device__ __forceinline__ bf16x8 frag16(LAS unsigned char* lds, int base, int pitch, int row, int col) { return *(const LAS bf16x8*)(lds + base + row * pitch + col * 2); }
__device__ __forceinline__ unsigned pkbf(float lo, float hi) { return pg8::cvt_pk_bf16(lo, hi); }

template <int DV, bool GLA, bool PASS2>
__device__ __forceinline__ void mix_unit(Frame& F, int bh, int seg, const bf16* ZR, int zp, int qoff, int koff, int goff, int ooff, const bf16* VT, int dvt,
                                         float* AGG, float* DSEG, bf16* OUT, int ldo, int ocol0, const float* ng, const float* lbl) {
    constexpr int NV = DV / 32, SW0 = (DV == 128) ? 4 : 0, OTP = DV + 4;
    static_assert(64 * OTP * 4 <= L_VT, "O tile overlays QE..KLT");
    LAS unsigned char* lds = F.lds + RING_OFF;
    const int w = F.wave, lane = F.lane, r = lane & 31, hh = lane >> 5, b = bh >> 2, h = bh & 3, tok0 = b * SEQ + seg * 512, c0 = 2 * lane;
    LAS float* TOT = (LAS float*)(lds + L_TOT); LAS float* DEC = (LAS float*)(lds + L_DEC);
    float lb[2] = {0.f, 0.f};
    if (!GLA) {
#pragma unroll
        for (int e = 0; e < 2; ++e) { const int c = h * 128 + c0 + e; const float l0 = lbl[c], l1 = lbl[512 + c], l2 = lbl[1024 + c], mx = fmaxf(l0, fmaxf(l1, l2)); const float e0 = __expf(l0 - mx), e1 = __expf(l1 - mx), e2 = __expf(l2 - mx); lb[e] = e0 / (e0 + e1 + e2); } }
    f32x16 S[4];
    const size_t aggbase = ((size_t)(bh * 32 + seg) * 128) * DV;
#pragma unroll
    for (int ct = 0; ct < 4; ++ct)
#pragma unroll
        for (int rr = 0; rr < 16; ++rr) S[ct][rr] = 0.f;
    if (PASS2 && w < NV) {
#pragma unroll
        for (int ct = 0; ct < 4; ++ct)
#pragma unroll
            for (int rr = 0; rr < 16; ++rr) S[ct][rr] = AGG[aggbase + (size_t)(32 * ct + (rr & 3) + 8 * (rr >> 2) + 4 * hh) * DV + 32 * w + r];
    }
    float lsum[2] = {0.f, 0.f};
    for (int ch = 0; ch < 8; ++ch) {
        const int t0 = tok0 + ch * 64;
        unsigned qv[8], kv[8], gv[8];
#pragma unroll
        for (int tt = 0; tt < 8; ++tt) { const bf16* zr = ZR + (size_t)(t0 + 8 * w + tt) * zp + h * 128 + c0;
            qv[tt] = PASS2 ? *(const unsigned*)(zr + qoff) : 0u; kv[tt] = *(const unsigned*)(zr + koff); gv[tt] = GLA ? *(const unsigned*)(zr + goff) : 0u; }
#pragma unroll
        for (int i = 0; i < DV * 8 / 512; ++i) { const int idx = F.tid + 512 * i, v = idx >> 3, jc = idx & 7;
            *(LAS v4u*)(lds + L_VT + v * P72 + jc * 16) = *(const v4u*)(VT + ((size_t)(t0 >> 6) * dvt + h * DV + v) * 64 + jc * 8); }
        float cl[8][2], qq[8][2], kk[8][2]; float run[2] = {0.f, 0.f};
#pragma unroll
        for (int tt = 0; tt < 8; ++tt)
#pragma unroll
            for (int e = 0; e < 2; ++e) {
                const float kf = e ? pg8::bf_hi(kv[tt]) : pg8::bf_lo(kv[tt]), qf = e ? pg8::bf_hi(qv[tt]) : pg8::bf_lo(qv[tt]); float lg;
                if (GLA) { lg = (e ? pg8::bf_hi(gv[tt]) : pg8::bf_lo(gv[tt])) * 0.0625f; kk[tt][e] = kf; qq[tt][e] = qf; }
                else { const float sg = pg8::fsigmoid(kf), fo = lb[e] + (1.f - lb[e]) * sg; lg = __logf(fo); kk[tt][e] = (1.f - lb[e]) * (1.f - sg); qq[tt][e] = pg8::fsilu(qf); }
                run[e] += lg; cl[tt][e] = run[e]; }
        TOT[w * 128 + c0] = run[0]; TOT[w * 128 + c0 + 1] = run[1];
        __syncthreads();
        float off[2] = {0.f, 0.f}, last[2] = {0.f, 0.f}, ref[2] = {0.f, 0.f};
#pragma unroll
        for (int ww = 0; ww < 8; ++ww) { const float t0_ = TOT[ww * 128 + c0], t1_ = TOT[ww * 128 + c0 + 1];
            if (ww < w) { off[0] += t0_; off[1] += t1_; } if (ww < 4) { ref[0] += t0_; ref[1] += t1_; } last[0] += t0_; last[1] += t1_; }
        float klv[2][8];
#pragma unroll
        for (int tt = 0; tt < 8; ++tt) { float qe[2], qi[2], ki[2];
#pragma unroll
            for (int e = 0; e < 2; ++e) { const float cum = off[e] + cl[tt][e]; klv[e][tt] = kk[tt][e] * __expf(last[e] - cum);
                if (PASS2) { qe[e] = qq[tt][e] * __expf(cum); qi[e] = qq[tt][e] * __expf(cum - ref[e]); ki[e] = kk[tt][e] * __expf(ref[e] - cum); } }
            if (PASS2) { const int o = (8 * w + tt) * P136 + c0 * 2;
                *(LAS unsigned*)(lds + L_QE + o) = pkbf(qe[0], qe[1]); *(LAS unsigned*)(lds + L_QI + o) = pkbf(qi[0], qi[1]); *(LAS unsigned*)(lds + L_KI + o) = pkbf(ki[0], ki[1]); } }
#pragma unroll
        for (int e = 0; e < 2; ++e) { v4u o; o.x = pkbf(klv[e][0], klv[e][1]); o.y = pkbf(klv[e][2], klv[e][3]); o.z = pkbf(klv[e][4], klv[e][5]); o.w = pkbf(klv[e][6], klv[e][7]);
            *(LAS v4u*)(lds + L_KLT + (c0 + e) * P72 + 16 * w) = o; }
        if (w == 0) { DEC[c0] = __expf(last[0]); DEC[c0 + 1] = __expf(last[1]); lsum[0] += last[0]; lsum[1] += last[1]; }
        __syncthreads();
        f32x16 O[2];
        if (PASS2) {
            if (w >= SW0 && w < SW0 + 3) {
                const int ti = w - SW0, jt = ti >> 1, it = (ti + 1) >> 1;
                f32x16 X;
#pragma unroll
                for (int rr = 0; rr < 16; ++rr) X[rr] = 0.f;
#pragma unroll
                for (int s = 0; s < 8; ++s) X = __builtin_amdgcn_mfma_f32_32x32x16_bf16(frag16(lds, L_KI, P136, 32 * jt + r, 16 * s + 8 * hh), frag16(lds, L_QI, P136, 32 * it + r, 16 * s + 8 * hh), X, 0, 0, 0);
#pragma unroll
                for (int g = 0; g < 4; ++g) { float x[4];
#pragma unroll
                    for (int e = 0; e < 4; ++e) { const int j = 32 * jt + 8 * g + 4 * hh + e, i = 32 * it + r; x[e] = (j <= i) ? X[4 * g + e] : 0.f; }
                    v2u o; o.x = pkbf(x[0], x[1]); o.y = pkbf(x[2], x[3]);
                    *(LAS v2u*)(lds + L_P + (32 * it + r) * P72 + (32 * jt + 8 * g + 4 * hh) * 2) = o; }
            }
            if (w < NV) {
#pragma unroll
                for (int it = 0; it < 2; ++it)
#pragma unroll
                    for (int rr = 0; rr < 16; ++rr) O[it][rr] = 0.f;
#pragma unroll
                for (int ct = 0; ct < 4; ++ct)
#pragma unroll
                    for (int s = 0; s < 2; ++s) {
                        union { bf16x8 v; unsigned u[4]; } Bs;
#pragma unroll
                        for (int p = 0; p < 4; ++p) Bs.u[p] = pkbf(S[ct][8 * s + 2 * p], S[ct][8 * s + 2 * p + 1]);
#pragma unroll
                        for (int it = 0; it < 2; ++it) { union { bf16x8 v; bf16x4 hlf[2]; } A; const int o = L_QE + (32 * it + r) * P136 + (32 * ct + 16 * s + 4 * hh) * 2;
                            A.hlf[0] = *(const LAS bf16x4*)(lds + o); A.hlf[1] = *(const LAS bf16x4*)(lds + o + 16);
                            O[it] = __builtin_amdgcn_mfma_f32_32x32x16_bf16(A.v, Bs.v, O[it], 0, 0, 0); } }
            }
            __syncthreads();
        }
        if (w < NV) {
            if (PASS2) {
#pragma unroll
                for (int it = 0; it < 2; ++it)
#pragma unroll
                    for (int jt = 0; jt <= it; ++jt)
#pragma unroll
                        for (int s = 0; s < 2; ++s)
                            O[it] = __builtin_amdgcn_mfma_f32_32x32x16_bf16(frag16(lds, L_P, P72, 32 * it + r, 32 * jt + 16 * s + 8 * hh), frag16(lds, L_VT, P72, 32 * w + r, 32 * jt + 16 * s + 8 * hh), O[it], 0, 0, 0);
            }
#pragma unroll
            for (int ct = 0; ct < 4; ++ct) {
#pragma unroll
                for (int g = 0; g < 4; ++g) { const f32x4 d4 = *(const LAS f32x4*)(DEC + 32 * ct + 8 * g + 4 * hh);
#pragma unroll
                    for (int e = 0; e < 4; ++e) S[ct][4 * g + e] *= d4[e]; }
#pragma unroll
                for (int sj = 0; sj < 4; ++sj)
                    S[ct] = __builtin_amdgcn_mfma_f32_32x32x16_bf16(frag16(lds, L_KLT, P72, 32 * ct + r, 16 * sj + 8 * hh), frag16(lds, L_VT, P72, 32 * w + r, 16 * sj + 8 * hh), S[ct], 0, 0, 0);
            }
        }
        __syncthreads();
        if (PASS2) {
            LAS float* OT = (LAS float*)lds;
            if (w < NV) {
#pragma unroll
                for (int it = 0; it < 2; ++it)
#pragma unroll
                    for (int rr = 0; rr < 16; ++rr) OT[(32 * it + (rr & 3) + 8 * (rr >> 2) + 4 * hh) * OTP + 32 * w + r] = O[it][rr];
            }
            __syncthreads();
            const int i = F.tid >> 3, sub = F.tid & 7; float ov[DV / 64][8]; float ss = 0.f;
#pragma unroll
            for (int q = 0; q < DV / 64; ++q) { const f32x4 a = *(const LAS f32x4*)(OT + i * OTP + sub * 8 + 64 * q), bq = *(const LAS f32x4*)(OT + i * OTP + sub * 8 + 64 * q + 4);
#pragma unroll
                for (int e = 0; e < 4; ++e) { ov[q][e] = a[e]; ov[q][4 + e] = bq[e]; ss += a[e] * a[e] + bq[e] * bq[e]; } }
            ss += __shfl_xor(ss, 1); ss += __shfl_xor(ss, 2); ss += __shfl_xor(ss, 4);
            const float rs = 1.0f / sqrtf(ss * (1.0f / DV) + EPS);
#pragma unroll
            for (int q = 0; q < DV / 64; ++q) { const int col = sub * 8 + 64 * q;
                const v4u gw = *(const v4u*)(ZR + (size_t)(t0 + i) * zp + ooff + h * DV + col); const f32x4 n0 = *(const f32x4*)(ng + col), n1 = *(const f32x4*)(ng + col + 4);
                const float g8[8] = {pg8::bf_lo(gw.x), pg8::bf_hi(gw.x), pg8::bf_lo(gw.y), pg8::bf_hi(gw.y), pg8::bf_lo(gw.z), pg8::bf_hi(gw.z), pg8::bf_lo(gw.w), pg8::bf_hi(gw.w)};
                float y[8];
#pragma unroll
                for (int e = 0; e < 8; ++e) y[e] = ov[q][e] * rs * (e < 4 ? n0[e] : n1[e - 4]) * pg8::fsilu(g8[e]);
                v4u o; o.x = pkbf(y[0], y[1]); o.y = pkbf(y[2], y[3]); o.z = pkbf(y[4], y[5]); o.w = pkbf(y[6], y[7]);
                *(v4u*)(OUT + (size_t)(t0 + i) * ldo + ocol0 + h * DV + col) = o; }
            __syncthreads();
        }
    }
    if (!PASS2) {
        if (w < NV) {
#pragma unroll
            for (int ct = 0; ct < 4; ++ct)
#pragma unroll
                for (int rr = 0; rr < 16; ++rr) AGG[aggbase + (size_t)(32 * ct + (rr & 3) + 8 * (rr >> 2) + 4 * hh) * DV + 32 * w + r] = S[ct][rr];
        }
        if (w == 0) { DSEG[(bh * 32 + seg) * 128 + c0] = __expf(lsum[0]); DSEG[(bh * 32 + seg) * 128 + c0 + 1] = __expf(lsum[1]); }
    }
}
template <int DV> __device__ __forceinline__ void mix_carry(Frame& F, float* AGG, const float* DSEG) {
    constexpr int PER = 128 * DV;
    for (int idx = F.vcu * (NWAVES * 64) + F.tid; idx < 8 * PER; idx += F.G * NWAVES * 64) {
        const int bh = idx / PER, rem = idx % PER, c = rem / DV; float a[32], d[32];
#pragma unroll
        for (int s = 0; s < 32; ++s) { a[s] = AGG[(size_t)(bh * 32 + s) * PER + rem]; d[s] = DSEG[(bh * 32 + s) * 128 + c]; }
        float cur = 0.f;
#pragma unroll
        for (int s = 0; s < 32; ++s) { AGG[(size_t)(bh * 32 + s) * PER + rem] = cur; cur = d[s] * cur + a[s]; }
    }
}
}
constexpr int N_PHASES = 18;
__global__ void __launch_bounds__(NWAVES * 64, 2) mk_fwd(Args args) {
    extern __shared__ __attribute__((aligned(16))) unsigned char lds[];
    Frame F;
    F.lds = (LAS unsigned char*)lds;
    F.MISC = (volatile LAS unsigned*)(F.lds + MISC_OFF);
    F.tid = threadIdx.x; F.lane = F.tid & 63; F.wave = __builtin_amdgcn_readfirstlane(F.tid >> 6);
    F.G = gridDim.x; { const int bx = blockIdx.x; F.vcu = (F.G % 8 == 0) ? (bx % 8) * (F.G / 8) + bx / 8 : bx; }
    F.in = args.in; F.out = args.out; F.ws = args.ws;
    F.ctl = (gu32*)(args.ws + WS_CTL);
    for (int u = F.tid; u < (LDS_BYTES - LDSCTL_OFF) / 4; u += NWAVES * 64) ((LAS unsigned*)(F.lds + LDSCTL_OFF))[u] = 0u;
    __syncthreads();
    const int lo = args.ph_lo, hi = args.ph_hi;
    XcdBarrier bar; bar.bar = (unsigned*)(F.ctl + CW_BAR); bar.x = 0; bar.st = nullptr;
    if (hi - lo > 1) bar = xcd_barrier_post((unsigned*)(F.ctl + CW_BAR), F.MISC + 8);
#define IN(k) (lo <= (k) && (k) < hi)
#define SEAM(k) do { if (IN(k) && IN((k) + 1)) xcd_barrier(bar); } while (0)
    unsigned char* ws = args.ws;
    float* rowsq = (float*)(ws + WS_ROWSQ); bf16* xb = (bf16*)(ws + WS_XB); const float* mod = (const float*)(ws + WS_MOD); const float* cv = (const float*)(ws + WS_CV);
    const int bid = (int)blockIdx.x;

    if (IN(0)) { p0_prologue_a(F); } SEAM(0);
    if (IN(1)) { p1_prologue_b(F); } SEAM(1);
    if (IN(2)) {
        pg8::Gemm g{xb, (const bf16*)(ws + WS_WIN0), D, D, D}; pg8::StaticOrder S; S.init(T, N_IN0, F.G, bid, 64, (size_t)N_IN0 * D * 2);
        pg8::EpiIn0 E{rowsq, cv + CV_IN0, (bf16*)(ws + WS_UT), (bf16*)(ws + WS_QFG), (bf16*)(ws + WS_VT0)};
        pg8::gemm_phase<pg8::EpiIn0, pg8::StaticOrder, true>(F.lds + RING_OFF, g, S, E);
    } SEAM(2);
    if (IN(3)) {
        for (int un = F.vcu; un < 256; un += F.G)
            gl::mix_unit<128, false, false>(F, un >> 5, un & 31, (const bf16*)(ws + WS_QFG), 1536, 0, 512, 0, 1024, (const bf16*)(ws + WS_VT0), 512, (float*)(ws + WS_HGA), (float*)(ws + WS_HGD), nullptr, 0, 0, nullptr, F.in[I_LBLOG]);
        __syncthreads();
        pg8::Gemm g{(const bf16*)(ws + WS_UT), (const bf16*)(ws + WS_S5F), UTP, 512, 512}; pg8::GroupOrder S; S.init(4, 1, S5G, F.G, F.vcu, (size_t)NCH * UTP * 2, (size_t)256 * 512 * 2);
        pg8::EpiS5X E{(float*)(ws + WS_XLOC)};
        pg8::gemm_phase<pg8::EpiS5X, pg8::GroupOrder, true>(F.lds + RING_OFF, g, S, E);
    } SEAM(3);
    if (IN(4)) { s5_carry(F); gl::mix_carry<128>(F, (float*)(ws + WS_HGA), (const float*)(ws + WS_HGD)); } SEAM(4);
    if (IN(5)) {
        for (int un = F.vcu; un < 256; un += F.G)
            gl::mix_unit<128, false, true>(F, un >> 5, un & 31, (const bf16*)(ws + WS_QFG), 1536, 0, 512, 0, 1024, (const bf16*)(ws + WS_VT0), 512, (float*)(ws + WS_HGA), (float*)(ws + WS_HGD), (bf16*)(ws + WS_MIXED), D, 512, F.in[I_HGNORM], F.in[I_LBLOG]);
        __syncthreads();
        pg8::Gemm g{(const bf16*)(ws + WS_UT), (const bf16*)(ws + WS_S5T), UTP, UTP, UTP}; pg8::GroupOrder S; S.init(4, 2, S5G, F.G, F.vcu, (size_t)NCH * UTP * 2, (size_t)512 * UTP * 2);
        pg8::EpiS5Y E{(bf16*)(ws + WS_YGELU)};
        pg8::gemm_phase<pg8::EpiS5Y, pg8::GroupOrder, true>(F.lds + RING_OFF, g, S, E);
    } SEAM(5);
    if (IN(6)) {
        pg8::Gemm g{(const bf16*)(ws + WS_YGELU), (const bf16*)(ws + WS_WGLU), 512, 512, 512}; pg8::StaticOrder S; S.init(T, 512, F.G, bid, 64, 0);
        pg8::EpiGlu E{(const bf16*)(ws + WS_YGELU), F.in[I_BGLU], (bf16*)(ws + WS_MIXED), D};
        pg8::gemm_phase<pg8::EpiGlu, pg8::StaticOrder, true>(F.lds + RING_OFF, g, S, E);
    } SEAM(6);
    if (IN(7)) {
        pg8::Gemm g{(const bf16*)(ws + WS_MIXED), (const bf16*)(ws + WS_WOUT0), D, D, D}; pg8::StaticOrder S; S.init(T, D, F.G, bid, 64, 0);
        pg8::EpiResid E{F.in[I_X], F.out, xb, rowsq, mod + 2048, 6144};
        pg8::gemm_phase<pg8::EpiResid, pg8::StaticOrder, true>(F.lds + RING_OFF, g, S, E);
    } SEAM(7);
    if (IN(8)) {
        pg8::Gemm g{xb, (const bf16*)(ws + WS_W13_0), D, D, D}; pg8::StaticOrder S; S.init(T, N_UP, F.G, bid, 64, (size_t)N_UP * D * 2);
        pg8::EpiFfnUp E{rowsq, cv + CV_UP0, (bf16*)(ws + WS_HID)};
        pg8::gemm_phase<pg8::EpiFfnUp, pg8::StaticOrder, true>(F.lds + RING_OFF, g, S, E);
    } SEAM(8);
    if (IN(9)) {
        pg8::Gemm g{(const bf16*)(ws + WS_HID), (const bf16*)(ws + WS_W2_0), FF, FF, FF}; pg8::StaticOrder S; S.init(T, D, F.G, bid, 64, 0);
        pg8::EpiResid E{F.out, F.out, xb, rowsq, mod + 5120, 6144};
        pg8::gemm_phase<pg8::EpiResid, pg8::StaticOrder, true>(F.lds + RING_OFF, g, S, E);
    } SEAM(9);
    if (IN(10)) {
        pg8::Gemm g{xb, (const bf16*)(ws + WS_WIN1), D, D, D}; pg8::StaticOrder S; S.init(T, N_IN1, F.G, bid, 64, (size_t)N_IN1 * D * 2);
        pg8::EpiIn1 E{rowsq, cv + CV_IN1, F.in[I_ODBA], (bf16*)(ws + WS_Z1), (bf16*)(ws + WS_VT1)};
        pg8::gemm_phase<pg8::EpiIn1, pg8::StaticOrder, true>(F.lds + RING_OFF, g, S, E);
    } SEAM(10);
    if (IN(11)) {
        for (int un = F.vcu; un < 256; un += F.G)
            gl::mix_unit<256, true, false>(F, un >> 5, un & 31, (const bf16*)(ws + WS_Z1), 2560, 0, 512, 2048, 1024, (const bf16*)(ws + WS_VT1), 1024, (float*)(ws + WS_GLA_A), (float*)(ws + WS_GLA_D), nullptr, 0, 0, nullptr, nullptr);
    } SEAM(11);
    if (IN(12)) { gl::mix_carry<256>(F, (float*)(ws + WS_GLA_A), (const float*)(ws + WS_GLA_D)); } SEAM(12);
    if (IN(13)) {
        for (int un = F.vcu; un < 256; un += F.G)
            gl::mix_unit<256, true, true>(F, un >> 5, un & 31, (const bf16*)(ws + WS_Z1), 2560, 0, 512, 2048, 1024, (const bf16*)(ws + WS_VT1), 1024, (float*)(ws + WS_GLA_A), (float*)(ws + WS_GLA_D), (bf16*)(ws + WS_MIXED2), D, 0, F.in[I_GLANORM], nullptr);
    } SEAM(13);
    if (IN(14)) {
        pg8::Gemm g{(const bf16*)(ws + WS_MIXED2), (const bf16*)(ws + WS_WOUT1), D, D, D}; pg8::StaticOrder S; S.init(T, D, F.G, bid, 64, 0);
        pg8::EpiResid E{F.out, F.out, xb, rowsq, mod + 2 * 6144 + 2048, 6144};
        pg8::gemm_phase<pg8::EpiResid, pg8::StaticOrder, true>(F.lds + RING_OFF, g, S, E);
    } SEAM(14);
    if (IN(15)) {
        pg8::Gemm g{xb, (const bf16*)(ws + WS_W13_1), D, D, D}; pg8::StaticOrder S; S.init(T, N_UP, F.G, bid, 64, (size_t)N_UP * D * 2);
        pg8::EpiFfnUp E{rowsq, cv + CV_UP1, (bf16*)(ws + WS_HID)};
        pg8::gemm_phase<pg8::EpiFfnUp, pg8::StaticOrder, true>(F.lds + RING_OFF, g, S, E);
    } SEAM(15);
    if (IN(16)) {
        pg8::Gemm g{(const bf16*)(ws + WS_HID), (const bf16*)(ws + WS_W2_1), FF, FF, FF}; pg8::StaticOrder S; S.init(T, D, F.G, bid, 64, 0);
        pg8::EpiResid E{F.out, F.out, xb, rowsq, mod + 2 * 6144 + 5120, 6144};
        pg8::gemm_phase<pg8::EpiResid, pg8::StaticOrder, true>(F.lds + RING_OFF, g, S, E);
    } SEAM(16);
    if (IN(17)) { final_norm(F); }
#undef IN
#undef SEAM
}


extern "C" void kernel_launch(void* const* d_in, const int* in_sizes, int n_in, void* d_out, int out_size, void* d_ws, size_t ws_size, hipStream_t stream) {
    static int grid = 0;
    if (grid == 0) {
        if (n_in != 30 || in_sizes[0] != T * D || out_size != T * D || ws_size < WS_END) { fprintf(stderr, "kernel_launch: unexpected shapes: n_in %d in0 %d out %d ws %zu (need %zu)\n", n_in, n_in > 0 ? in_sizes[0] : -1, out_size, ws_size, (size_t)WS_END); grid = -1; return; }
        int dev = 0, cus = 0, per_cu = 0;
        if (hipGetDevice(&dev) != hipSuccess || hipDeviceGetAttribute(&cus, hipDeviceAttributeMultiprocessorCount, dev) != hipSuccess) { fprintf(stderr, "kernel_launch: device query failed\n"); grid = -1; return; }
        if (hipFuncSetAttribute((const void*)mk_fwd, hipFuncAttributeMaxDynamicSharedMemorySize, LDS_BYTES) != hipSuccess) { fprintf(stderr, "kernel_launch: hipFuncSetAttribute failed\n"); grid = -1; return; }
        if (hipOccupancyMaxActiveBlocksPerMultiprocessor(&per_cu, (const void*)mk_fwd, NWAVES * 64, LDS_BYTES) != hipSuccess || per_cu < 1) { fprintf(stderr, "kernel_launch: occupancy query reports %d workgroups per CU; nothing launched\n", per_cu); (void)hipGetLastError(); grid = -1; return; }
        grid = cus;
    }
    if (grid < 0) return;
    (void)hipMemsetAsync((char*)d_ws + WS_CTL, 0, CTL_ZERO_BYTES, stream);
    Args a{};
    for (int i = 0; i < 30; ++i) a.in[i] = (const float*)d_in[i];
    a.out = (float*)d_out; a.ws = (unsigned char*)d_ws; a.ph_lo = 0; a.ph_hi = N_PHASES;
    hipLaunchKernelGGL(mk_fwd, dim3(grid), dim3(NWAVES * 64), LDS_BYTES, stream, a);
}
```

```cpp
#include <hip/hip_runtime.h>
#include <cstdio>
#include <cstdint>
#include <cmath>
namespace pg8 {
#define PG8_LAS __attribute__((address_space(3)))
typedef unsigned short bf16_t;
typedef short bf16x8 __attribute__((ext_vector_type(8)));
typedef float f32x4 __attribute__((ext_vector_type(4)));
typedef unsigned u32x4 __attribute__((ext_vector_type(4)));
typedef unsigned u32x2 __attribute__((ext_vector_type(2)));
constexpr int BM = 256, BK = 64, HALF = 128, HTB = HALF * BK * 2  , STAGE_BYTES = 8 * HTB, NXCD = 8, WGM = 8;

__host__ __device__ __forceinline__ int lds_byte(int r, int c) { const int st = (r >> 4) * 2 + (c >> 5), rr = r & 15, cc = c & 31, ob = rr * 64 + cc * 2; return st * 1024 + (ob ^ (((ob >> 9) & 1) << 5)); }
__host__ __device__ __forceinline__ void stage_rc(int b, int& R, int& C) { const int st = b / 1024, sb = b % 1024, swz = sb ^ (((sb >> 9) & 1) << 5); R = (st >> 1) * 16 + swz / 64; C = (st & 1) * 32 + (swz % 64) / 2; }
__host__ __device__ __forceinline__ int perm32(int rho) { const int n = rho >> 4, i = rho & 15; return 8 * (i >> 2) + 4 * n + (i & 3); }

struct Unit { int pm, pn, g; size_t aoff, boff; };
struct Gemm { const bf16_t* A; const bf16_t* Bt; int lda, ldb, K; };

struct StaticOrder {
    int nM, nN, nwg, G, c, pm_per_batch; size_t bstride;
    __device__ void init(int M, int N, int G_, int c_, int pmpb, size_t bs) { nM = M / BM; nN = N / BM; nwg = nM * nN; G = G_; c = c_; pm_per_batch = pmpb; bstride = bs; }
    __device__ bool next(int i, Unit& u) const {
        const long L = (long)i * G + c; if (L >= nwg) return false;
        int wgid = (int)L; { const int q = nwg / NXCD, r = nwg % NXCD, xcd = wgid % NXCD, off = wgid / NXCD; wgid = (xcd < r ? xcd * (q + 1) : r * (q + 1) + (xcd - r) * q) + off; }
        const int nig = WGM * nN, gid = wgid / nig, fm = gid * WGM, gsz = (nM - fm) < WGM ? (nM - fm) : WGM;
        u.pm = fm + ((wgid % nig) % gsz); u.pn = (wgid % nig) / gsz; u.g = u.pm / pm_per_batch; u.aoff = 0; u.boff = (size_t)u.g * bstride; return true;
    }
};
struct GroupOrder {
    int nM, nN, ngroups, G, c; size_t astride, bstride;
    __device__ void init(int nM_, int nN_, int ng, int G_, int c_, size_t as, size_t bs) { nM = nM_; nN = nN_; ngroups = ng; G = G_; c = c_; astride = as; bstride = bs; }
    __device__ bool next(int i, Unit& u) const {
        const long L = (long)i * G + c; if (L >= (long)ngroups * nM * nN) return false;
        const int g = (int)(L / (nM * nN)), r = (int)(L % (nM * nN)); u.g = g; u.pm = r / nN; u.pn = r % nN; u.aoff = (size_t)g * astride; u.boff = (size_t)g * bstride; return true;
    }
};

__device__ __forceinline__ unsigned cvt_pk_bf16(float lo, float hi) { unsigned r; asm volatile("v_cvt_pk_bf16_f32 %0, %1, %2" : "=v"(r) : "v"(lo), "v"(hi)); return r; }
__device__ __forceinline__ float bf_lo(unsigned w) { return __uint_as_float(w << 16); }
__device__ __forceinline__ float bf_hi(unsigned w) { return __uint_as_float(w & 0xffff0000u); }
__device__ __forceinline__ float fsigmoid(float x) { return __builtin_amdgcn_rcpf(1.0f + __expf(-x)); }
__device__ __forceinline__ float fsilu(float x) { return x * fsigmoid(x); }
__device__ __forceinline__ float fgelu_tanh(float y) { return y * fsigmoid(1.5957691216f * (y + 0.044715f * y * y * y)); }
__device__ __forceinline__ float flogsigmoid(float x) { return fminf(x, 0.f) - __logf(1.0f + __expf(-fabsf(x))); }
__device__ __forceinline__ float row_rstd(const float* rowsq, int row) {
    const f32x4* p = (const f32x4*)(rowsq + (size_t)row * 16); const f32x4 a = p[0], b = p[1], c = p[2], d = p[3];
    const float s = ((a[0] + a[1]) + (a[2] + a[3])) + ((b[0] + b[1]) + (b[2] + b[3])) + ((c[0] + c[1]) + (c[2] + c[3])) + ((d[0] + d[1]) + (d[2] + d[3]));
    return 1.0f / sqrtf(s * (1.0f / 1024.0f) + 1e-6f);
}


struct EpiIn0 {
    static constexpr bool PERM = true, AFTER_DRAIN = false;
    const float* rowsq; const float* cvec; bf16_t* Ut; bf16_t* QFG; bf16_t* VT;
    __device__ __forceinline__ void operator()(const f32x4 (&acc)[2][2][4][2], const Unit& u, int wr, int wc, int fr, int fq) const {
        f32x4 cv[2][2];
#pragma unroll
        for (int bj = 0; bj < 2; ++bj)
#pragma unroll
            for (int n = 0; n < 2; ++n) cv[bj][n] = *(const f32x4*)(cvec + u.g * 2560 + u.pn * BM + bj * HALF + wc * 32 + 8 * fq + 4 * n);
#pragma unroll
        for (int ai = 0; ai < 2; ++ai)
#pragma unroll
        for (int m = 0; m < 4; ++m) { const int row = u.pm * BM + ai * HALF + wr * 64 + m * 16 + fr;
            const float rs = row_rstd(rowsq, row);
#pragma unroll
            for (int bj = 0; bj < 2; ++bj) { const int c0 = u.pn * BM + bj * HALF + wc * 32 + 8 * fq;
                const f32x4 v0 = acc[ai][bj][m][0] * rs + cv[bj][0], v1 = acc[ai][bj][m][1] * rs + cv[bj][1];
                u32x4 w; w.x = cvt_pk_bf16(v0[0], v0[1]); w.y = cvt_pk_bf16(v0[2], v0[3]); w.z = cvt_pk_bf16(v1[0], v1[1]); w.w = cvt_pk_bf16(v1[2], v1[3]);
                if (u.pn == 6 || u.pn == 7) { bf16_t* d = VT + ((size_t)(row >> 6) * 512 + (c0 - 1536)) * 64 + (row & 63);
                    d[0] = (bf16_t)w.x; d[64] = (bf16_t)(w.x >> 16); d[128] = (bf16_t)w.y; d[192] = (bf16_t)(w.y >> 16); d[256] = (bf16_t)w.z; d[320] = (bf16_t)(w.z >> 16); d[384] = (bf16_t)w.w; d[448] = (bf16_t)(w.w >> 16); }
                else { bf16_t* dst = (u.pn < 2) ? Ut + ((size_t)((c0 >> 4) * 1024 + (row >> 5)) * 640 + (row & 31) * 16 + (c0 & 15)) : QFG + (size_t)row * 1536 + (u.pn < 6 ? c0 - 512 : c0 - 1024);
                    *(u32x4*)dst = w; } }
        }
    }
};
struct EpiS5X {
    static constexpr bool PERM = false, AFTER_DRAIN = false;
    float* Xloc;
    __device__ __forceinline__ void operator()(const f32x4 (&acc)[2][2][4][2], const Unit& u, int wr, int wc, int fr, int fq) const {
#pragma unroll
        for (int ai = 0; ai < 2; ++ai)
#pragma unroll
        for (int m = 0; m < 4; ++m) { const int row = u.pm * BM + ai * HALF + wr * 64 + m * 16 + fr;
#pragma unroll
            for (int n = 0; n < 2; ++n) *(f32x4*)(Xloc + ((size_t)u.g * 1024 + row) * 128 + wc * 32 + 16 * n + 4 * fq) = acc[ai][0][m][n];
        }
    }
};
struct EpiS5Y {
    static constexpr bool PERM = true, AFTER_DRAIN = false;
    bf16_t* Y;
    __device__ __forceinline__ void operator()(const f32x4 (&acc)[2][2][4][2], const Unit& u, int wr, int wc, int fr, int fq) const {
#pragma unroll
        for (int ai = 0; ai < 2; ++ai)
#pragma unroll
        for (int m = 0; m < 4; ++m) { const int row = u.pm * BM + ai * HALF + wr * 64 + m * 16 + fr;
#pragma unroll
            for (int bj = 0; bj < 2; ++bj) { const int c0 = u.pn * BM + bj * HALF + wc * 32 + 8 * fq;
                const f32x4 a0 = acc[ai][bj][m][0], a1 = acc[ai][bj][m][1];
                u32x4 w; w.x = cvt_pk_bf16(fgelu_tanh(a0[0]), fgelu_tanh(a0[1])); w.y = cvt_pk_bf16(fgelu_tanh(a0[2]), fgelu_tanh(a0[3]));
                w.z = cvt_pk_bf16(fgelu_tanh(a1[0]), fgelu_tanh(a1[1])); w.w = cvt_pk_bf16(fgelu_tanh(a1[2]), fgelu_tanh(a1[3]));
                *(u32x4*)(Y + ((size_t)row * 32 + (c0 >> 4)) * 512 + u.g * 16 + (c0 & 15)) = w; }
        }
    }
};
struct EpiGlu {
    static constexpr bool PERM = true, AFTER_DRAIN = false;
    const bf16_t* Y; const float* bias; bf16_t* O; int ldo;
    __device__ __forceinline__ void operator()(const f32x4 (&acc)[2][2][4][2], const Unit& u, int wr, int wc, int fr, int fq) const {
        f32x4 bv[2][2];
#pragma unroll
        for (int bj = 0; bj < 2; ++bj)
#pragma unroll
            for (int n = 0; n < 2; ++n) bv[bj][n] = *(const f32x4*)(bias + u.pn * BM + bj * HALF + wc * 32 + 8 * fq + 4 * n);
#pragma unroll
        for (int ai = 0; ai < 2; ++ai)
#pragma unroll
        for (int m = 0; m < 4; ++m) { const int row = u.pm * BM + ai * HALF + wr * 64 + m * 16 + fr;
#pragma unroll
            for (int bj = 0; bj < 2; ++bj) { const int c0 = u.pn * BM + bj * HALF + wc * 32 + 8 * fq;
                const u32x4 yw = *(const u32x4*)(Y + (size_t)row * 512 + c0);
                const f32x4 a0 = acc[ai][bj][m][0] + bv[bj][0], a1 = acc[ai][bj][m][1] + bv[bj][1];
                u32x4 w; w.x = cvt_pk_bf16(bf_lo(yw.x) * fsigmoid(a0[0]), bf_hi(yw.x) * fsigmoid(a0[1])); w.y = cvt_pk_bf16(bf_lo(yw.y) * fsigmoid(a0[2]), bf_hi(yw.y) * fsigmoid(a0[3]));
                w.z = cvt_pk_bf16(bf_lo(yw.z) * fsigmoid(a1[0]), bf_hi(yw.z) * fsigmoid(a1[1])); w.w = cvt_pk_bf16(bf_lo(yw.w) * fsigmoid(a1[2]), bf_hi(yw.w) * fsigmoid(a1[3]));
                *(u32x4*)(O + (size_t)row * ldo + c0) = w; }
        }
    }
};
struct EpiResid {
    static constexpr bool PERM = true, AFTER_DRAIN = false;
    const float* xold; float* xnew; bf16_t* xb; float* rowsq; const float* gate; int gstride;
    __device__ __forceinline__ void operator()(const f32x4 (&acc)[2][2][4][2], const Unit& u, int wr, int wc, int fr, int fq) const {
        f32x4 gv[2][2];
#pragma unroll
        for (int bj = 0; bj < 2; ++bj)
#pragma unroll
            for (int n = 0; n < 2; ++n) gv[bj][n] = *(const f32x4*)(gate + u.g * gstride + u.pn * BM + bj * HALF + wc * 32 + 8 * fq + 4 * n);
#pragma unroll
        for (int ai = 0; ai < 2; ++ai)
#pragma unroll
        for (int m = 0; m < 4; ++m) { const int row = u.pm * BM + ai * HALF + wr * 64 + m * 16 + fr;
            float sq = 0.f;
#pragma unroll
            for (int bj = 0; bj < 2; ++bj) { const size_t off = (size_t)row * 1024 + u.pn * BM + bj * HALF + wc * 32 + 8 * fq;
                const f32x4 x0 = *(const f32x4*)(xold + off), x1 = *(const f32x4*)(xold + off + 4);
                const f32x4 v0 = x0 + gv[bj][0] * acc[ai][bj][m][0], v1 = x1 + gv[bj][1] * acc[ai][bj][m][1];
                *(f32x4*)(xnew + off) = v0; *(f32x4*)(xnew + off + 4) = v1;
                sq += (v0[0] * v0[0] + v0[1] * v0[1]) + (v0[2] * v0[2] + v0[3] * v0[3]) + (v1[0] * v1[0] + v1[1] * v1[1]) + (v1[2] * v1[2] + v1[3] * v1[3]);
                u32x4 w; w.x = cvt_pk_bf16(v0[0], v0[1]); w.y = cvt_pk_bf16(v0[2], v0[3]); w.z = cvt_pk_bf16(v1[0], v1[1]); w.w = cvt_pk_bf16(v1[2], v1[3]);
                *(u32x4*)(xb + off) = w; }
            sq += __shfl_xor(sq, 16); sq += __shfl_xor(sq, 32);
            if (fq == 0) rowsq[(size_t)row * 16 + u.pn * 4 + wc] = sq;
        }
    }
};
struct EpiFfnUp {
    static constexpr bool PERM = true, AFTER_DRAIN = false;
    const float* rowsq; const float* cvec; bf16_t* H;
    __device__ __forceinline__ void operator()(const f32x4 (&acc)[2][2][4][2], const Unit& u, int wr, int wc, int fr, int fq) const {
        f32x4 cv[2][2];
#pragma unroll
        for (int bj = 0; bj < 2; ++bj)
#pragma unroll
            for (int n = 0; n < 2; ++n) cv[bj][n] = *(const f32x4*)(cvec + u.g * 5632 + u.pn * BM + bj * HALF + wc * 32 + 8 * fq + 4 * n);
#pragma unroll
        for (int ai = 0; ai < 2; ++ai)
#pragma unroll
        for (int m = 0; m < 4; ++m) { const int row = u.pm * BM + ai * HALF + wr * 64 + m * 16 + fr;
            const float rs = row_rstd(rowsq, row);
            const f32x4 a0 = acc[ai][0][m][0] * rs + cv[0][0], a1 = acc[ai][0][m][1] * rs + cv[0][1], b0 = acc[ai][1][m][0] * rs + cv[1][0], b1 = acc[ai][1][m][1] * rs + cv[1][1];
            u32x4 w; w.x = cvt_pk_bf16(fsilu(a0[0]) * b0[0], fsilu(a0[1]) * b0[1]); w.y = cvt_pk_bf16(fsilu(a0[2]) * b0[2], fsilu(a0[3]) * b0[3]);
            w.z = cvt_pk_bf16(fsilu(a1[0]) * b1[0], fsilu(a1[1]) * b1[1]); w.w = cvt_pk_bf16(fsilu(a1[2]) * b1[2], fsilu(a1[3]) * b1[3]);
            *(u32x4*)(H + (size_t)row * 2816 + u.pn * HALF + wc * 32 + 8 * fq) = w;
        }
    }
};
struct EpiIn1 {
    static constexpr bool PERM = true, AFTER_DRAIN = false;
    const float* rowsq; const float* cvec; const float* ba; bf16_t* Z; bf16_t* VT;
    __device__ __forceinline__ void operator()(const f32x4 (&acc)[2][2][4][2], const Unit& u, int wr, int wc, int fr, int fq) const {
        f32x4 cv[2][2];
#pragma unroll
        for (int bj = 0; bj < 2; ++bj)
#pragma unroll
            for (int n = 0; n < 2; ++n) { const int c = u.pn * BM + bj * HALF + wc * 32 + 8 * fq + 4 * n; cv[bj][n] = *(const f32x4*)(cvec + u.g * 3584 + c); if (u.pn >= 12) cv[bj][n] += *(const f32x4*)(ba + c - 3072); }
#pragma unroll
        for (int ai = 0; ai < 2; ++ai)
#pragma unroll
        for (int m = 0; m < 4; ++m) { const int row = u.pm * BM + ai * HALF + wr * 64 + m * 16 + fr;
            const float rs = row_rstd(rowsq, row);
#pragma unroll
            for (int bj = 0; bj < 2; ++bj) { const int c0 = u.pn * BM + bj * HALF + wc * 32 + 8 * fq;
                f32x4 v0 = acc[ai][bj][m][0] * rs + cv[bj][0], v1 = acc[ai][bj][m][1] * rs + cv[bj][1];
                if (u.pn < 2) { v0 = v0 * 0.08838834764831845f; v1 = v1 * 0.08838834764831845f; }
                if (u.pn >= 12) {
#pragma unroll
                    for (int e = 0; e < 4; ++e) { v0[e] = flogsigmoid(v0[e]); v1[e] = flogsigmoid(v1[e]); } }
                u32x4 w; w.x = cvt_pk_bf16(v0[0], v0[1]); w.y = cvt_pk_bf16(v0[2], v0[3]); w.z = cvt_pk_bf16(v1[0], v1[1]); w.w = cvt_pk_bf16(v1[2], v1[3]);
                if (u.pn >= 4 && u.pn < 8) { bf16_t* d = VT + ((size_t)(row >> 6) * 1024 + (c0 - 1024)) * 64 + (row & 63);
                    d[0] = (bf16_t)w.x; d[64] = (bf16_t)(w.x >> 16); d[128] = (bf16_t)w.y; d[192] = (bf16_t)(w.y >> 16); d[256] = (bf16_t)w.z; d[320] = (bf16_t)(w.z >> 16); d[384] = (bf16_t)w.w; d[448] = (bf16_t)(w.w >> 16); }
                else *(u32x4*)(Z + (size_t)row * 2560 + (u.pn < 4 ? c0 : c0 - 1024)) = w; }
        }
    }
};

template <class Epi, class Sched, bool ALIGN_EPI>
__device__ __forceinline__ void gemm_phase(PG8_LAS unsigned char* lds, const Gemm g, const Sched& S, const Epi& E) {
    const int tid = threadIdx.x, wid = __builtin_amdgcn_readfirstlane(tid >> 6), lane = tid & 63, wr = wid >> 2, wc = wid & 3, fr = lane & 15, fq = lane >> 4;
    const int K = g.K, nt = K / BK;
    unsigned voffA[2], voffB[2];
#pragma unroll
    for (int i = 0; i < 2; ++i) { int R, C; stage_rc(tid * 16 + i * 8192, R, C); const int Rb = Epi::PERM ? ((R & ~31) + perm32(R & 31)) : R;
        voffA[i] = (unsigned)(R * g.lda + C) * 2u; voffB[i] = (unsigned)(Rb * g.ldb + C) * 2u; }
    const size_t kstep = (size_t)(BK * 2);
    const size_t hstepA = (size_t)HALF * g.lda * 2, hstepB = (size_t)HALF * g.ldb * 2;
    const unsigned ldsw = (unsigned)wid * 1024u;
    const int aoff = lds_byte(wr * 64 + fr, fq * 8), boff = lds_byte(wc * 32 + fr, fq * 8);
#define PG8_SA(b, h) (((b) * 2 + (h)) * HTB)
#define PG8_SB(b, h) ((4 + (b) * 2 + (h)) * HTB)
#define PG8_STAGE(bufoff, gbase, voff) do { _Pragma("unroll") for (int _i = 0; _i < 2; ++_i) \
        __builtin_amdgcn_global_load_lds((const unsigned*)((const char*)(gbase) + (voff)[_i]), (PG8_LAS unsigned*)(lds + (bufoff) + ldsw + _i * 8192), 16, 0, 0); } while (0)
#define PG8_LDA(dst, b, h) do { _Pragma("unroll") for (int m = 0; m < 4; ++m) _Pragma("unroll") for (int k = 0; k < 2; ++k) dst[m][k] = *(const PG8_LAS bf16x8*)(lds + PG8_SA(b, h) + aoff + m * 2048 + k * 1024); } while (0)
#define PG8_LDB(dst, b, h) do { _Pragma("unroll") for (int n = 0; n < 2; ++n) _Pragma("unroll") for (int k = 0; k < 2; ++k) dst[n][k] = *(const PG8_LAS bf16x8*)(lds + PG8_SB(b, h) + boff + n * 2048 + k * 1024); } while (0)
#define PG8_MMA(ai, bj, At, Bt) do { __builtin_amdgcn_s_setprio(1); _Pragma("unroll") for (int m = 0; m < 4; ++m) _Pragma("unroll") for (int n = 0; n < 2; ++n) _Pragma("unroll") for (int k = 0; k < 2; ++k) \
        acc[ai][bj][m][n] = __builtin_amdgcn_mfma_f32_16x16x32_bf16(Bt[n][k], At[m][k], acc[ai][bj][m][n], 0, 0, 0); __builtin_amdgcn_s_setprio(0); } while (0)
#define PG8_WAIT_V(n) asm volatile("s_waitcnt vmcnt(" #n ")" ::: "memory")
#define PG8_WAIT_L(n) asm volatile("s_waitcnt lgkmcnt(" #n ")" ::: "memory")
#define PG8_BAR __builtin_amdgcn_s_barrier()
#define PG8_SCHED __builtin_amdgcn_sched_barrier(0)
    Unit cur, nxt; int ui = 0;
    if (!S.next(0, cur)) return;
    f32x4 acc[2][2][4][2];
#pragma unroll
    for (int a = 0; a < 2; ++a)
#pragma unroll
        for (int b = 0; b < 2; ++b)
#pragma unroll
            for (int m = 0; m < 4; ++m)
#pragma unroll
                for (int n = 0; n < 2; ++n) acc[a][b][m][n] = (f32x4){0.f, 0.f, 0.f, 0.f};
    bf16x8 At[4][2], B0[2][2], B1[2][2];
    const char* cA = (const char*)g.A + cur.aoff + (size_t)cur.pm * 2 * hstepA; const char* cB = (const char*)g.Bt + cur.boff + (size_t)cur.pn * 2 * hstepB;
    PG8_STAGE(PG8_SB(0, 0), cB, voffB); PG8_STAGE(PG8_SB(0, 1), cB + hstepB, voffB); PG8_STAGE(PG8_SA(0, 0), cA, voffA); PG8_STAGE(PG8_SA(0, 1), cA + hstepA, voffA);
    if (wr == 1) PG8_BAR;
    PG8_WAIT_V(2); PG8_BAR;
    PG8_STAGE(PG8_SB(1, 0), cB + kstep, voffB); PG8_STAGE(PG8_SA(1, 0), cA + kstep, voffA); PG8_STAGE(PG8_SB(1, 1), cB + hstepB + kstep, voffB);
    PG8_WAIT_V(6); PG8_BAR;
    for (;;) {
        const bool has_next = S.next(ui + 1, nxt);
        const char* nA = has_next ? (const char*)g.A + nxt.aoff + (size_t)nxt.pm * 2 * hstepA : cA; const char* nB = has_next ? (const char*)g.Bt + nxt.boff + (size_t)nxt.pn * 2 * hstepB : cB;
        for (int t = 0; t < nt; t += 2) {
            const bool last = (t == nt - 2);
            const char* a1 = cA + (size_t)(t + 1) * kstep;
            const char* a2 = last ? nA : cA + (size_t)(t + 2) * kstep; const char* b2 = last ? nB : cB + (size_t)(t + 2) * kstep;
            const char* a3 = a2 + kstep; const char* b3 = b2 + kstep;
            PG8_LDB(B0, 0, 0); PG8_LDB(B1, 0, 1); PG8_SCHED; PG8_LDA(At, 0, 0); PG8_STAGE(PG8_SA(1, 1), a1 + hstepA, voffA);
            PG8_WAIT_V(8); PG8_WAIT_L(0); PG8_BAR; PG8_MMA(0, 0, At, B0); PG8_MMA(0, 1, At, B1); PG8_BAR; PG8_SCHED;
            PG8_LDA(At, 0, 1); PG8_STAGE(PG8_SB(0, 0), b2, voffB); PG8_STAGE(PG8_SB(0, 1), b2 + hstepB, voffB); PG8_STAGE(PG8_SA(0, 0), a2, voffA);
            PG8_WAIT_V(8); PG8_WAIT_L(0); PG8_BAR; PG8_MMA(1, 0, At, B0); PG8_MMA(1, 1, At, B1); PG8_BAR; PG8_SCHED;
            PG8_LDB(B0, 1, 0); PG8_LDB(B1, 1, 1); PG8_SCHED; PG8_LDA(At, 1, 0); PG8_STAGE(PG8_SA(0, 1), a2 + hstepA, voffA);
            PG8_WAIT_V(8); PG8_WAIT_L(0); PG8_BAR; PG8_MMA(0, 0, At, B0); PG8_MMA(0, 1, At, B1); PG8_BAR; PG8_SCHED;
            PG8_LDA(At, 1, 1); PG8_STAGE(PG8_SB(1, 0), b3, voffB); PG8_STAGE(PG8_SB(1, 1), b3 + hstepB, voffB); PG8_STAGE(PG8_SA(1, 0), a3, voffA);
            PG8_WAIT_V(8); PG8_WAIT_L(0); PG8_BAR; PG8_MMA(1, 0, At, B0); PG8_MMA(1, 1, At, B1); PG8_BAR; PG8_SCHED;
        }
        if constexpr (ALIGN_EPI) { if (wr == 0) PG8_BAR; }
        E(acc, cur, wr, wc, fr, fq);
        if (!has_next) break;
#pragma unroll
        for (int a = 0; a < 2; ++a)
#pragma unroll
            for (int b = 0; b < 2; ++b)
#pragma unroll
                for (int m = 0; m < 4; ++m)
#pragma unroll
                    for (int n = 0; n < 2; ++n) acc[a][b][m][n] = (f32x4){0.f, 0.f, 0.f, 0.f};
        cur = nxt; cA = nA; cB = nB; ++ui;
        if constexpr (ALIGN_EPI) { if (wr == 1) PG8_BAR; }
    }
    PG8_WAIT_V(0);
    if constexpr (!ALIGN_EPI) { if (wr == 0) PG8_BAR; }
    PG8_BAR;
#undef PG8_SA
#undef PG8_SB
#undef PG8_STAGE
#undef PG8_LDA
#undef PG8_LDB
#undef PG8_MMA
#undef PG8_WAIT_V
#undef PG8_WAIT_L
#undef PG8_BAR
#undef PG8_SCHED
}
}
constexpr int NWAVES = 8;
constexpr int BATCH = 2, SEQ = 16384, D = 1024, T = BATCH * SEQ;
constexpr int FF = 2816, S5W = 512, S5G = 32, S5P = 64, LC = 32, NCH = T / LC  , UTP = LC * 16 + 128  ;
constexpr int N_IN0 = 2560, N_IN1 = 3584, N_UP = 5632;
constexpr float EPS = 1e-6f;
constexpr size_t MiB = 1u << 20;
constexpr size_t WS_CTL = 0, CTL_ZERO_BYTES = 1 * MiB;
constexpr size_t WS_MOD = 1 * MiB;
constexpr size_t WS_CV = 1 * MiB + 128 * 1024;
constexpr int CV_IN0 = 0, CV_UP0 = 2 * N_IN0, CV_IN1 = CV_UP0 + 2 * N_UP, CV_UP1 = CV_IN1 + 2 * N_IN1;
constexpr size_t WS_S5LAM = 1 * MiB + 512 * 1024;
constexpr size_t WS_WIN0 = 2 * MiB, WS_WOUT0 = 12 * MiB, WS_WGLU = 14 * MiB, WS_S5F = 15 * MiB, WS_S5T = 23 * MiB, WS_W13_0 = 43 * MiB, WS_W2_0 = 65 * MiB,
                 WS_WIN1 = 71 * MiB, WS_WOUT1 = 85 * MiB, WS_W13_1 = 87 * MiB, WS_W2_1 = 109 * MiB;
constexpr size_t WS_ROWSQ = 115 * MiB, WS_XB = 117 * MiB, WS_POOL = 181 * MiB, WS_END = 512 * MiB;
constexpr size_t WS_UT = WS_POOL, WS_QFG = 221 * MiB, WS_VT0 = 317 * MiB, WS_XLOC = 349 * MiB, WS_YGELU = 365 * MiB, WS_MIXED = 397 * MiB, WS_HGA = 461 * MiB, WS_HGD = 477 * MiB;
constexpr size_t WS_HID = WS_POOL;
constexpr size_t WS_Z1 = WS_POOL, WS_VT1 = 341 * MiB, WS_MIXED2 = 405 * MiB, WS_GLA_A = 469 * MiB, WS_GLA_D = 501 * MiB;
static_assert(WS_WIN0 + (size_t)2 * N_IN0 * D * 2 <= WS_WOUT0 && WS_S5F + (size_t)S5G * 256 * 512 * 2 <= WS_S5T && WS_S5T + (size_t)S5G * 512 * UTP * 2 <= WS_W13_0 && WS_W13_0 + (size_t)2 * N_UP * D * 2 <= WS_W2_0 &&
              WS_W2_0 + (size_t)D * FF * 2 <= WS_WIN1 && WS_WIN1 + (size_t)2 * N_IN1 * D * 2 <= WS_WOUT1 && WS_W13_1 + (size_t)2 * N_UP * D * 2 <= WS_W2_1 && WS_W2_1 + (size_t)D * FF * 2 <= WS_ROWSQ, "weights map");
static_assert(WS_UT + (size_t)S5G * NCH * UTP * 2 <= WS_QFG && WS_QFG + (size_t)T * 1536 * 2 <= WS_VT0 && WS_VT0 + (size_t)T * 512 * 2 <= WS_XLOC && WS_XLOC + (size_t)S5G * NCH * 128 * 4 <= WS_YGELU && WS_YGELU + (size_t)T * 512 * 2 <= WS_MIXED &&
              WS_MIXED + (size_t)T * D * 2 <= WS_HGA && WS_HGA + (size_t)8 * 32 * 128 * 128 * 4 <= WS_HGD && WS_HID + (size_t)T * FF * 2 <= WS_END && WS_Z1 + (size_t)T * 2560 * 2 <= WS_VT1 && WS_VT1 + (size_t)T * D * 2 <= WS_MIXED2 &&
              WS_MIXED2 + (size_t)T * D * 2 <= WS_GLA_A && WS_GLA_A + (size_t)8 * 32 * 128 * 256 * 4 <= WS_GLA_D && WS_GLA_D + 8 * 32 * 128 * 4 <= WS_END, "pool map");
constexpr int CW_BAR = 4096;

constexpr int RING_OFF = 0, RING_BYTES = 131072;
constexpr int LDSCTL_OFF = RING_BYTES, MISC_OFF = LDSCTL_OFF + 320;
constexpr int LDS_BYTES = 147456;
static_assert(MISC_OFF + 128 <= LDS_BYTES, "LDS map");

#define GAS __attribute__((address_space(1)))
#define LAS __attribute__((address_space(3)))
typedef unsigned short bf16;
typedef unsigned v4u __attribute__((ext_vector_type(4)));
typedef unsigned v2u __attribute__((ext_vector_type(2)));
typedef float f32x4 __attribute__((ext_vector_type(4)));
typedef GAS unsigned gu32;
#define RLX_AGENT __ATOMIC_RELAXED, __HIP_MEMORY_SCOPE_AGENT
#define LDS_WAIT() asm volatile("s_waitcnt lgkmcnt(0)" ::: "memory")
#define VM_WAIT() asm volatile("s_waitcnt vmcnt(0)" ::: "memory")
__device__ __forceinline__ unsigned f2bf(float f) { unsigned u = __builtin_bit_cast(unsigned, f); return (u + 0x7fffu + ((u >> 16) & 1u)) >> 16; }
__device__ __forceinline__ unsigned pk2(float lo, float hi) { return f2bf(lo) | (f2bf(hi) << 16); }
__device__ __forceinline__ float bf2f(bf16 v) { return __uint_as_float((unsigned)v << 16); }

#define XB_TMO      128
#define XB_XCNT(j)  (256  + 64 * (j))
#define XB_XSUB(j)  (1280 + 64 * (j))
#define XB_XGEN(j)  (2304 + 64 * (j))
#define XB_TOP      3328
#define XB_TOPGEN   3392
#define XCD_BAR_WORDS 3456
#define XB_SPIN_CAP (1u << 18)
__device__ __forceinline__ unsigned xb_ld(unsigned* p)              { return __hip_atomic_load(p, __ATOMIC_RELAXED, __HIP_MEMORY_SCOPE_AGENT); }
__device__ __forceinline__ unsigned xb_add(unsigned* p, unsigned v) { return __hip_atomic_fetch_add(p, v, __ATOMIC_RELAXED, __HIP_MEMORY_SCOPE_AGENT); }
__device__ __forceinline__ unsigned xb_xcc_id() { return (unsigned)__builtin_amdgcn_s_getreg((3 << 11) | 20) & 0xFu; }
#define XB_SPIN(cond, bar) do { unsigned _sp = 0; while (cond) { __builtin_amdgcn_s_sleep(1); \
    if ((++_sp & 255u) == 0u) { if (xb_ld(&(bar)[XB_TMO])) break; if (_sp > XB_SPIN_CAP) { atomicAdd(&(bar)[XB_TMO], 1u); break; } } } } while (0)
struct XcdBarrier { unsigned* bar; unsigned x; volatile LAS unsigned* st; };
__device__ __forceinline__ XcdBarrier xcd_barrier_post(unsigned* bar, volatile LAS unsigned* st) {
    XcdBarrier b; b.bar = bar; b.x = xb_xcc_id(); b.st = st;
    if (threadIdx.x == 0) (void)xb_add(&bar[XB_XCNT(b.x)], 1u);
    return b;
}
__device__ __forceinline__ void xcd_barrier_complete(unsigned* bar, unsigned x, unsigned& nloc, unsigned& nx) {
    const unsigned G = gridDim.x * gridDim.y * gridDim.z;
    unsigned sum, cnt, mine, sp = 0u;
    for (;;) {
        sum = 0u; cnt = 0u; mine = 0u;
#pragma unroll
        for (unsigned j = 0; j < 16; ++j) { const unsigned c = xb_ld(&bar[XB_XCNT(j)]); sum += c; cnt += (c > 0u) ? 1u : 0u; mine = (j == x) ? c : mine; }
        if (sum == G) break;
        __builtin_amdgcn_s_sleep(1);
        if ((++sp & 255u) == 0u) { if (xb_ld(&bar[XB_TMO])) break; if (sp > XB_SPIN_CAP) { atomicAdd(&bar[XB_TMO], 1u); break; } }
    }
    nloc = mine > 0u ? mine : 1u; nx = cnt > 0u ? cnt : 1u;
}
__device__ __forceinline__ void xcd_barrier(const XcdBarrier& b) {
    asm volatile("s_waitcnt vmcnt(0)" ::: "memory");
    __syncthreads();
    if (threadIdx.x == 0) {
        unsigned* bar = b.bar;
        __builtin_amdgcn_s_waitcnt(0);
        unsigned nloc = b.st[0], nx = b.st[1];
        if (nloc == 0u) { xcd_barrier_complete(bar, b.x, nloc, nx); b.st[0] = nloc; b.st[1] = nx; }
        const unsigned old = xb_add(&bar[XB_XSUB(b.x)], 1u);
        const unsigned gen = old / nloc;
        if (old + 1u == (gen + 1u) * nloc) {
            __builtin_amdgcn_fence(__ATOMIC_RELEASE, "agent");
            asm volatile("s_waitcnt vmcnt(0)" ::: "memory");
            const unsigned og = xb_add(&bar[XB_TOP], 1u);
            const unsigned tg = og / nx;
            if (og + 1u == (tg + 1u) * nx) xb_add(&bar[XB_TOPGEN], 1u);
            else XB_SPIN(xb_ld(&bar[XB_TOPGEN]) == tg, bar);
            __builtin_amdgcn_fence(__ATOMIC_ACQUIRE, "agent");
            xb_add(&bar[XB_XGEN(b.x)], 1u);
            asm volatile("s_waitcnt vmcnt(0)" ::: "memory");
        } else {
            XB_SPIN(xb_ld(&bar[XB_XGEN(b.x)]) == gen, bar);
            __builtin_amdgcn_fence(__ATOMIC_ACQUIRE, "agent");
            asm volatile("s_waitcnt vmcnt(0)" ::: "memory");
        }
    }
    __syncthreads();
}

struct Args { const float* in[30]; float* out; unsigned char* ws; int ph_lo, ph_hi; };
enum InIdx { I_X = 0, I_C, I_ADAW, I_ADAB, I_NMG, I_NFG, I_EVWIN, I_EVWOUT, I_LAMRE, I_LAMIM, I_BRE, I_BIM, I_CRE, I_CIM, I_S5D, I_LOGSTEP, I_WGLU, I_BGLU, I_LBLOG, I_HGNORM,
             I_ODWIN, I_ODWA1, I_ODWA2, I_ODBA, I_GLANORM, I_ODWOUT, I_W1, I_W3, I_W2, I_FNORM };
struct Frame {
    LAS unsigned char* lds;
    volatile LAS unsigned* MISC;
    gu32* ctl;
    int tid, lane, wave, vcu, G;
    const float* const* in; float* out; unsigned char* ws;
};
__device__ __forceinline__ float wave_sum(float v) {
#pragma unroll
    for (int o = 1; o < 64; o <<= 1) v += __shfl_xor(v, o);
    return v;
}
__device__ __forceinline__ float dsilu(float x) { return x / (1.0f + expf(-x)); }

__device__ __forceinline__ void tile_store(const LAS float* scr, bf16* dst  , int ldk, const float* sc  , int lane) {
    const int c = lane & 7;
    float s8[8];
#pragma unroll
    for (int j = 0; j < 8; ++j) s8[j] = sc ? sc[8 * c + j] : 1.0f;
#pragma unroll
    for (int j = 0; j < 4; ++j) { const int n = (lane >> 3) + 8 * j; const LAS float* s = scr + (8 * c) * 33 + n;
        v4u o; o.x = pk2(s[0 * 33] * s8[0], s[1 * 33] * s8[1]); o.y = pk2(s[2 * 33] * s8[2], s[3 * 33] * s8[3]); o.z = pk2(s[4 * 33] * s8[4], s[5 * 33] * s8[5]); o.w = pk2(s[6 * 33] * s8[6], s[7 * 33] * s8[7]);
        *(GAS v4u*)(dst + (size_t)n * ldk + 8 * c) = o; }
}
__device__ __forceinline__ void tile_load(const float* W  , int ldw, LAS float* scr, int lane) {
#pragma unroll 8
    for (int i = 0; i < 32; ++i) { const int kk = 2 * i + (lane >> 5); scr[kk * 33 + (lane & 31)] = W[(size_t)kk * ldw + (lane & 31)]; }
}
__device__ __forceinline__ void p_transpose_item(const float* W, int K, int N, bf16* WT, LAS float* scr, int item, int lane) {
    const int nblk = N / 32, kb = item / nblk, nb = item % nblk, k0 = 64 * kb, n0 = 32 * nb;
    tile_load(W + (size_t)k0 * N + n0, N, scr, lane);
    LDS_WAIT(); asm volatile("" ::: "memory");
    tile_store(scr, WT + (size_t)n0 * K + k0, K, nullptr, lane);
    LDS_WAIT(); asm volatile("" ::: "memory");
}

__device__ __forceinline__ void s5_constants(Frame& F, int g) {
    LAS float* PW = (LAS float*)(F.lds + RING_OFF);
    LAS float* BB = (LAS float*)(F.lds + RING_OFF + 17408);
    LAS float* CC = (LAS float*)(F.lds + RING_OFF + 25600);
    LAS float* KD = (LAS float*)(F.lds + RING_OFF + 33792);
    const float* lam_re = F.in[I_LAMRE] + g * 64; const float* lam_im = F.in[I_LAMIM] + g * 64;
    const float* b_re = F.in[I_BRE] + g * 1024; const float* b_im = F.in[I_BIM] + g * 1024;
    const float* c_re = F.in[I_CRE] + g * 1024; const float* c_im = F.in[I_CIM] + g * 1024;
    const double dl = exp((double)F.in[I_LOGSTEP][g]);
    for (int idx = F.tid; idx < 33 * 64; idx += NWAVES * 64) { const int d = idx >> 6, p = idx & 63;
        const double mag = exp((double)lam_re[p] * dl * d); double sn, cs; sincos((double)lam_im[p] * dl * d, &sn, &cs);
        PW[idx * 2] = (float)(mag * cs); PW[idx * 2 + 1] = (float)(mag * sn); }
    for (int idx = F.tid; idx < 1024; idx += NWAVES * 64) { const int p = idx >> 4;
        const double lr = lam_re[p], li = lam_im[p]; const double mag = exp(lr * dl); double sn, cs; sincos(li * dl, &sn, &cs);
        const double nr = mag * cs - 1.0, ni = mag * sn, den = lr * lr + li * li;
        const double qr = (nr * lr + ni * li) / den, qi = (ni * lr - nr * li) / den;
        const double br = b_re[idx], bi = b_im[idx];
        BB[idx * 2] = (float)(qr * br - qi * bi); BB[idx * 2 + 1] = (float)(qr * bi + qi * br);
        CC[idx * 2] = c_re[idx]; CC[idx * 2 + 1] = c_im[idx]; }
    __syncthreads();
    for (int idx = F.tid; idx < 32 * 256; idx += NWAVES * 64) { const int d = idx >> 8, ho = (idx >> 4) & 15, hi = idx & 15; float s = 0.f;
        for (int p = 0; p < 64; ++p) { const float cr = CC[(ho * 64 + p) * 2], ci = CC[(ho * 64 + p) * 2 + 1], pr = PW[(d * 64 + p) * 2], pi = PW[(d * 64 + p) * 2 + 1];
            const float xr = cr * pr - ci * pi, xi = cr * pi + ci * pr; s += xr * BB[(p * 16 + hi) * 2] - xi * BB[(p * 16 + hi) * 2 + 1]; }
        if (d == 0 && ho == hi) s += F.in[I_S5D][g * 16 + ho];
        KD[idx] = s; }
    __syncthreads();
    bf16* Tg = (bf16*)(F.ws + WS_S5T) + (size_t)g * 512 * UTP;
    for (int idx = F.tid; idx < 512 * 64; idx += NWAVES * 64) { const int n = idx >> 6, kc = idx & 63, l = n >> 4, ho = n & 15, j = kc >> 1, hi0 = (kc & 1) * 8;
        v4u o = (v4u){0u, 0u, 0u, 0u};
        if (j <= l) { const LAS float* k = KD + ((l - j) * 16 + ho) * 16 + hi0; o.x = pk2(k[0], k[1]); o.y = pk2(k[2], k[3]); o.z = pk2(k[4], k[5]); o.w = pk2(k[6], k[7]); }
        *(GAS v4u*)(Tg + (size_t)n * UTP + kc * 8) = o; }
    for (int idx = F.tid; idx < 512 * 16; idx += NWAVES * 64) { const int n = idx >> 4, pc = idx & 15, l = n >> 4, ho = n & 15, im = pc >> 3, p0 = (pc & 7) * 8; float v[8];
#pragma unroll
        for (int e = 0; e < 8; ++e) { const int p = p0 + e; const float cr = CC[(ho * 64 + p) * 2], ci = CC[(ho * 64 + p) * 2 + 1], pr = PW[((l + 1) * 64 + p) * 2], pi = PW[((l + 1) * 64 + p) * 2 + 1];
            v[e] = im ? -(cr * pi + ci * pr) : (cr * pr - ci * pi); }
        v4u o; o.x = pk2(v[0], v[1]); o.y = pk2(v[2], v[3]); o.z = pk2(v[4], v[5]); o.w = pk2(v[6], v[7]);
        *(GAS v4u*)(Tg + (size_t)n * UTP + 512 + pc * 8) = o; }
    bf16* Fg = (bf16*)(F.ws + WS_S5F) + (size_t)g * 256 * 512;
    for (int idx = F.tid; idx < 256 * 64; idx += NWAVES * 64) { const int r = idx >> 6, kc = idx & 63, j = kc >> 1, hi0 = (kc & 1) * 8;
        v4u o = (v4u){0u, 0u, 0u, 0u};
        if (r < 128) { const int p = r & 63, im = r >> 6; const float pr = PW[((LC - 1 - j) * 64 + p) * 2], pi = PW[((LC - 1 - j) * 64 + p) * 2 + 1]; float v[8];
#pragma unroll
            for (int e = 0; e < 8; ++e) { const float br = BB[(p * 16 + hi0 + e) * 2], bi = BB[(p * 16 + hi0 + e) * 2 + 1]; v[e] = im ? (pr * bi + pi * br) : (pr * br - pi * bi); }
            o.x = pk2(v[0], v[1]); o.y = pk2(v[2], v[3]); o.z = pk2(v[4], v[5]); o.w = pk2(v[6], v[7]); }
        *(GAS v4u*)(Fg + (size_t)r * 512 + kc * 8) = o; }
    if (F.tid < 64) { float* L = (float*)(F.ws + WS_S5LAM) + (g * 64 + F.tid) * 2; L[0] = PW[(LC * 64 + F.tid) * 2]; L[1] = PW[(LC * 64 + F.tid) * 2 + 1]; }
    __syncthreads();
}
template <class WF, class VF> __device__ __forceinline__ void gemv64(Frame& F, WF wf, VF vf, float& o0, float& o1) {
    LAS float* red = (LAS float*)(F.lds + RING_OFF);
    float a0 = 0.f, a1 = 0.f; const int kb = F.wave * 128;
#pragma unroll 8
    for (int k = 0; k < 128; ++k) { const float w = wf(kb + k); a0 += vf(0, kb + k) * w; a1 += vf(1, kb + k) * w; }
    red[(F.wave * 2 + 0) * 64 + F.lane] = a0; red[(F.wave * 2 + 1) * 64 + F.lane] = a1;
    __syncthreads();
    o0 = 0.f; o1 = 0.f;
    if (F.wave == 0) {
#pragma unroll
        for (int w = 0; w < 8; ++w) { o0 += red[(w * 2 + 0) * 64 + F.lane]; o1 += red[(w * 2 + 1) * 64 + F.lane]; } }
    __syncthreads();
}
__device__ __forceinline__ void p0_prologue_a(Frame& F) {
    if (F.vcu < 32) s5_constants(F, F.vcu);
    else if (F.vcu < 32 + 192) {
        const int task = F.vcu - 32, l = task / 96, n = (task % 96) * 64 + F.lane;
        const float* W = F.in[I_ADAW] + (size_t)l * 1024 * 6144 + n; const float* cc = F.in[I_C];
        float o0, o1;
        gemv64(F, [&](int k) { return W[(size_t)k * 6144]; }, [&](int b, int k) { return dsilu(cc[b * 1024 + k]); }, o0, o1);
        if (F.wave == 0) { const float bb = F.in[I_ADAB][l * 6144 + n]; float* mod = (float*)(F.ws + WS_MOD) + l * 2 * 6144; mod[n] = o0 + bb; mod[6144 + n] = o1 + bb; }
    }
    LAS float* scr = (LAS float*)(F.lds + RING_OFF + 4096 + F.wave * 12288);
    const int gw = F.vcu * NWAVES + F.wave, NGW = F.G * NWAVES;
    constexpr int I_O = (D / 64) * (D / 32), I_G = (512 / 64) * (512 / 32), I_2 = (FF / 64) * (D / 32);
    constexpr int NITEMS = 2 * I_O + I_G + 2 * I_2;
    for (int it = NGW - 1 - gw; it < NITEMS; it += NGW) {
        int r = it;
        if (r < I_O) { p_transpose_item(F.in[I_EVWOUT], D, D, (bf16*)(F.ws + WS_WOUT0), scr, r, F.lane); continue; } r -= I_O;
        if (r < I_O) { p_transpose_item(F.in[I_ODWOUT], D, D, (bf16*)(F.ws + WS_WOUT1), scr, r, F.lane); continue; } r -= I_O;
        if (r < I_G) { p_transpose_item(F.in[I_WGLU], 512, 512, (bf16*)(F.ws + WS_WGLU), scr, r, F.lane); continue; } r -= I_G;
        if (r < I_2) { p_transpose_item(F.in[I_W2], FF, D, (bf16*)(F.ws + WS_W2_0), scr, r, F.lane); continue; } r -= I_2;
        p_transpose_item(F.in[I_W2] + (size_t)FF * D, FF, D, (bf16*)(F.ws + WS_W2_1), scr, r, F.lane);
    }
    const float* x = F.in[I_X]; bf16* xb = (bf16*)(F.ws + WS_XB); float* rowsq = (float*)(F.ws + WS_ROWSQ);
    for (int m = NGW - 1 - gw; m < T; m += NGW) {
        const GAS f32x4* xr = (const GAS f32x4*)(x + (size_t)m * D) + F.lane; f32x4 v[4]; float s = 0.f;
#pragma unroll
        for (int j = 0; j < 4; ++j) { v[j] = xr[64 * j]; s += (v[j].x * v[j].x + v[j].y * v[j].y) + (v[j].z * v[j].z + v[j].w * v[j].w); }
        s = wave_sum(s);
        GAS unsigned long long* o8 = (GAS unsigned long long*)(xb + (size_t)m * D) + F.lane;
#pragma unroll
        for (int j = 0; j < 4; ++j) o8[64 * j] = (unsigned long long)pk2(v[j].x, v[j].y) | ((unsigned long long)pk2(v[j].z, v[j].w) << 32);
        if (F.lane < 16) rowsq[(size_t)m * 16 + F.lane] = F.lane == 0 ? s : 0.f;
    }
}

struct FusedSrc { const float* p; int ld; bool lowrank; int nlr; };
__device__ __forceinline__ FusedSrc fused_src(Frame& F, int mat, int R0) {
    FusedSrc s; s.lowrank = false; s.nlr = 0;
    if (mat == 0) { s.p = F.in[I_EVWIN] + R0; s.ld = N_IN0; }
    else if (mat == 2) { if (R0 < 3072) { s.p = F.in[I_ODWIN] + R0; s.ld = 3072; } else { s.p = nullptr; s.ld = 0; s.lowrank = true; s.nlr = R0 - 3072; } }
    else { const int l = mat >> 1, pn = R0 >> 8, half = (R0 >> 7) & 1, i0 = R0 & 127; s.p = (half ? F.in[I_W3] : F.in[I_W1]) + (size_t)l * D * FF + 128 * pn + i0; s.ld = FF; }
    return s;
}
__device__ __forceinline__ float lowrank_val(Frame& F, int k, int n) { const float* a1 = F.in[I_ODWA1] + k * 16; const float* a2 = F.in[I_ODWA2] + n; float s = 0.f;
#pragma unroll
    for (int r = 0; r < 16; ++r) s += a1[r] * a2[r * 512]; return s; }
__device__ __forceinline__ void p1_prologue_b(Frame& F) {
    const float* mod = (const float*)(F.ws + WS_MOD);
    for (int task = F.vcu; task < 272; task += F.G) {
        int mat, nb = task; if (nb < 40) mat = 0; else if ((nb -= 40) < 88) mat = 1; else if ((nb -= 88) < 56) mat = 2; else { nb -= 56; mat = 3; }
        const int l = mat >> 1, sh = (mat & 1) ? 3072 : 0, R = nb * 64 + F.lane; const FusedSrc s = fused_src(F, mat, nb * 64);
        float o0, o1;
        gemv64(F, [&](int k) { return s.lowrank ? lowrank_val(F, k, s.nlr + F.lane) : s.p[(size_t)k * s.ld + F.lane]; }, [&](int b, int k) { return mod[(l * 2 + b) * 6144 + sh + k]; }, o0, o1);
        if (F.wave == 0) { const int Ns[4] = {N_IN0, N_UP, N_IN1, N_UP}; const int offs[4] = {CV_IN0, CV_UP0, CV_IN1, CV_UP1};
            float* cv = (float*)(F.ws + WS_CV) + offs[mat]; cv[R] = o0; cv[Ns[mat] + R] = o1; }
    }
    LAS float* scr = (LAS float*)(F.lds + RING_OFF + 4096 + F.wave * 12288);
    LAS float* scl = scr + 64 * 33;
    const int gw = F.vcu * NWAVES + F.wave, NGW = F.G * NWAVES;
    constexpr int IT0 = 16 * (N_IN0 / 32), IT1 = 16 * (N_UP / 32), IT2 = 16 * (N_IN1 / 32);
    for (int it = NGW - 1 - gw; it < IT0 + 2 * IT1 + IT2; it += NGW) {
        int mat, r = it; if (r < IT0) mat = 0; else if ((r -= IT0) < IT1) mat = 1; else if ((r -= IT1) < IT2) mat = 2; else { r -= IT2; mat = 3; }
        const int Ns[4] = {N_IN0, N_UP, N_IN1, N_UP}; const size_t wso[4] = {WS_WIN0, WS_W13_0, WS_WIN1, WS_W13_1};
        const int N = Ns[mat], nblk = N / 32, kb = r / nblk, nb = r % nblk, k0 = 64 * kb, R0 = 32 * nb, l = mat >> 1;
        const FusedSrc s = fused_src(F, mat, R0);
        if (s.lowrank) {
#pragma unroll 4
            for (int i = 0; i < 32; ++i) { const int kk = 2 * i + (F.lane >> 5); scr[kk * 33 + (F.lane & 31)] = lowrank_val(F, k0 + kk, s.nlr + (F.lane & 31)); }
        } else tile_load(s.p + (size_t)k0 * s.ld, s.ld, scr, F.lane);
        { const int k = k0 + F.lane; const float gn = (mat & 1) ? F.in[I_NFG][l * 1024 + k] : F.in[I_NMG][l * 1024 + k]; const int so = (mat & 1) ? 4096 : 1024;
          scl[F.lane] = gn * (1.0f + mod[(l * 2 + 0) * 6144 + so + k]); scl[64 + F.lane] = gn * (1.0f + mod[(l * 2 + 1) * 6144 + so + k]); }
        LDS_WAIT(); asm volatile("" ::: "memory");
        bf16* dst = (bf16*)(F.ws + wso[mat]) + (size_t)R0 * D + k0;
        float sc0[8], sc1[8];
#pragma unroll
        for (int j = 0; j < 8; ++j) { sc0[j] = scl[8 * (F.lane & 7) + j]; sc1[j] = scl[64 + 8 * (F.lane & 7) + j]; }
        const int c = F.lane & 7;
#pragma unroll
        for (int j = 0; j < 4; ++j) { const int n = (F.lane >> 3) + 8 * j; const LAS float* sp = scr + (8 * c) * 33 + n;
            float v[8];
#pragma unroll
            for (int e = 0; e < 8; ++e) v[e] = sp[e * 33];
            v4u o; o.x = pk2(v[0] * sc0[0], v[1] * sc0[1]); o.y = pk2(v[2] * sc0[2], v[3] * sc0[3]); o.z = pk2(v[4] * sc0[4], v[5] * sc0[5]); o.w = pk2(v[6] * sc0[6], v[7] * sc0[7]);
            *(GAS v4u*)(dst + (size_t)n * D + 8 * c) = o;
            o.x = pk2(v[0] * sc1[0], v[1] * sc1[1]); o.y = pk2(v[2] * sc1[2], v[3] * sc1[3]); o.z = pk2(v[4] * sc1[4], v[5] * sc1[5]); o.w = pk2(v[6] * sc1[6], v[7] * sc1[7]);
            *(GAS v4u*)(dst + (size_t)N * D + (size_t)n * D + 8 * c) = o; }
        LDS_WAIT(); asm volatile("" ::: "memory");
    }
}

__device__ __forceinline__ void s5_carry(Frame& F) {
    for (int task = F.vcu; task < 64; task += F.G) {
        const int b = task >> 5, g = task & 31, p = F.tid & 63, seg = F.tid >> 6;
        const float* X = (const float*)(F.ws + WS_XLOC) + ((size_t)g * NCH + b * 512 + seg * 64) * 128 + p;
        const float* L = (const float*)(F.ws + WS_S5LAM) + (g * 64 + p) * 2; const float lr = L[0], li = L[1];
        float ar = 0.f, ai = 0.f;
#pragma unroll 8
        for (int c = 0; c < 64; ++c) { const float xr = X[(size_t)c * 128], xi = X[(size_t)c * 128 + 64]; const float nr = lr * ar - li * ai + xr, ni = lr * ai + li * ar + xi; ar = nr; ai = ni; }
        float sr = lr, si = li;
#pragma unroll
        for (int q = 0; q < 6; ++q) { const float nr = sr * sr - si * si, ni = 2.f * sr * si; sr = nr; si = ni; }
        LAS float* agg = (LAS float*)(F.lds + RING_OFF);
        agg[(seg * 64 + p) * 2] = ar; agg[(seg * 64 + p) * 2 + 1] = ai;
        __syncthreads();
        float cr = 0.f, ci = 0.f;
        for (int s = 0; s < seg; ++s) { const float xr = agg[(s * 64 + p) * 2], xi = agg[(s * 64 + p) * 2 + 1]; const float nr = sr * cr - si * ci + xr, ni = sr * ci + si * cr + xi; cr = nr; ci = ni; }
        bf16* U = (bf16*)(F.ws + WS_UT) + ((size_t)g * NCH + b * 512 + seg * 64) * UTP + 512 + p;
#pragma unroll 8
        for (int c = 0; c < 64; ++c) { U[(size_t)c * UTP] = (bf16)f2bf(cr); U[(size_t)c * UTP + 64] = (bf16)f2bf(ci);
            const float xr = X[(size_t)c * 128], xi = X[(size_t)c * 128 + 64]; const float nr = lr * cr - li * ci + xr, ni = lr * ci + li * cr + xi; cr = nr; ci = ni; }
        __syncthreads();
    }
}

__device__ __forceinline__ void final_norm(Frame& F) {
    const int gw = F.vcu * NWAVES + F.wave, NGW = F.G * NWAVES; const float* gn = F.in[I_FNORM];
    f32x4 gv[4];
#pragma unroll
    for (int j = 0; j < 4; ++j) gv[j] = ((const f32x4*)gn)[F.lane + 64 * j];
    for (int m = gw; m < T; m += NGW) {
        GAS f32x4* xr = (GAS f32x4*)(F.out + (size_t)m * D) + F.lane; f32x4 v[4]; float s = 0.f;
#pragma unroll
        for (int j = 0; j < 4; ++j) { v[j] = xr[64 * j]; s += (v[j].x * v[j].x + v[j].y * v[j].y) + (v[j].z * v[j].z + v[j].w * v[j].w); }
        const float rs = 1.0f / sqrtf(wave_sum(s) * (1.0f / D) + EPS);
#pragma unroll
        for (int j = 0; j < 4; ++j) xr[64 * j] = v[j] * rs * gv[j];
    }
}
namespace gl {
typedef short bf16x8 __attribute__((ext_vector_type(8)));
typedef short bf16x4 __attribute__((ext_vector_type(4)));
typedef float f32x16 __attribute__((ext_vector_type(16)));
constexpr int P136 = 272, P72 = 144;
constexpr int L_QE = 0, L_QI = 17408, L_KI = 34816, L_KLT = 52224, L_VT = 70656, L_P = 107520, L_TOT = 116736, L_DEC = 120832, L_NG = 121344, L_END = 122368;
static_assert(L_END <= RING_BYTES, "mixer LDS map");
__device__ __forceinline__ bf16x8 frag16(LAS unsigned char* lds, int base, int pitch, int row, int col) { return *(const LAS bf16x8*)(lds + base + row * pitch + col * 2); }
__device__ __forceinline__ unsigned pkbf(float lo, float hi) { return pg8::cvt_pk_bf16(lo, hi); }

#define GL_BAR() do { asm volatile("s_waitcnt lgkmcnt(0)" ::: "memory"); __builtin_amdgcn_s_barrier(); asm volatile("" ::: "memory"); } while (0)
template <int DV, bool GLA, bool PASS2> struct MixPF { unsigned qv[8], kv[8], gv[8]; v4u vt[DV * 8 / 512]; };
template <int DV, bool GLA, bool PASS2>
__device__ __forceinline__ void mix_load(MixPF<DV, GLA, PASS2>& P, int t0, int tid, int w, int h, int c0, const bf16* ZR, int zp, int qoff, int koff, int goff, int ooff, const bf16* VT, int dvt) {
#pragma unroll
    for (int tt = 0; tt < 8; ++tt) { const bf16* zr = ZR + (size_t)(t0 + 8 * w + tt) * zp + h * 128 + c0;
        P.qv[tt] = PASS2 ? *(const unsigned*)(zr + qoff) : 0u; P.kv[tt] = *(const unsigned*)(zr + koff); P.gv[tt] = GLA ? *(const unsigned*)(zr + goff) : 0u; }
#pragma unroll
    for (int i = 0; i < DV * 8 / 512; ++i) { const int idx = tid + 512 * i, v = idx >> 3, jc = idx & 7; P.vt[i] = *(const v4u*)(VT + ((size_t)(t0 >> 6) * dvt + h * DV + v) * 64 + jc * 8); }
}
template <int DV, bool GLA, bool PASS2>
__device__ __forceinline__ void mix_unit(Frame& F, int bh, int seg, const bf16* ZR, int zp, int qoff, int koff, int goff, int ooff, const bf16* VT, int dvt,
                                         float* AGG, float* DSEG, bf16* OUT, int ldo, int ocol0, const float* ng, const float* lbl) {
    constexpr int NV = DV / 32, SW0 = (DV == 128) ? 4 : 0, OTP = DV + 4;
    static_assert(64 * OTP * 4 <= L_VT, "O tile overlays QE..KLT");
    LAS unsigned char* lds = F.lds + RING_OFF;
    const int w = F.wave, lane = F.lane, r = lane & 31, hh = lane >> 5, b = bh >> 2, h = bh & 3, tok0 = b * SEQ + seg * 512, c0 = 2 * lane;
    LAS float* TOT = (LAS float*)(lds + L_TOT); LAS float* DEC = (LAS float*)(lds + L_DEC);
    MixPF<DV, GLA, PASS2> nxt;
    mix_load<DV, GLA, PASS2>(nxt, tok0, F.tid, w, h, c0, ZR, zp, qoff, koff, goff, ooff, VT, dvt);
    float lb[2] = {0.f, 0.f};
    if (!GLA) {
#pragma unroll
        for (int e = 0; e < 2; ++e) { const int c = h * 128 + c0 + e; const float l0 = lbl[c], l1 = lbl[512 + c], l2 = lbl[1024 + c], mx = fmaxf(l0, fmaxf(l1, l2)); const float e0 = __expf(l0 - mx), e1 = __expf(l1 - mx), e2 = __expf(l2 - mx); lb[e] = e0 / (e0 + e1 + e2); } }
    f32x16 S[4];
    const size_t aggbase = ((size_t)(bh * 32 + seg) * 128) * DV;
#pragma unroll
    for (int ct = 0; ct < 4; ++ct)
#pragma unroll
        for (int rr = 0; rr < 16; ++rr) S[ct][rr] = 0.f;
    if (PASS2 && w < NV) {
#pragma unroll
        for (int ct = 0; ct < 4; ++ct)
#pragma unroll
            for (int rr = 0; rr < 16; ++rr) S[ct][rr] = AGG[aggbase + (size_t)(32 * ct + (rr & 3) + 8 * (rr >> 2) + 4 * hh) * DV + 32 * w + r];
    }
    float lsum[2] = {0.f, 0.f};
    LAS float* NG = (LAS float*)(lds + L_NG);
    if (PASS2) { if (F.tid < DV) NG[F.tid] = ng[F.tid]; }
#pragma unroll 1
    for (int ch = 0; ch < 8; ++ch) {
        const int t0 = tok0 + ch * 64;
#pragma unroll
        for (int i = 0; i < DV * 8 / 512; ++i) { const int idx = F.tid + 512 * i, v = idx >> 3, jc = idx & 7; *(LAS v4u*)(lds + L_VT + v * P72 + jc * 16) = nxt.vt[i]; }
        float cl[8][2], qq[8][2], kk[8][2]; float run[2] = {0.f, 0.f};
#pragma unroll
        for (int tt = 0; tt < 8; ++tt)
#pragma unroll
            for (int e = 0; e < 2; ++e) {
                const float kf = e ? pg8::bf_hi(nxt.kv[tt]) : pg8::bf_lo(nxt.kv[tt]), qf = e ? pg8::bf_hi(nxt.qv[tt]) : pg8::bf_lo(nxt.qv[tt]); float lg;
                if (GLA) { lg = (e ? pg8::bf_hi(nxt.gv[tt]) : pg8::bf_lo(nxt.gv[tt])) * 0.0625f; kk[tt][e] = kf; qq[tt][e] = qf; }
                else { const float sg = pg8::fsigmoid(kf), fo = lb[e] + (1.f - lb[e]) * sg; lg = __logf(fo); kk[tt][e] = (1.f - lb[e]) * (1.f - sg); qq[tt][e] = pg8::fsilu(qf); }
                run[e] += lg; cl[tt][e] = run[e]; }
        TOT[w * 128 + c0] = run[0]; TOT[w * 128 + c0 + 1] = run[1];
        GL_BAR();
        float off[2] = {0.f, 0.f}, last[2] = {0.f, 0.f}, ref[2] = {0.f, 0.f};
#pragma unroll
        for (int ww = 0; ww < 8; ++ww) { const float t0_ = TOT[ww * 128 + c0], t1_ = TOT[ww * 128 + c0 + 1];
            if (ww < w) { off[0] += t0_; off[1] += t1_; } if (ww < 4) { ref[0] += t0_; ref[1] += t1_; } last[0] += t0_; last[1] += t1_; }
        float klv[2][8];
#pragma unroll
        for (int tt = 0; tt < 8; ++tt) { float qe[2], qi[2], ki[2];
#pragma unroll
            for (int e = 0; e < 2; ++e) { const float cum = off[e] + cl[tt][e]; klv[e][tt] = kk[tt][e] * __expf(last[e] - cum);
                if (PASS2) { qe[e] = qq[tt][e] * __expf(cum); qi[e] = qq[tt][e] * __expf(cum - ref[e]); ki[e] = kk[tt][e] * __expf(ref[e] - cum); } }
            if (PASS2) { const int o = (8 * w + tt) * P136 + c0 * 2;
                *(LAS unsigned*)(lds + L_QE + o) = pkbf(qe[0], qe[1]); *(LAS unsigned*)(lds + L_QI + o) = pkbf(qi[0], qi[1]); *(LAS unsigned*)(lds + L_KI + o) = pkbf(ki[0], ki[1]); } }
#pragma unroll
        for (int e = 0; e < 2; ++e) { v4u o; o.x = pkbf(klv[e][0], klv[e][1]); o.y = pkbf(klv[e][2], klv[e][3]); o.z = pkbf(klv[e][4], klv[e][5]); o.w = pkbf(klv[e][6], klv[e][7]);
            *(LAS v4u*)(lds + L_KLT + (c0 + e) * P72 + 16 * w) = o; }
        if (w == 0) { DEC[c0] = __expf(last[0]); DEC[c0 + 1] = __expf(last[1]); lsum[0] += last[0]; lsum[1] += last[1]; }
        GL_BAR();
        if (ch + 1 < 8) mix_load<DV, GLA, PASS2>(nxt, t0 + 64, F.tid, w, h, c0, ZR, zp, qoff, koff, goff, ooff, VT, dvt);
        v4u og[DV / 64];
        if (PASS2) {
#pragma unroll
            for (int q = 0; q < DV / 64; ++q) og[q] = *(const v4u*)(ZR + (size_t)(t0 + (F.tid >> 3)) * zp + ooff + h * DV + (F.tid & 7) * 8 + 64 * q); }
        f32x16 O[2];
        if (PASS2) {
            if (w >= SW0 && w < SW0 + 3) {
                const int ti = w - SW0, jt = ti >> 1, it = (ti + 1) >> 1;
                f32x16 X;
#pragma unroll
                for (int rr = 0; rr < 16; ++rr) X[rr] = 0.f;
#pragma unroll
                for (int s = 0; s < 8; ++s) X = __builtin_amdgcn_mfma_f32_32x32x16_bf16(frag16(lds, L_KI, P136, 32 * jt + r, 16 * s + 8 * hh), frag16(lds, L_QI, P136, 32 * it + r, 16 * s + 8 * hh), X, 0, 0, 0);
#pragma unroll
                for (int g = 0; g < 4; ++g) { float x[4];
#pragma unroll
                    for (int e = 0; e < 4; ++e) { const int j = 32 * jt + 8 * g + 4 * hh + e, i = 32 * it + r; x[e] = (j <= i) ? X[4 * g + e] : 0.f; }
                    v2u o; o.x = pkbf(x[0], x[1]); o.y = pkbf(x[2], x[3]);
                    *(LAS v2u*)(lds + L_P + (32 * it + r) * P72 + (32 * jt + 8 * g + 4 * hh) * 2) = o; }
            }
            if (w < NV) {
#pragma unroll
                for (int it = 0; it < 2; ++it)
#pragma unroll
                    for (int rr = 0; rr < 16; ++rr) O[it][rr] = 0.f;
#pragma unroll
                for (int ct = 0; ct < 4; ++ct)
#pragma unroll
                    for (int s = 0; s < 2; ++s) {
                        union { bf16x8 v; unsigned u[4]; } Bs;
#pragma unroll
                        for (int p = 0; p < 4; ++p) Bs.u[p] = pkbf(S[ct][8 * s + 2 * p], S[ct][8 * s + 2 * p + 1]);
#pragma unroll
                        for (int it = 0; it < 2; ++it) { union { bf16x8 v; bf16x4 hlf[2]; } A; const int o = L_QE + (32 * it + r) * P136 + (32 * ct + 16 * s + 4 * hh) * 2;
                            A.hlf[0] = *(const LAS bf16x4*)(lds + o); A.hlf[1] = *(const LAS bf16x4*)(lds + o + 16);
                            O[it] = __builtin_amdgcn_mfma_f32_32x32x16_bf16(A.v, Bs.v, O[it], 0, 0, 0); } }
            }
            GL_BAR();
        }
        if (w < NV) {
            if (PASS2) {
#pragma unroll
                for (int it = 0; it < 2; ++it)
#pragma unroll
                    for (int jt = 0; jt <= it; ++jt)
#pragma unroll
                        for (int s = 0; s < 2; ++s)
                            O[it] = __builtin_amdgcn_mfma_f32_32x32x16_bf16(frag16(lds, L_P, P72, 32 * it + r, 32 * jt + 16 * s + 8 * hh), frag16(lds, L_VT, P72, 32 * w + r, 32 * jt + 16 * s + 8 * hh), O[it], 0, 0, 0);
            }
#pragma unroll
            for (int ct = 0; ct < 4; ++ct) {
#pragma unroll
                for (int g = 0; g < 4; ++g) { const f32x4 d4 = *(const LAS f32x4*)(DEC + 32 * ct + 8 * g + 4 * hh);
#pragma unroll
                    for (int e = 0; e < 4; ++e) S[ct][4 * g + e] *= d4[e]; }
#pragma unroll
                for (int sj = 0; sj < 4; ++sj)
                    S[ct] = __builtin_amdgcn_mfma_f32_32x32x16_bf16(frag16(lds, L_KLT, P72, 32 * ct + r, 16 * sj + 8 * hh), frag16(lds, L_VT, P72, 32 * w + r, 16 * sj + 8 * hh), S[ct], 0, 0, 0);
            }
        }
        GL_BAR();
        if (PASS2) {
            LAS float* OT = (LAS float*)lds;
            if (w < NV) {
#pragma unroll
                for (int it = 0; it < 2; ++it)
#pragma unroll
                    for (int rr = 0; rr < 16; ++rr) OT[(32 * it + (rr & 3) + 8 * (rr >> 2) + 4 * hh) * OTP + 32 * w + r] = O[it][rr];
            }
            GL_BAR();
            const int i = F.tid >> 3, sub = F.tid & 7; float ov[DV / 64][8]; float ss = 0.f;
#pragma unroll
            for (int q = 0; q < DV / 64; ++q) { const f32x4 a = *(const LAS f32x4*)(OT + i * OTP + sub * 8 + 64 * q), bq = *(const LAS f32x4*)(OT + i * OTP + sub * 8 + 64 * q + 4);
#pragma unroll
                for (int e = 0; e < 4; ++e) { ov[q][e] = a[e]; ov[q][4 + e] = bq[e]; ss += a[e] * a[e] + bq[e] * bq[e]; } }
            ss += __shfl_xor(ss, 1); ss += __shfl_xor(ss, 2); ss += __shfl_xor(ss, 4);
            const float rs = 1.0f / sqrtf(ss * (1.0f / DV) + EPS);
#pragma unroll
            for (int q = 0; q < DV / 64; ++q) { const int col = sub * 8 + 64 * q; const v4u gw = og[q];
                const float g8[8] = {pg8::bf_lo(gw.x), pg8::bf_hi(gw.x), pg8::bf_lo(gw.y), pg8::bf_hi(gw.y), pg8::bf_lo(gw.z), pg8::bf_hi(gw.z), pg8::bf_lo(gw.w), pg8::bf_hi(gw.w)};
                const f32x4 n0 = *(const LAS f32x4*)(NG + col), n1 = *(const LAS f32x4*)(NG + col + 4);
                float y[8];
#pragma unroll
                for (int e = 0; e < 8; ++e) y[e] = ov[q][e] * rs * (e < 4 ? n0[e] : n1[e - 4]) * pg8::fsilu(g8[e]);
                v4u o; o.x = pkbf(y[0], y[1]); o.y = pkbf(y[2], y[3]); o.z = pkbf(y[4], y[5]); o.w = pkbf(y[6], y[7]);
                *(v4u*)(OUT + (size_t)(t0 + i) * ldo + ocol0 + h * DV + col) = o; }
        }
    }
    if (!PASS2) {
        if (w < NV) {
#pragma unroll
            for (int ct = 0; ct < 4; ++ct)
#pragma unroll
                for (int rr = 0; rr < 16; ++rr) AGG[aggbase + (size_t)(32 * ct + (rr & 3) + 8 * (rr >> 2) + 4 * hh) * DV + 32 * w + r] = S[ct][rr];
        }
        if (w == 0) { DSEG[(bh * 32 + seg) * 128 + c0] = __expf(lsum[0]); DSEG[(bh * 32 + seg) * 128 + c0 + 1] = __expf(lsum[1]); }
    }
}
template <int DV> __device__ __forceinline__ void mix_carry(Frame& F, float* AGG, const float* DSEG) {
    constexpr int PER = 128 * DV;
    for (int idx = F.vcu * (NWAVES * 64) + F.tid; idx < 8 * PER; idx += F.G * NWAVES * 64) {
        const int bh = idx / PER, rem = idx % PER, c = rem / DV; float a[32], d[32];
#pragma unroll
        for (int s = 0; s < 32; ++s) { a[s] = AGG[(size_t)(bh * 32 + s) * PER + rem]; d[s] = DSEG[(bh * 32 + s) * 128 + c]; }
        float cur = 0.f;
#pragma unroll
        for (int s = 0; s < 32; ++s) { AGG[(size_t)(bh * 32 + s) * PER + rem] = cur; cur = d[s] * cur + a[s]; }
    }
}
}
constexpr int N_PHASES = 18;
__global__ void __launch_bounds__(NWAVES * 64, 2) mk_fwd(Args args) {
    extern __shared__ __attribute__((aligned(16))) unsigned char lds[];
    Frame F;
    F.lds = (LAS unsigned char*)lds;
    F.MISC = (volatile LAS unsigned*)(F.lds + MISC_OFF);
    F.tid = threadIdx.x; F.lane = F.tid & 63; F.wave = __builtin_amdgcn_readfirstlane(F.tid >> 6);
    F.G = gridDim.x; { const int bx = blockIdx.x; F.vcu = (F.G % 8 == 0) ? (bx % 8) * (F.G / 8) + bx / 8 : bx; }
    F.in = args.in; F.out = args.out; F.ws = args.ws;
    F.ctl = (gu32*)(args.ws + WS_CTL);
    for (int u = F.tid; u < (LDS_BYTES - LDSCTL_OFF) / 4; u += NWAVES * 64) ((LAS unsigned*)(F.lds + LDSCTL_OFF))[u] = 0u;
    __syncthreads();
    const int lo = args.ph_lo, hi = args.ph_hi;
    XcdBarrier bar; bar.bar = (unsigned*)(F.ctl + CW_BAR); bar.x = 0; bar.st = nullptr;
    if (hi - lo > 1) bar = xcd_barrier_post((unsigned*)(F.ctl + CW_BAR), F.MISC + 8);
#define IN(k) (lo <= (k) && (k) < hi)
#define SEAM(k) do { if (IN(k) && IN((k) + 1)) xcd_barrier(bar); } while (0)
    unsigned char* ws = args.ws;
    float* rowsq = (float*)(ws + WS_ROWSQ); bf16* xb = (bf16*)(ws + WS_XB); const float* mod = (const float*)(ws + WS_MOD); const float* cv = (const float*)(ws + WS_CV);
    const int bid = (int)blockIdx.x;

    if (IN(0)) { p0_prologue_a(F); } SEAM(0);
    if (IN(1)) { p1_prologue_b(F); } SEAM(1);
    if (IN(2)) {
        pg8::Gemm g{xb, (const bf16*)(ws + WS_WIN0), D, D, D}; pg8::StaticOrder S; S.init(T, N_IN0, F.G, bid, 64, (size_t)N_IN0 * D * 2);
        pg8::EpiIn0 E{rowsq, cv + CV_IN0, (bf16*)(ws + WS_UT), (bf16*)(ws + WS_QFG), (bf16*)(ws + WS_VT0)};
        pg8::gemm_phase<pg8::EpiIn0, pg8::StaticOrder, true>(F.lds + RING_OFF, g, S, E);
    } SEAM(2);
    if (IN(3)) {
        { const int un = F.vcu; if (un < 256)
            gl::mix_unit<128, false, false>(F, un >> 5, un & 31, (const bf16*)(ws + WS_QFG), 1536, 0, 512, 0, 1024, (const bf16*)(ws + WS_VT0), 512, (float*)(ws + WS_HGA), (float*)(ws + WS_HGD), nullptr, 0, 0, nullptr, F.in[I_LBLOG]); }
        __syncthreads();
        pg8::Gemm g{(const bf16*)(ws + WS_UT), (const bf16*)(ws + WS_S5F), UTP, 512, 512}; pg8::GroupOrder S; S.init(4, 1, S5G, F.G, F.vcu, (size_t)NCH * UTP * 2, (size_t)256 * 512 * 2);
        pg8::EpiS5X E{(float*)(ws + WS_XLOC)};
        pg8::gemm_phase<pg8::EpiS5X, pg8::GroupOrder, true>(F.lds + RING_OFF, g, S, E);
    } SEAM(3);
    if (IN(4)) { s5_carry(F); gl::mix_carry<128>(F, (float*)(ws + WS_HGA), (const float*)(ws + WS_HGD)); } SEAM(4);
    if (IN(5)) {
        { const int un = F.vcu; if (un < 256)
            gl::mix_unit<128, false, true>(F, un >> 5, un & 31, (const bf16*)(ws + WS_QFG), 1536, 0, 512, 0, 1024, (const bf16*)(ws + WS_VT0), 512, (float*)(ws + WS_HGA), (float*)(ws + WS_HGD), (bf16*)(ws + WS_MIXED), D, 512, F.in[I_HGNORM], F.in[I_LBLOG]); }
        __syncthreads();
        pg8::Gemm g{(const bf16*)(ws + WS_UT), (const bf16*)(ws + WS_S5T), UTP, UTP, UTP}; pg8::GroupOrder S; S.init(4, 2, S5G, F.G, F.vcu, (size_t)NCH * UTP * 2, (size_t)512 * UTP * 2);
        pg8::EpiS5Y E{(bf16*)(ws + WS_YGELU)};
        pg8::gemm_phase<pg8::EpiS5Y, pg8::GroupOrder, true>(F.lds + RING_OFF, g, S, E);
    } SEAM(5);
    if (IN(6)) {
        pg8::Gemm g{(const bf16*)(ws + WS_YGELU), (const bf16*)(ws + WS_WGLU), 512, 512, 512}; pg8::StaticOrder S; S.init(T, 512, F.G, bid, 64, 0);
        pg8::EpiGlu E{(const bf16*)(ws + WS_YGELU), F.in[I_BGLU], (bf16*)(ws + WS_MIXED), D};
        pg8::gemm_phase<pg8::EpiGlu, pg8::StaticOrder, true>(F.lds + RING_OFF, g, S, E);
    } SEAM(6);
    if (IN(7)) {
        pg8::Gemm g{(const bf16*)(ws + WS_MIXED), (const bf16*)(ws + WS_WOUT0), D, D, D}; pg8::StaticOrder S; S.init(T, D, F.G, bid, 64, 0);
        pg8::EpiResid E{F.in[I_X], F.out, xb, rowsq, mod + 2048, 6144};
        pg8::gemm_phase<pg8::EpiResid, pg8::StaticOrder, true>(F.lds + RING_OFF, g, S, E);
    } SEAM(7);
    if (IN(8)) {
        pg8::Gemm g{xb, (const bf16*)(ws + WS_W13_0), D, D, D}; pg8::StaticOrder S; S.init(T, N_UP, F.G, bid, 64, (size_t)N_UP * D * 2);
        pg8::EpiFfnUp E{rowsq, cv + CV_UP0, (bf16*)(ws + WS_HID)};
        pg8::gemm_phase<pg8::EpiFfnUp, pg8::StaticOrder, true>(F.lds + RING_OFF, g, S, E);
    } SEAM(8);
    if (IN(9)) {
        pg8::Gemm g{(const bf16*)(ws + WS_HID), (const bf16*)(ws + WS_W2_0), FF, FF, FF}; pg8::StaticOrder S; S.init(T, D, F.G, bid, 64, 0);
        pg8::EpiResid E{F.out, F.out, xb, rowsq, mod + 5120, 6144};
        pg8::gemm_phase<pg8::EpiResid, pg8::StaticOrder, true>(F.lds + RING_OFF, g, S, E);
    } SEAM(9);
    if (IN(10)) {
        pg8::Gemm g{xb, (const bf16*)(ws + WS_WIN1), D, D, D}; pg8::StaticOrder S; S.init(T, N_IN1, F.G, bid, 64, (size_t)N_IN1 * D * 2);
        pg8::EpiIn1 E{rowsq, cv + CV_IN1, F.in[I_ODBA], (bf16*)(ws + WS_Z1), (bf16*)(ws + WS_VT1)};
        pg8::gemm_phase<pg8::EpiIn1, pg8::StaticOrder, true>(F.lds + RING_OFF, g, S, E);
    } SEAM(10);
    if (IN(11)) {
        { const int un = F.vcu; if (un < 256)
            gl::mix_unit<256, true, false>(F, un >> 5, un & 31, (const bf16*)(ws + WS_Z1), 2560, 0, 512, 2048, 1024, (const bf16*)(ws + WS_VT1), 1024, (float*)(ws + WS_GLA_A), (float*)(ws + WS_GLA_D), nullptr, 0, 0, nullptr, nullptr); }
    } SEAM(11);
    if (IN(12)) { gl::mix_carry<256>(F, (float*)(ws + WS_GLA_A), (const float*)(ws + WS_GLA_D)); } SEAM(12);
    if (IN(13)) {
        { const int un = F.vcu; if (un < 256)
            gl::mix_unit<256, true, true>(F, un >> 5, un & 31, (const bf16*)(ws + WS_Z1), 2560, 0, 512, 2048, 1024, (const bf16*)(ws + WS_VT1), 1024, (float*)(ws + WS_GLA_A), (float*)(ws + WS_GLA_D), (bf16*)(ws + WS_MIXED2), D, 0, F.in[I_GLANORM], nullptr); }
    } SEAM(13);
    if (IN(14)) {
        pg8::Gemm g{(const bf16*)(ws + WS_MIXED2), (const bf16*)(ws + WS_WOUT1), D, D, D}; pg8::StaticOrder S; S.init(T, D, F.G, bid, 64, 0);
        pg8::EpiResid E{F.out, F.out, xb, rowsq, mod + 2 * 6144 + 2048, 6144};
        pg8::gemm_phase<pg8::EpiResid, pg8::StaticOrder, true>(F.lds + RING_OFF, g, S, E);
    } SEAM(14);
    if (IN(15)) {
        pg8::Gemm g{xb, (const bf16*)(ws + WS_W13_1), D, D, D}; pg8::StaticOrder S; S.init(T, N_UP, F.G, bid, 64, (size_t)N_UP * D * 2);
        pg8::EpiFfnUp E{rowsq, cv + CV_UP1, (bf16*)(ws + WS_HID)};
        pg8::gemm_phase<pg8::EpiFfnUp, pg8::StaticOrder, true>(F.lds + RING_OFF, g, S, E);
    } SEAM(15);
    if (IN(16)) {
        pg8::Gemm g{(const bf16*)(ws + WS_HID), (const bf16*)(ws + WS_W2_1), FF, FF, FF}; pg8::StaticOrder S; S.init(T, D, F.G, bid, 64, 0);
        pg8::EpiResid E{F.out, F.out, xb, rowsq, mod + 2 * 6144 + 5120, 6144};
        pg8::gemm_phase<pg8::EpiResid, pg8::StaticOrder, true>(F.lds + RING_OFF, g, S, E);
    } SEAM(16);
    if (IN(17)) { final_norm(F); }
#undef IN
#undef SEAM
}


extern "C" void kernel_launch(void* const* d_in, const int* in_sizes, int n_in, void* d_out, int out_size, void* d_ws, size_t ws_size, hipStream_t stream) {
    static int grid = 0;
    if (grid == 0) {
        if (n_in != 30 || in_sizes[0] != T * D || out_size != T * D || ws_size < WS_END) { fprintf(stderr, "kernel_launch: unexpected shapes: n_in %d in0 %d out %d ws %zu (need %zu)\n", n_in, n_in > 0 ? in_sizes[0] : -1, out_size, ws_size, (size_t)WS_END); grid = -1; return; }
        int dev = 0, cus = 0, per_cu = 0;
        if (hipGetDevice(&dev) != hipSuccess || hipDeviceGetAttribute(&cus, hipDeviceAttributeMultiprocessorCount, dev) != hipSuccess) { fprintf(stderr, "kernel_launch: device query failed\n"); grid = -1; return; }
        if (hipFuncSetAttribute((const void*)mk_fwd, hipFuncAttributeMaxDynamicSharedMemorySize, LDS_BYTES) != hipSuccess) { fprintf(stderr, "kernel_launch: hipFuncSetAttribute failed\n"); grid = -1; return; }
        if (hipOccupancyMaxActiveBlocksPerMultiprocessor(&per_cu, (const void*)mk_fwd, NWAVES * 64, LDS_BYTES) != hipSuccess || per_cu < 1) { fprintf(stderr, "kernel_launch: occupancy query reports %d workgroups per CU; nothing launched\n", per_cu); (void)hipGetLastError(); grid = -1; return; }
        if (cus < 256) { fprintf(stderr, "kernel_launch: this kernel needs 256 CUs (found %d); nothing launched\n", cus); grid = -1; return; }
        grid = 256;
    }
    if (grid < 0) return;
    (void)hipMemsetAsync((char*)d_ws + WS_CTL, 0, CTL_ZERO_BYTES, stream);
    Args a{};
    for (int i = 0; i < 30; ++i) a.in[i] = (const float*)d_in[i];
    a.out = (float*)d_out; a.ws = (unsigned char*)d_ws;
#ifdef PROBE_RANGES
    static const int ranges[][2] = PROBE_RANGES;
    for (unsigned i = 0; i < sizeof(ranges) / sizeof(ranges[0]); ++i) { if (i) (void)hipMemsetAsync((char*)d_ws + WS_CTL, 0, CTL_ZERO_BYTES, stream);
        a.ph_lo = ranges[i][0]; a.ph_hi = ranges[i][1]; hipLaunchKernelGGL(mk_fwd, dim3(grid), dim3(NWAVES * 64), LDS_BYTES, stream, a); }
#else
    a.ph_lo = 0; a.ph_hi = N_PHASES;
    hipLaunchKernelGGL(mk_fwd, dim3(grid), dim3(NWAVES * 64), LDS_BYTES, stream, a);
#endif
}
```

```cpp
#include <hip/hip_runtime.h>
#include <cstdio>
#include <cstdint>
#include <cmath>
namespace pg8 {
#define PG8_LAS __attribute__((address_space(3)))
typedef unsigned short bf16_t;
typedef short bf16x8 __attribute__((ext_vector_type(8)));
typedef float f32x4 __attribute__((ext_vector_type(4)));
typedef unsigned u32x4 __attribute__((ext_vector_type(4)));
typedef unsigned u32x2 __attribute__((ext_vector_type(2)));
constexpr int BM = 256, BK = 64, HALF = 128, HTB = HALF * BK * 2  , STAGE_BYTES = 8 * HTB, NXCD = 8, WGM = 8;

__host__ __device__ __forceinline__ int lds_byte(int r, int c) { const int st = (r >> 4) * 2 + (c >> 5), rr = r & 15, cc = c & 31, ob = rr * 64 + cc * 2; return st * 1024 + (ob ^ (((ob >> 9) & 1) << 5)); }
__host__ __device__ __forceinline__ void stage_rc(int b, int& R, int& C) { const int st = b / 1024, sb = b % 1024, swz = sb ^ (((sb >> 9) & 1) << 5); R = (st >> 1) * 16 + swz / 64; C = (st & 1) * 32 + (swz % 64) / 2; }
__host__ __device__ __forceinline__ int perm32(int rho) { const int n = rho >> 4, i = rho & 15; return 8 * (i >> 2) + 4 * n + (i & 3); }

struct Unit { int pm, pn, g; size_t aoff, boff; };
struct Gemm { const bf16_t* A; const bf16_t* Bt; int lda, ldb, K; };

struct StaticOrder {
    int nM, nN, nwg, G, c, pm_per_batch; size_t bstride;
    __device__ void init(int M, int N, int G_, int c_, int pmpb, size_t bs) { nM = M / BM; nN = N / BM; nwg = nM * nN; G = G_; c = c_; pm_per_batch = pmpb; bstride = bs; }
    __device__ bool next(int i, Unit& u) const {
        const long L = (long)i * G + c; if (L >= nwg) return false;
        int wgid = (int)L; { const int q = nwg / NXCD, r = nwg % NXCD, xcd = wgid % NXCD, off = wgid / NXCD; wgid = (xcd < r ? xcd * (q + 1) : r * (q + 1) + (xcd - r) * q) + off; }
        const int nig = WGM * nN, gid = wgid / nig, fm = gid * WGM, gsz = (nM - fm) < WGM ? (nM - fm) : WGM;
        u.pm = fm + ((wgid % nig) % gsz); u.pn = (wgid % nig) / gsz; u.g = u.pm / pm_per_batch; u.aoff = 0; u.boff = (size_t)u.g * bstride; return true;
    }
};
struct GroupOrder {
    int nM, nN, ngroups, G, c; size_t astride, bstride;
    __device__ void init(int nM_, int nN_, int ng, int G_, int c_, size_t as, size_t bs) { nM = nM_; nN = nN_; ngroups = ng; G = G_; c = c_; astride = as; bstride = bs; }
    __device__ bool next(int i, Unit& u) const {
        const long L = (long)i * G + c; if (L >= (long)ngroups * nM * nN) return false;
        const int g = (int)(L / (nM * nN)), r = (int)(L % (nM * nN)); u.g = g; u.pm = r / nN; u.pn = r % nN; u.aoff = (size_t)g * astride; u.boff = (size_t)g * bstride; return true;
    }
};

__device__ __forceinline__ unsigned cvt_pk_bf16(float lo, float hi) { unsigned r; asm volatile("v_cvt_pk_bf16_f32 %0, %1, %2" : "=v"(r) : "v"(lo), "v"(hi)); return r; }
__device__ __forceinline__ float bf_lo(unsigned w) { return __uint_as_float(w << 16); }
__device__ __forceinline__ float bf_hi(unsigned w) { return __uint_as_float(w & 0xffff0000u); }
__device__ __forceinline__ float fsigmoid(float x) { return __builtin_amdgcn_rcpf(1.0f + __expf(-x)); }
__device__ __forceinline__ float fsilu(float x) { return x * fsigmoid(x); }
__device__ __forceinline__ float fgelu_tanh(float y) { return y * fsigmoid(1.5957691216f * (y + 0.044715f * y * y * y)); }
__device__ __forceinline__ float flogsigmoid(float x) { return fminf(x, 0.f) - __logf(1.0f + __expf(-fabsf(x))); }
__device__ __forceinline__ float row_rstd(const float* rowsq, int row) {
    const f32x4* p = (const f32x4*)(rowsq + (size_t)row * 16); const f32x4 a = p[0], b = p[1], c = p[2], d = p[3];
    const float s = ((a[0] + a[1]) + (a[2] + a[3])) + ((b[0] + b[1]) + (b[2] + b[3])) + ((c[0] + c[1]) + (c[2] + c[3])) + ((d[0] + d[1]) + (d[2] + d[3]));
    return 1.0f / sqrtf(s * (1.0f / 1024.0f) + 1e-6f);
}


struct EpiIn0 {
    static constexpr bool PERM = true, AFTER_DRAIN = false;
    const float* rowsq; const float* cvec; bf16_t* Ut; bf16_t* QFG; bf16_t* VT;
    __device__ __forceinline__ void operator()(const f32x4 (&acc)[2][2][4][2], const Unit& u, int wr, int wc, int fr, int fq) const {
        f32x4 cv[2][2];
#pragma unroll
        for (int bj = 0; bj < 2; ++bj)
#pragma unroll
            for (int n = 0; n < 2; ++n) cv[bj][n] = *(const f32x4*)(cvec + u.g * 2560 + u.pn * BM + bj * HALF + wc * 32 + 8 * fq + 4 * n);
#pragma unroll
        for (int ai = 0; ai < 2; ++ai)
#pragma unroll
        for (int m = 0; m < 4; ++m) { const int row = u.pm * BM + ai * HALF + wr * 64 + m * 16 + fr;
            const float rs = row_rstd(rowsq, row);
#pragma unroll
            for (int bj = 0; bj < 2; ++bj) { const int c0 = u.pn * BM + bj * HALF + wc * 32 + 8 * fq;
                const f32x4 v0 = acc[ai][bj][m][0] * rs + cv[bj][0], v1 = acc[ai][bj][m][1] * rs + cv[bj][1];
                u32x4 w; w.x = cvt_pk_bf16(v0[0], v0[1]); w.y = cvt_pk_bf16(v0[2], v0[3]); w.z = cvt_pk_bf16(v1[0], v1[1]); w.w = cvt_pk_bf16(v1[2], v1[3]);
                if (u.pn == 6 || u.pn == 7) { bf16_t* d = VT + ((size_t)(row >> 6) * 512 + (c0 - 1536)) * 64 + (row & 63);
                    d[0] = (bf16_t)w.x; d[64] = (bf16_t)(w.x >> 16); d[128] = (bf16_t)w.y; d[192] = (bf16_t)(w.y >> 16); d[256] = (bf16_t)w.z; d[320] = (bf16_t)(w.z >> 16); d[384] = (bf16_t)w.w; d[448] = (bf16_t)(w.w >> 16); }
                else { bf16_t* dst = (u.pn < 2) ? Ut + ((size_t)((c0 >> 4) * 1024 + (row >> 5)) * 640 + (row & 31) * 16 + (c0 & 15)) : QFG + (size_t)row * 1536 + (u.pn < 6 ? c0 - 512 : c0 - 1024);
                    *(u32x4*)dst = w; } }
        }
    }
};
struct EpiS5X {
    static constexpr bool PERM = false, AFTER_DRAIN = false;
    float* Xloc;
    __device__ __forceinline__ void operator()(const f32x4 (&acc)[2][2][4][2], const Unit& u, int wr, int wc, int fr, int fq) const {
#pragma unroll
        for (int ai = 0; ai < 2; ++ai)
#pragma unroll
        for (int m = 0; m < 4; ++m) { const int row = u.pm * BM + ai * HALF + wr * 64 + m * 16 + fr;
#pragma unroll
            for (int n = 0; n < 2; ++n) *(f32x4*)(Xloc + ((size_t)u.g * 1024 + row) * 128 + wc * 32 + 16 * n + 4 * fq) = acc[ai][0][m][n];
        }
    }
};
struct EpiS5Y {
    static constexpr bool PERM = true, AFTER_DRAIN = false;
    bf16_t* Y;
    __device__ __forceinline__ void operator()(const f32x4 (&acc)[2][2][4][2], const Unit& u, int wr, int wc, int fr, int fq) const {
#pragma unroll
        for (int ai = 0; ai < 2; ++ai)
#pragma unroll
        for (int m = 0; m < 4; ++m) { const int row = u.pm * BM + ai * HALF + wr * 64 + m * 16 + fr;
#pragma unroll
            for (int bj = 0; bj < 2; ++bj) { const int c0 = u.pn * BM + bj * HALF + wc * 32 + 8 * fq;
                const f32x4 a0 = acc[ai][bj][m][0], a1 = acc[ai][bj][m][1];
                u32x4 w; w.x = cvt_pk_bf16(fgelu_tanh(a0[0]), fgelu_tanh(a0[1])); w.y = cvt_pk_bf16(fgelu_tanh(a0[2]), fgelu_tanh(a0[3]));
                w.z = cvt_pk_bf16(fgelu_tanh(a1[0]), fgelu_tanh(a1[1])); w.w = cvt_pk_bf16(fgelu_tanh(a1[2]), fgelu_tanh(a1[3]));
                *(u32x4*)(Y + ((size_t)row * 32 + (c0 >> 4)) * 512 + u.g * 16 + (c0 & 15)) = w; }
        }
    }
};
struct EpiGlu {
    static constexpr bool PERM = true, AFTER_DRAIN = false;
    const bf16_t* Y; const float* bias; bf16_t* O; int ldo;
    __device__ __forceinline__ void operator()(const f32x4 (&acc)[2][2][4][2], const Unit& u, int wr, int wc, int fr, int fq) const {
        f32x4 bv[2][2];
#pragma unroll
        for (int bj = 0; bj < 2; ++bj)
#pragma unroll
            for (int n = 0; n < 2; ++n) bv[bj][n] = *(const f32x4*)(bias + u.pn * BM + bj * HALF + wc * 32 + 8 * fq + 4 * n);
#pragma unroll
        for (int ai = 0; ai < 2; ++ai)
#pragma unroll
        for (int m = 0; m < 4; ++m) { const int row = u.pm * BM + ai * HALF + wr * 64 + m * 16 + fr;
#pragma unroll
            for (int bj = 0; bj < 2; ++bj) { const int c0 = u.pn * BM + bj * HALF + wc * 32 + 8 * fq;
                const u32x4 yw = *(const u32x4*)(Y + (size_t)row * 512 + c0);
                const f32x4 a0 = acc[ai][bj][m][0] + bv[bj][0], a1 = acc[ai][bj][m][1] + bv[bj][1];
                u32x4 w; w.x = cvt_pk_bf16(bf_lo(yw.x) * fsigmoid(a0[0]), bf_hi(yw.x) * fsigmoid(a0[1])); w.y = cvt_pk_bf16(bf_lo(yw.y) * fsigmoid(a0[2]), bf_hi(yw.y) * fsigmoid(a0[3]));
                w.z = cvt_pk_bf16(bf_lo(yw.z) * fsigmoid(a1[0]), bf_hi(yw.z) * fsigmoid(a1[1])); w.w = cvt_pk_bf16(bf_lo(yw.w) * fsigmoid(a1[2]), bf_hi(yw.w) * fsigmoid(a1[3]));
                *(u32x4*)(O + (size_t)row * ldo + c0) = w; }
        }
    }
};
struct EpiResid {
    static constexpr bool PERM = true, AFTER_DRAIN = false;
    const float* xold; float* xnew; bf16_t* xb; float* rowsq; const float* gate; int gstride;
    __device__ __forceinline__ void operator()(const f32x4 (&acc)[2][2][4][2], const Unit& u, int wr, int wc, int fr, int fq) const {
        f32x4 gv[2][2];
#pragma unroll
        for (int bj = 0; bj < 2; ++bj)
#pragma unroll
            for (int n = 0; n < 2; ++n) gv[bj][n] = *(const f32x4*)(gate + u.g * gstride + u.pn * BM + bj * HALF + wc * 32 + 8 * fq + 4 * n);
#pragma unroll
        for (int ai = 0; ai < 2; ++ai)
#pragma unroll
        for (int m = 0; m < 4; ++m) { const int row = u.pm * BM + ai * HALF + wr * 64 + m * 16 + fr;
            float sq = 0.f;
#pragma unroll
            for (int bj = 0; bj < 2; ++bj) { const size_t off = (size_t)row * 1024 + u.pn * BM + bj * HALF + wc * 32 + 8 * fq;
                const f32x4 x0 = *(const f32x4*)(xold + off), x1 = *(const f32x4*)(xold + off + 4);
                const f32x4 v0 = x0 + gv[bj][0] * acc[ai][bj][m][0], v1 = x1 + gv[bj][1] * acc[ai][bj][m][1];
                *(f32x4*)(xnew + off) = v0; *(f32x4*)(xnew + off + 4) = v1;
                sq += (v0[0] * v0[0] + v0[1] * v0[1]) + (v0[2] * v0[2] + v0[3] * v0[3]) + (v1[0] * v1[0] + v1[1] * v1[1]) + (v1[2] * v1[2] + v1[3] * v1[3]);
                u32x4 w; w.x = cvt_pk_bf16(v0[0], v0[1]); w.y = cvt_pk_bf16(v0[2], v0[3]); w.z = cvt_pk_bf16(v1[0], v1[1]); w.w = cvt_pk_bf16(v1[2], v1[3]);
                *(u32x4*)(xb + off) = w; }
            sq += __shfl_xor(sq, 16); sq += __shfl_xor(sq, 32);
            if (fq == 0) rowsq[(size_t)row * 16 + u.pn * 4 + wc] = sq;
        }
    }
};
struct EpiFfnUp {
    static constexpr bool PERM = true, AFTER_DRAIN = false;
    const float* rowsq; const float* cvec; bf16_t* H;
    __device__ __forceinline__ void operator()(const f32x4 (&acc)[2][2][4][2], const Unit& u, int wr, int wc, int fr, int fq) const {
        f32x4 cv[2][2];
#pragma unroll
        for (int bj = 0; bj < 2; ++bj)
#pragma unroll
            for (int n = 0; n < 2; ++n) cv[bj][n] = *(const f32x4*)(cvec + u.g * 5632 + u.pn * BM + bj * HALF + wc * 32 + 8 * fq + 4 * n);
#pragma unroll
        for (int ai = 0; ai < 2; ++ai)
#pragma unroll
        for (int m = 0; m < 4; ++m) { const int row = u.pm * BM + ai * HALF + wr * 64 + m * 16 + fr;
            const float rs = row_rstd(rowsq, row);
            const f32x4 a0 = acc[ai][0][m][0] * rs + cv[0][0], a1 = acc[ai][0][m][1] * rs + cv[0][1], b0 = acc[ai][1][m][0] * rs + cv[1][0], b1 = acc[ai][1][m][1] * rs + cv[1][1];
            u32x4 w; w.x = cvt_pk_bf16(fsilu(a0[0]) * b0[0], fsilu(a0[1]) * b0[1]); w.y = cvt_pk_bf16(fsilu(a0[2]) * b0[2], fsilu(a0[3]) * b0[3]);
            w.z = cvt_pk_bf16(fsilu(a1[0]) * b1[0], fsilu(a1[1]) * b1[1]); w.w = cvt_pk_bf16(fsilu(a1[2]) * b1[2], fsilu(a1[3]) * b1[3]);
            *(u32x4*)(H + (size_t)row * 2816 + u.pn * HALF + wc * 32 + 8 * fq) = w;
        }
    }
};
struct EpiIn1 {
    static constexpr bool PERM = true, AFTER_DRAIN = false;
    const float* rowsq; const float* cvec; const float* ba; bf16_t* Z; bf16_t* VT;
    __device__ __forceinline__ void operator()(const f32x4 (&acc)[2][2][4][2], const Unit& u, int wr, int wc, int fr, int fq) const {
        f32x4 cv[2][2];
#pragma unroll
        for (int bj = 0; bj < 2; ++bj)
#pragma unroll
            for (int n = 0; n < 2; ++n) { const int c = u.pn * BM + bj * HALF + wc * 32 + 8 * fq + 4 * n; cv[bj][n] = *(const f32x4*)(cvec + u.g * 3584 + c); if (u.pn >= 12) cv[bj][n] += *(const f32x4*)(ba + c - 3072); }
#pragma unroll
        for (int ai = 0; ai < 2; ++ai)
#pragma unroll
        for (int m = 0; m < 4; ++m) { const int row = u.pm * BM + ai * HALF + wr * 64 + m * 16 + fr;
            const float rs = row_rstd(rowsq, row);
#pragma unroll
            for (int bj = 0; bj < 2; ++bj) { const int c0 = u.pn * BM + bj * HALF + wc * 32 + 8 * fq;
                f32x4 v0 = acc[ai][bj][m][0] * rs + cv[bj][0], v1 = acc[ai][bj][m][1] * rs + cv[bj][1];
                if (u.pn < 2) { v0 = v0 * 0.08838834764831845f; v1 = v1 * 0.08838834764831845f; }
                if (u.pn >= 12) {
#pragma unroll
                    for (int e = 0; e < 4; ++e) { v0[e] = flogsigmoid(v0[e]); v1[e] = flogsigmoid(v1[e]); } }
                u32x4 w; w.x = cvt_pk_bf16(v0[0], v0[1]); w.y = cvt_pk_bf16(v0[2], v0[3]); w.z = cvt_pk_bf16(v1[0], v1[1]); w.w = cvt_pk_bf16(v1[2], v1[3]);
                if (u.pn >= 4 && u.pn < 8) { bf16_t* d = VT + ((size_t)(row >> 6) * 1024 + (c0 - 1024)) * 64 + (row & 63);
                    d[0] = (bf16_t)w.x; d[64] = (bf16_t)(w.x >> 16); d[128] = (bf16_t)w.y; d[192] = (bf16_t)(w.y >> 16); d[256] = (bf16_t)w.z; d[320] = (bf16_t)(w.z >> 16); d[384] = (bf16_t)w.w; d[448] = (bf16_t)(w.w >> 16); }
                else *(u32x4*)(Z + (size_t)row * 2560 + (u.pn < 4 ? c0 : c0 - 1024)) = w; }
        }
    }
};

template <class Epi, class Sched, bool ALIGN_EPI>
__device__ __forceinline__ void gemm_phase(PG8_LAS unsigned char* lds, const Gemm g, const Sched& S, const Epi& E) {
    const int tid = threadIdx.x, wid = __builtin_amdgcn_readfirstlane(tid >> 6), lane = tid & 63, wr = wid >> 2, wc = wid & 3, fr = lane & 15, fq = lane >> 4;
    const int K = g.K, nt = K / BK;
    unsigned voffA[2], voffB[2];
#pragma unroll
    for (int i = 0; i < 2; ++i) { int R, C; stage_rc(tid * 16 + i * 8192, R, C); const int Rb = Epi::PERM ? ((R & ~31) + perm32(R & 31)) : R;
        voffA[i] = (unsigned)(R * g.lda + C) * 2u; voffB[i] = (unsigned)(Rb * g.ldb + C) * 2u; }
    const size_t kstep = (size_t)(BK * 2);
    const size_t hstepA = (size_t)HALF * g.lda * 2, hstepB = (size_t)HALF * g.ldb * 2;
    const unsigned ldsw = (unsigned)wid * 1024u;
    const int aoff = lds_byte(wr * 64 + fr, fq * 8), boff = lds_byte(wc * 32 + fr, fq * 8);
#define PG8_SA(b, h) (((b) * 2 + (h)) * HTB)
#define PG8_SB(b, h) ((4 + (b) * 2 + (h)) * HTB)
#define PG8_STAGE(bufoff, gbase, voff) do { _Pragma("unroll") for (int _i = 0; _i < 2; ++_i) \
        __builtin_amdgcn_global_load_lds((const unsigned*)((const char*)(gbase) + (voff)[_i]), (PG8_LAS unsigned*)(lds + (bufoff) + ldsw + _i * 8192), 16, 0, 0); } while (0)
#define PG8_LDA(dst, b, h) do { _Pragma("unroll") for (int m = 0; m < 4; ++m) _Pragma("unroll") for (int k = 0; k < 2; ++k) dst[m][k] = *(const PG8_LAS bf16x8*)(lds + PG8_SA(b, h) + aoff + m * 2048 + k * 1024); } while (0)
#define PG8_LDB(dst, b, h) do { _Pragma("unroll") for (int n = 0; n < 2; ++n) _Pragma("unroll") for (int k = 0; k < 2; ++k) dst[n][k] = *(const PG8_LAS bf16x8*)(lds + PG8_SB(b, h) + boff + n * 2048 + k * 1024); } while (0)
#define PG8_MMA(ai, bj, At, Bt) do { __builtin_amdgcn_s_setprio(1); _Pragma("unroll") for (int m = 0; m < 4; ++m) _Pragma("unroll") for (int n = 0; n < 2; ++n) _Pragma("unroll") for (int k = 0; k < 2; ++k) \
        acc[ai][bj][m][n] = __builtin_amdgcn_mfma_f32_16x16x32_bf16(Bt[n][k], At[m][k], acc[ai][bj][m][n], 0, 0, 0); __builtin_amdgcn_s_setprio(0); } while (0)
#define PG8_WAIT_V(n) asm volatile("s_waitcnt vmcnt(" #n ")" ::: "memory")
#define PG8_WAIT_L(n) asm volatile("s_waitcnt lgkmcnt(" #n ")" ::: "memory")
#define PG8_BAR __builtin_amdgcn_s_barrier()
#define PG8_SCHED __builtin_amdgcn_sched_barrier(0)
    Unit cur, nxt; int ui = 0;
    if (!S.next(0, cur)) return;
    f32x4 acc[2][2][4][2];
#pragma unroll
    for (int a = 0; a < 2; ++a)
#pragma unroll
        for (int b = 0; b < 2; ++b)
#pragma unroll
            for (int m = 0; m < 4; ++m)
#pragma unroll
                for (int n = 0; n < 2; ++n) acc[a][b][m][n] = (f32x4){0.f, 0.f, 0.f, 0.f};
    bf16x8 At[4][2], B0[2][2], B1[2][2];
    const char* cA = (const char*)g.A + cur.aoff + (size_t)cur.pm * 2 * hstepA; const char* cB = (const char*)g.Bt + cur.boff + (size_t)cur.pn * 2 * hstepB;
    PG8_STAGE(PG8_SB(0, 0), cB, voffB); PG8_STAGE(PG8_SB(0, 1), cB + hstepB, voffB); PG8_STAGE(PG8_SA(0, 0), cA, voffA); PG8_STAGE(PG8_SA(0, 1), cA + hstepA, voffA);
    if (wr == 1) PG8_BAR;
    PG8_WAIT_V(2); PG8_BAR;
    PG8_STAGE(PG8_SB(1, 0), cB + kstep, voffB); PG8_STAGE(PG8_SA(1, 0), cA + kstep, voffA); PG8_STAGE(PG8_SB(1, 1), cB + hstepB + kstep, voffB);
    PG8_WAIT_V(6); PG8_BAR;
    for (;;) {
        const bool has_next = S.next(ui + 1, nxt);
        const char* nA = has_next ? (const char*)g.A + nxt.aoff + (size_t)nxt.pm * 2 * hstepA : cA; const char* nB = has_next ? (const char*)g.Bt + nxt.boff + (size_t)nxt.pn * 2 * hstepB : cB;
        for (int t = 0; t < nt; t += 2) {
            const bool last = (t == nt - 2);
            const char* a1 = cA + (size_t)(t + 1) * kstep;
            const char* a2 = last ? nA : cA + (size_t)(t + 2) * kstep; const char* b2 = last ? nB : cB + (size_t)(t + 2) * kstep;
            const char* a3 = a2 + kstep; const char* b3 = b2 + kstep;
            PG8_LDB(B0, 0, 0); PG8_LDB(B1, 0, 1); PG8_SCHED; PG8_LDA(At, 0, 0); PG8_STAGE(PG8_SA(1, 1), a1 + hstepA, voffA);
            PG8_WAIT_V(8); PG8_WAIT_L(0); PG8_BAR; PG8_MMA(0, 0, At, B0); PG8_MMA(0, 1, At, B1); PG8_BAR; PG8_SCHED;
            PG8_LDA(At, 0, 1); PG8_STAGE(PG8_SB(0, 0), b2, voffB); PG8_STAGE(PG8_SB(0, 1), b2 + hstepB, voffB); PG8_STAGE(PG8_SA(0, 0), a2, voffA);
            PG8_WAIT_V(8); PG8_WAIT_L(0); PG8_BAR; PG8_MMA(1, 0, At, B0); PG8_MMA(1, 1, At, B1); PG8_BAR; PG8_SCHED;
            PG8_LDB(B0, 1, 0); PG8_LDB(B1, 1, 1); PG8_SCHED; PG8_LDA(At, 1, 0); PG8_STAGE(PG8_SA(0, 1), a2 + hstepA, voffA);
            PG8_WAIT_V(8); PG8_WAIT_L(0); PG8_BAR; PG8_MMA(0, 0, At, B0); PG8_MMA(0, 1, At, B1); PG8_BAR; PG8_SCHED;
            PG8_LDA(At, 1, 1); PG8_STAGE(PG8_SB(1, 0), b3, voffB); PG8_STAGE(PG8_SB(1, 1), b3 + hstepB, voffB); PG8_STAGE(PG8_SA(1, 0), a3, voffA);
            PG8_WAIT_V(8); PG8_WAIT_L(0); PG8_BAR; PG8_MMA(1, 0, At, B0); PG8_MMA(1, 1, At, B1); PG8_BAR; PG8_SCHED;
        }
        if constexpr (ALIGN_EPI) { if (wr == 0) PG8_BAR; }
        E(acc, cur, wr, wc, fr, fq);
        if (!has_next) break;
#pragma unroll
        for (int a = 0; a < 2; ++a)
#pragma unroll
            for (int b = 0; b < 2; ++b)
#pragma unroll
                for (int m = 0; m < 4; ++m)
#pragma unroll
                    for (int n = 0; n < 2; ++n) acc[a][b][m][n] = (f32x4){0.f, 0.f, 0.f, 0.f};
        cur = nxt; cA = nA; cB = nB; ++ui;
        if constexpr (ALIGN_EPI) { if (wr == 1) PG8_BAR; }
    }
    PG8_WAIT_V(0);
    if constexpr (!ALIGN_EPI) { if (wr == 0) PG8_BAR; }
    PG8_BAR;
#undef PG8_SA
#undef PG8_SB
#undef PG8_STAGE
#undef PG8_LDA
#undef PG8_LDB
#undef PG8_MMA
#undef PG8_WAIT_V
#undef PG8_WAIT_L
#undef PG8_BAR
#undef PG8_SCHED
}
}
constexpr int NWAVES = 8;
constexpr int BATCH = 2, SEQ = 16384, D = 1024, T = BATCH * SEQ;
constexpr int FF = 2816, S5W = 512, S5G = 32, S5P = 64, LC = 32, NCH = T / LC  , UTP = LC * 16 + 128  ;
constexpr int N_IN0 = 2560, N_IN1 = 3584, N_UP = 5632;
constexpr float EPS = 1e-6f;
constexpr size_t MiB = 1u << 20;
constexpr size_t WS_CTL = 0, CTL_ZERO_BYTES = 1 * MiB;
constexpr size_t WS_MOD = 1 * MiB;
constexpr size_t WS_CV = 1 * MiB + 128 * 1024;
constexpr int CV_IN0 = 0, CV_UP0 = 2 * N_IN0, CV_IN1 = CV_UP0 + 2 * N_UP, CV_UP1 = CV_IN1 + 2 * N_IN1;
constexpr size_t WS_S5LAM = 1 * MiB + 512 * 1024;
constexpr size_t WS_WIN0 = 2 * MiB, WS_WOUT0 = 12 * MiB, WS_WGLU = 14 * MiB, WS_S5F = 15 * MiB, WS_S5T = 23 * MiB, WS_W13_0 = 43 * MiB, WS_W2_0 = 65 * MiB,
                 WS_WIN1 = 71 * MiB, WS_WOUT1 = 85 * MiB, WS_W13_1 = 87 * MiB, WS_W2_1 = 109 * MiB;
constexpr size_t WS_ROWSQ = 115 * MiB, WS_XB = 117 * MiB, WS_POOL = 181 * MiB, WS_END = 512 * MiB;
constexpr size_t WS_UT = WS_POOL, WS_QFG = 221 * MiB, WS_VT0 = 317 * MiB, WS_XLOC = 349 * MiB, WS_YGELU = 365 * MiB, WS_MIXED = 397 * MiB, WS_HGA = 461 * MiB, WS_HGD = 477 * MiB;
constexpr size_t WS_WA = 349 * MiB;
constexpr size_t WS_HID = WS_POOL;
constexpr size_t WS_Z1 = WS_POOL, WS_VT1 = 341 * MiB, WS_MIXED2 = 405 * MiB, WS_GLA_A = 469 * MiB, WS_GLA_D = 501 * MiB;
static_assert(WS_WIN0 + (size_t)2 * N_IN0 * D * 2 <= WS_WOUT0 && WS_S5F + (size_t)S5G * 256 * 512 * 2 <= WS_S5T && WS_S5T + (size_t)S5G * 512 * UTP * 2 <= WS_W13_0 && WS_W13_0 + (size_t)2 * N_UP * D * 2 <= WS_W2_0 &&
              WS_W2_0 + (size_t)D * FF * 2 <= WS_WIN1 && WS_WIN1 + (size_t)2 * N_IN1 * D * 2 <= WS_WOUT1 && WS_W13_1 + (size_t)2 * N_UP * D * 2 <= WS_W2_1 && WS_W2_1 + (size_t)D * FF * 2 <= WS_ROWSQ, "weights map");
static_assert(WS_UT + (size_t)S5G * NCH * UTP * 2 <= WS_QFG && WS_QFG + (size_t)T * 1536 * 2 <= WS_VT0 && WS_VT0 + (size_t)T * 512 * 2 <= WS_XLOC && WS_XLOC + (size_t)S5G * NCH * 128 * 4 <= WS_YGELU && WS_YGELU + (size_t)T * 512 * 2 <= WS_MIXED &&
              WS_MIXED + (size_t)T * D * 2 <= WS_HGA && WS_HGA + (size_t)8 * 32 * 128 * 128 * 4 <= WS_HGD && WS_HID + (size_t)T * FF * 2 <= WS_END && WS_Z1 + (size_t)T * 2560 * 2 <= WS_VT1 && WS_VT1 + (size_t)T * D * 2 <= WS_MIXED2 &&
              WS_MIXED2 + (size_t)T * D * 2 <= WS_GLA_A && WS_GLA_A + (size_t)8 * 32 * 128 * 256 * 4 <= WS_GLA_D && WS_GLA_D + 8 * 32 * 128 * 4 <= WS_END, "pool map");
constexpr int CW_BAR = 4096;

constexpr int RING_OFF = 0, RING_BYTES = 131072;
constexpr int LDSCTL_OFF = RING_BYTES, MISC_OFF = LDSCTL_OFF + 320;
constexpr int LDS_BYTES = 147456;
static_assert(MISC_OFF + 128 <= LDS_BYTES, "LDS map");

#define GAS __attribute__((address_space(1)))
#define LAS __attribute__((address_space(3)))
typedef unsigned short bf16;
typedef unsigned v4u __attribute__((ext_vector_type(4)));
typedef unsigned v2u __attribute__((ext_vector_type(2)));
typedef float f32x4 __attribute__((ext_vector_type(4)));
typedef GAS unsigned gu32;
#define RLX_AGENT __ATOMIC_RELAXED, __HIP_MEMORY_SCOPE_AGENT
#define LDS_WAIT() asm volatile("s_waitcnt lgkmcnt(0)" ::: "memory")
#define VM_WAIT() asm volatile("s_waitcnt vmcnt(0)" ::: "memory")
__device__ __forceinline__ unsigned f2bf(float f) { unsigned u = __builtin_bit_cast(unsigned, f); return (u + 0x7fffu + ((u >> 16) & 1u)) >> 16; }
__device__ __forceinline__ unsigned pk2(float lo, float hi) { return f2bf(lo) | (f2bf(hi) << 16); }
__device__ __forceinline__ float bf2f(bf16 v) { return __uint_as_float((unsigned)v << 16); }

#define XB_TMO      128
#define XB_XCNT(j)  (256  + 64 * (j))
#define XB_XSUB(j)  (1280 + 64 * (j))
#define XB_XGEN(j)  (2304 + 64 * (j))
#define XB_TOP      3328
#define XB_TOPGEN   3392
#define XCD_BAR_WORDS 3456
#define XB_SPIN_CAP (1u << 18)
__device__ __forceinline__ unsigned xb_ld(unsigned* p)              { return __hip_atomic_load(p, __ATOMIC_RELAXED, __HIP_MEMORY_SCOPE_AGENT); }
__device__ __forceinline__ unsigned xb_add(unsigned* p, unsigned v) { return __hip_atomic_fetch_add(p, v, __ATOMIC_RELAXED, __HIP_MEMORY_SCOPE_AGENT); }
__device__ __forceinline__ unsigned xb_xcc_id() { return (unsigned)__builtin_amdgcn_s_getreg((3 << 11) | 20) & 0xFu; }
#define XB_SPIN(cond, bar) do { unsigned _sp = 0; while (cond) { __builtin_amdgcn_s_sleep(1); \
    if ((++_sp & 255u) == 0u) { if (xb_ld(&(bar)[XB_TMO])) break; if (_sp > XB_SPIN_CAP) { atomicAdd(&(bar)[XB_TMO], 1u); break; } } } } while (0)
struct XcdBarrier { unsigned* bar; unsigned x; volatile LAS unsigned* st; };
__device__ __forceinline__ XcdBarrier xcd_barrier_post(unsigned* bar, volatile LAS unsigned* st) {
    XcdBarrier b; b.bar = bar; b.x = xb_xcc_id(); b.st = st;
    if (threadIdx.x == 0) (void)xb_add(&bar[XB_XCNT(b.x)], 1u);
    return b;
}
__device__ __forceinline__ void xcd_barrier_complete(unsigned* bar, unsigned x, unsigned& nloc, unsigned& nx) {
    const unsigned G = gridDim.x * gridDim.y * gridDim.z;
    unsigned sum, cnt, mine, sp = 0u;
    for (;;) {
        sum = 0u; cnt = 0u; mine = 0u;
#pragma unroll
        for (unsigned j = 0; j < 16; ++j) { const unsigned c = xb_ld(&bar[XB_XCNT(j)]); sum += c; cnt += (c > 0u) ? 1u : 0u; mine = (j == x) ? c : mine; }
        if (sum == G) break;
        __builtin_amdgcn_s_sleep(1);
        if ((++sp & 255u) == 0u) { if (xb_ld(&bar[XB_TMO])) break; if (sp > XB_SPIN_CAP) { atomicAdd(&bar[XB_TMO], 1u); break; } }
    }
    nloc = mine > 0u ? mine : 1u; nx = cnt > 0u ? cnt : 1u;
}
__device__ __forceinline__ void xcd_barrier(const XcdBarrier& b) {
    asm volatile("s_waitcnt vmcnt(0)" ::: "memory");
    __syncthreads();
    if (threadIdx.x == 0) {
        unsigned* bar = b.bar;
        __builtin_amdgcn_s_waitcnt(0);
        unsigned nloc = b.st[0], nx = b.st[1];
        if (nloc == 0u) { xcd_barrier_complete(bar, b.x, nloc, nx); b.st[0] = nloc; b.st[1] = nx; }
        const unsigned old = xb_add(&bar[XB_XSUB(b.x)], 1u);
        const unsigned gen = old / nloc;
        if (old + 1u == (gen + 1u) * nloc) {
            __builtin_amdgcn_fence(__ATOMIC_RELEASE, "agent");
            asm volatile("s_waitcnt vmcnt(0)" ::: "memory");
            const unsigned og = xb_add(&bar[XB_TOP], 1u);
            const unsigned tg = og / nx;
            if (og + 1u == (tg + 1u) * nx) xb_add(&bar[XB_TOPGEN], 1u);
            else XB_SPIN(xb_ld(&bar[XB_TOPGEN]) == tg, bar);
            __builtin_amdgcn_fence(__ATOMIC_ACQUIRE, "agent");
            xb_add(&bar[XB_XGEN(b.x)], 1u);
            asm volatile("s_waitcnt vmcnt(0)" ::: "memory");
        } else {
            XB_SPIN(xb_ld(&bar[XB_XGEN(b.x)]) == gen, bar);
            __builtin_amdgcn_fence(__ATOMIC_ACQUIRE, "agent");
            asm volatile("s_waitcnt vmcnt(0)" ::: "memory");
        }
    }
    __syncthreads();
}

struct Args { const float* in[30]; float* out; unsigned char* ws; int ph_lo, ph_hi; };
enum InIdx { I_X = 0, I_C, I_ADAW, I_ADAB, I_NMG, I_NFG, I_EVWIN, I_EVWOUT, I_LAMRE, I_LAMIM, I_BRE, I_BIM, I_CRE, I_CIM, I_S5D, I_LOGSTEP, I_WGLU, I_BGLU, I_LBLOG, I_HGNORM,
             I_ODWIN, I_ODWA1, I_ODWA2, I_ODBA, I_GLANORM, I_ODWOUT, I_W1, I_W3, I_W2, I_FNORM };
struct Frame {
    LAS unsigned char* lds;
    volatile LAS unsigned* MISC;
    gu32* ctl;
    int tid, lane, wave, vcu, G;
    const float* const* in; float* out; unsigned char* ws;
};
__device__ __forceinline__ float wave_sum(float v) {
#pragma unroll
    for (int o = 1; o < 64; o <<= 1) v += __shfl_xor(v, o);
    return v;
}
__device__ __forceinline__ float dsilu(float x) { return x / (1.0f + expf(-x)); }

__device__ __forceinline__ void tile_store(const LAS float* scr, bf16* dst  , int ldk, const float* sc  , int lane) {
    const int c = lane & 7;
    float s8[8];
#pragma unroll
    for (int j = 0; j < 8; ++j) s8[j] = sc ? sc[8 * c + j] : 1.0f;
#pragma unroll
    for (int j = 0; j < 4; ++j) { const int n = (lane >> 3) + 8 * j; const LAS float* s = scr + (8 * c) * 33 + n;
        v4u o; o.x = pk2(s[0 * 33] * s8[0], s[1 * 33] * s8[1]); o.y = pk2(s[2 * 33] * s8[2], s[3 * 33] * s8[3]); o.z = pk2(s[4 * 33] * s8[4], s[5 * 33] * s8[5]); o.w = pk2(s[6 * 33] * s8[6], s[7 * 33] * s8[7]);
        *(GAS v4u*)(dst + (size_t)n * ldk + 8 * c) = o; }
}
__device__ __forceinline__ void tile_load(const float* W  , int ldw, LAS float* scr, int lane) {
    const int nn = (lane & 7) * 4, kr = lane >> 3; f32x4 v[8];
#pragma unroll
    for (int i = 0; i < 8; ++i) v[i] = *(const GAS f32x4*)(W + (size_t)(kr + 8 * i) * ldw + nn);
#pragma unroll
    for (int i = 0; i < 8; ++i) { LAS float* d = scr + (kr + 8 * i) * 33 + nn; d[0] = v[i].x; d[1] = v[i].y; d[2] = v[i].z; d[3] = v[i].w; }
}
__device__ __forceinline__ void p_transpose_item(const float* W, int K, int N, bf16* WT, LAS float* scr, int item, int lane) {
    const int nblk = N / 32, kb = item / nblk, nb = item % nblk, k0 = 64 * kb, n0 = 32 * nb;
    tile_load(W + (size_t)k0 * N + n0, N, scr, lane);
    LDS_WAIT(); asm volatile("" ::: "memory");
    tile_store(scr, WT + (size_t)n0 * K + k0, K, nullptr, lane);
    LDS_WAIT(); asm volatile("" ::: "memory");
}

__device__ __forceinline__ void s5_constants(Frame& F, int g) {
    LAS float* PW = (LAS float*)(F.lds + RING_OFF);
    LAS float* BB = (LAS float*)(F.lds + RING_OFF + 17408);
    LAS float* CC = (LAS float*)(F.lds + RING_OFF + 25600);
    LAS float* KD = (LAS float*)(F.lds + RING_OFF + 33792);
    LAS float* QQ = (LAS float*)(F.lds + RING_OFF + 66560);
    const float* lam_re = F.in[I_LAMRE] + g * 64; const float* lam_im = F.in[I_LAMIM] + g * 64;
    const float* b_re = F.in[I_BRE] + g * 1024; const float* b_im = F.in[I_BIM] + g * 1024;
    const float* c_re = F.in[I_CRE] + g * 1024; const float* c_im = F.in[I_CIM] + g * 1024;
    if (F.tid < 64) { const int p = F.tid; const double dl = exp((double)F.in[I_LOGSTEP][g]);
        const double lr = lam_re[p], li = lam_im[p]; const double mag = exp(lr * dl); double sn, cs; sincos(li * dl, &sn, &cs);
        const double ar = mag * cs, ai = mag * sn;
        const double nr = ar - 1.0, ni = ai, den = lr * lr + li * li;
        QQ[p * 2] = (float)((nr * lr + ni * li) / den); QQ[p * 2 + 1] = (float)((ni * lr - nr * li) / den);
        double pr = 1.0, pi = 0.0;
        for (int d = 0; d <= LC; ++d) { PW[(d * 64 + p) * 2] = (float)pr; PW[(d * 64 + p) * 2 + 1] = (float)pi; const double tr = pr * ar - pi * ai, ti = pr * ai + pi * ar; pr = tr; pi = ti; } }
    for (int idx = F.tid; idx < 1024; idx += NWAVES * 64) { CC[idx * 2] = c_re[idx]; CC[idx * 2 + 1] = c_im[idx]; }
    __syncthreads();
    for (int idx = F.tid; idx < 1024; idx += NWAVES * 64) { const int p = idx >> 4; const float qr = QQ[p * 2], qi = QQ[p * 2 + 1], br = b_re[idx], bi = b_im[idx];
        BB[idx * 2] = qr * br - qi * bi; BB[idx * 2 + 1] = qr * bi + qi * br; }
    __syncthreads();
    { const int d = F.tid >> 4, ho0 = ((F.tid >> 2) & 3) * 4, hi0 = (F.tid & 3) * 4; float acc[4][4];
#pragma unroll
      for (int a = 0; a < 4; ++a)
#pragma unroll
          for (int q = 0; q < 4; ++q) acc[a][q] = 0.f;
      for (int p = 0; p < 64; ++p) { const float pr = PW[(d * 64 + p) * 2], pi = PW[(d * 64 + p) * 2 + 1]; float xr[4], xi[4];
#pragma unroll
          for (int a = 0; a < 4; ++a) { const float cr = CC[((ho0 + a) * 64 + p) * 2], ci = CC[((ho0 + a) * 64 + p) * 2 + 1]; xr[a] = cr * pr - ci * pi; xi[a] = cr * pi + ci * pr; }
          const f32x4 b0 = *(const LAS f32x4*)(BB + (p * 16 + hi0) * 2), b1 = *(const LAS f32x4*)(BB + (p * 16 + hi0) * 2 + 4);
          const float br[4] = {b0[0], b0[2], b1[0], b1[2]}, bi[4] = {b0[1], b0[3], b1[1], b1[3]};
#pragma unroll
          for (int a = 0; a < 4; ++a)
#pragma unroll
              for (int q = 0; q < 4; ++q) acc[a][q] += xr[a] * br[q] - xi[a] * bi[q]; }
#pragma unroll
      for (int a = 0; a < 4; ++a)
#pragma unroll
          for (int q = 0; q < 4; ++q) { float v = acc[a][q]; if (d == 0 && ho0 + a == hi0 + q) v += F.in[I_S5D][g * 16 + ho0 + a]; KD[(d * 16 + ho0 + a) * 16 + hi0 + q] = v; } }
    __syncthreads();
    bf16* Tg = (bf16*)(F.ws + WS_S5T) + (size_t)g * 512 * UTP;
    for (int idx = F.tid; idx < 512 * 64; idx += NWAVES * 64) { const int n = idx >> 6, kc = idx & 63, l = n >> 4, ho = n & 15, j = kc >> 1, hi0 = (kc & 1) * 8;
        v4u o = (v4u){0u, 0u, 0u, 0u};
        if (j <= l) { const LAS float* k = KD + ((l - j) * 16 + ho) * 16 + hi0; o.x = pk2(k[0], k[1]); o.y = pk2(k[2], k[3]); o.z = pk2(k[4], k[5]); o.w = pk2(k[6], k[7]); }
        *(GAS v4u*)(Tg + (size_t)n * UTP + kc * 8) = o; }
    for (int idx = F.tid; idx < 512 * 16; idx += NWAVES * 64) { const int n = idx >> 4, pc = idx & 15, l = n >> 4, ho = n & 15, im = pc >> 3, p0 = (pc & 7) * 8; float v[8];
#pragma unroll
        for (int e = 0; e < 8; ++e) { const int p = p0 + e; const float cr = CC[(ho * 64 + p) * 2], ci = CC[(ho * 64 + p) * 2 + 1], pr = PW[((l + 1) * 64 + p) * 2], pi = PW[((l + 1) * 64 + p) * 2 + 1];
            v[e] = im ? -(cr * pi + ci * pr) : (cr * pr - ci * pi); }
        v4u o; o.x = pk2(v[0], v[1]); o.y = pk2(v[2], v[3]); o.z = pk2(v[4], v[5]); o.w = pk2(v[6], v[7]);
        *(GAS v4u*)(Tg + (size_t)n * UTP + 512 + pc * 8) = o; }
    bf16* Fg = (bf16*)(F.ws + WS_S5F) + (size_t)g * 256 * 512;
    for (int idx = F.tid; idx < 256 * 64; idx += NWAVES * 64) { const int r = idx >> 6, kc = idx & 63, j = kc >> 1, hi0 = (kc & 1) * 8;
        v4u o = (v4u){0u, 0u, 0u, 0u};
        if (r < 128) { const int p = r & 63, im = r >> 6; const float pr = PW[((LC - 1 - j) * 64 + p) * 2], pi = PW[((LC - 1 - j) * 64 + p) * 2 + 1]; float v[8];
#pragma unroll
            for (int e = 0; e < 8; ++e) { const float br = BB[(p * 16 + hi0 + e) * 2], bi = BB[(p * 16 + hi0 + e) * 2 + 1]; v[e] = im ? (pr * bi + pi * br) : (pr * br - pi * bi); }
            o.x = pk2(v[0], v[1]); o.y = pk2(v[2], v[3]); o.z = pk2(v[4], v[5]); o.w = pk2(v[6], v[7]); }
        *(GAS v4u*)(Fg + (size_t)r * 512 + kc * 8) = o; }
    if (F.tid < 64) { float* L = (float*)(F.ws + WS_S5LAM) + (g * 64 + F.tid) * 2; L[0] = PW[(LC * 64 + F.tid) * 2]; L[1] = PW[(LC * 64 + F.tid) * 2 + 1]; }
    __syncthreads();
}
template <class WF, class VF> __device__ __forceinline__ void gemv64(Frame& F, WF wf, VF vf, float& o0, float& o1) {
    LAS float* red = (LAS float*)(F.lds + RING_OFF);
    float a0 = 0.f, a1 = 0.f; const int kb = F.wave * 128;
#pragma unroll 16
    for (int k = 0; k < 128; ++k) { const float w = wf(kb + k); a0 += vf(0, kb + k) * w; a1 += vf(1, kb + k) * w; }
    red[(F.wave * 2 + 0) * 64 + F.lane] = a0; red[(F.wave * 2 + 1) * 64 + F.lane] = a1;
    __syncthreads();
    o0 = 0.f; o1 = 0.f;
    if (F.wave == 0) {
#pragma unroll
        for (int w = 0; w < 8; ++w) { o0 += red[(w * 2 + 0) * 64 + F.lane]; o1 += red[(w * 2 + 1) * 64 + F.lane]; } }
    __syncthreads();
}
__device__ __forceinline__ void p0_prologue_a(Frame& F) {
    for (int t = F.vcu * NWAVES * 64 + F.tid; t < 1024 * 128; t += F.G * NWAVES * 64) { const int k = t >> 7, n4 = (t & 127) * 4;
        const f32x4* a1 = (const f32x4*)(F.in[I_ODWA1] + k * 16); const float* a2 = F.in[I_ODWA2] + n4; f32x4 acc = (f32x4){0.f, 0.f, 0.f, 0.f};
#pragma unroll
        for (int r4 = 0; r4 < 4; ++r4) { const f32x4 av = a1[r4];
#pragma unroll
            for (int e = 0; e < 4; ++e) acc += *(const f32x4*)(a2 + (size_t)(r4 * 4 + e) * 512) * av[e]; }
        *(f32x4*)((float*)(F.ws + WS_WA) + (size_t)k * 512 + n4) = acc; }
    if (F.vcu < 32) { s5_constants(F, F.vcu); return; }
    if (F.vcu < 32 + 192) {
        const int task = F.vcu - 32, l = task / 96, n = (task % 96) * 64 + F.lane;
        const float* W = F.in[I_ADAW] + (size_t)l * 1024 * 6144 + n; const float* cc = F.in[I_C];
        LAS float* sc = (LAS float*)(F.lds + RING_OFF + 8192);
        for (int i = F.tid; i < 2048; i += NWAVES * 64) sc[i] = dsilu(cc[i]);
        __syncthreads();
        float o0, o1;
        gemv64(F, [&](int k) { return W[(size_t)k * 6144]; }, [&](int b, int k) { return sc[b * 1024 + k]; }, o0, o1);
        if (F.wave == 0) { const float bb = F.in[I_ADAB][l * 6144 + n]; float* mod = (float*)(F.ws + WS_MOD) + l * 2 * 6144; mod[n] = o0 + bb; mod[6144 + n] = o1 + bb; }
    }
    LAS float* scr = (LAS float*)(F.lds + RING_OFF + 16384 + F.wave * 12288);
    const int gw = (F.vcu - 32) * NWAVES + F.wave, NGW = (F.G - 32) * NWAVES;
    constexpr int I_O = (D / 64) * (D / 32), I_G = (512 / 64) * (512 / 32), I_2 = (FF / 64) * (D / 32);
    constexpr int NITEMS = 2 * I_O + I_G + 2 * I_2;
    for (int it = NGW - 1 - gw; it < NITEMS; it += NGW) {
        int r = it;
        if (r < I_O) { p_transpose_item(F.in[I_EVWOUT], D, D, (bf16*)(F.ws + WS_WOUT0), scr, r, F.lane); continue; } r -= I_O;
        if (r < I_O) { p_transpose_item(F.in[I_ODWOUT], D, D, (bf16*)(F.ws + WS_WOUT1), scr, r, F.lane); continue; } r -= I_O;
        if (r < I_G) { p_transpose_item(F.in[I_WGLU], 512, 512, (bf16*)(F.ws + WS_WGLU), scr, r, F.lane); continue; } r -= I_G;
        if (r < I_2) { p_transpose_item(F.in[I_W2], FF, D, (bf16*)(F.ws + WS_W2_0), scr, r, F.lane); continue; } r -= I_2;
        p_transpose_item(F.in[I_W2] + (size_t)FF * D, FF, D, (bf16*)(F.ws + WS_W2_1), scr, r, F.lane);
    }
    const float* x = F.in[I_X]; bf16* xb = (bf16*)(F.ws + WS_XB); float* rowsq = (float*)(F.ws + WS_ROWSQ);
    for (int m0 = NGW - 1 - gw; m0 < T; m0 += 4 * NGW) {
        f32x4 v[4][4];
#pragma unroll
        for (int q = 0; q < 4; ++q) { const int m = m0 + q * NGW; if (m < T) { const GAS f32x4* xr = (const GAS f32x4*)(x + (size_t)m * D) + F.lane;
#pragma unroll
                for (int j = 0; j < 4; ++j) v[q][j] = xr[64 * j]; } }
#pragma unroll
        for (int q = 0; q < 4; ++q) { const int m = m0 + q * NGW; if (m < T) { float s = 0.f;
#pragma unroll
                for (int j = 0; j < 4; ++j) s += (v[q][j].x * v[q][j].x + v[q][j].y * v[q][j].y) + (v[q][j].z * v[q][j].z + v[q][j].w * v[q][j].w);
                s = wave_sum(s);
                GAS unsigned long long* o8 = (GAS unsigned long long*)(xb + (size_t)m * D) + F.lane;
#pragma unroll
                for (int j = 0; j < 4; ++j) o8[64 * j] = (unsigned long long)pk2(v[q][j].x, v[q][j].y) | ((unsigned long long)pk2(v[q][j].z, v[q][j].w) << 32);
                if (F.lane < 16) rowsq[(size_t)m * 16 + F.lane] = F.lane == 0 ? s : 0.f; } }
    }
}

struct FusedSrc { const float* p; int ld; };
__device__ __forceinline__ FusedSrc fused_src(Frame& F, int mat, int R0) {
    FusedSrc s;
    if (mat == 0) { s.p = F.in[I_EVWIN] + R0; s.ld = N_IN0; }
    else if (mat == 2) { if (R0 < 3072) { s.p = F.in[I_ODWIN] + R0; s.ld = 3072; } else { s.p = (const float*)(F.ws + WS_WA) + (R0 - 3072); s.ld = 512; } }
    else { const int l = mat >> 1, pn = R0 >> 8, half = (R0 >> 7) & 1, i0 = R0 & 127; s.p = (half ? F.in[I_W3] : F.in[I_W1]) + (size_t)l * D * FF + 128 * pn + i0; s.ld = FF; }
    return s;
}
__device__ __forceinline__ void p1_prologue_b(Frame& F) {
    const float* mod = (const float*)(F.ws + WS_MOD);
    for (int task = F.vcu; task < 272; task += F.G) {
        int mat, nb = task; if (nb < 40) mat = 0; else if ((nb -= 40) < 88) mat = 1; else if ((nb -= 88) < 56) mat = 2; else { nb -= 56; mat = 3; }
        const int l = mat >> 1, sh = (mat & 1) ? 3072 : 0, R = nb * 64 + F.lane; const FusedSrc s = fused_src(F, mat, nb * 64);
        LAS float* sc = (LAS float*)(F.lds + RING_OFF + 8192);
        for (int i = F.tid; i < 2048; i += NWAVES * 64) sc[i] = mod[(l * 2 + (i >> 10)) * 6144 + sh + (i & 1023)];
        __syncthreads();
        float o0, o1;
        gemv64(F, [&](int k) { return s.p[(size_t)k * s.ld + F.lane]; }, [&](int b, int k) { return sc[b * 1024 + k]; }, o0, o1);
        if (F.wave == 0) { const int Ns[4] = {N_IN0, N_UP, N_IN1, N_UP}; const int offs[4] = {CV_IN0, CV_UP0, CV_IN1, CV_UP1};
            float* cv = (float*)(F.ws + WS_CV) + offs[mat]; cv[R] = o0; cv[Ns[mat] + R] = o1; }
    }
    LAS float* scr = (LAS float*)(F.lds + RING_OFF + 16384 + F.wave * 12288);
    LAS float* scl = scr + 64 * 33;
    const int gw = F.vcu * NWAVES + F.wave, NGW = F.G * NWAVES;
    constexpr int IT0 = 16 * (N_IN0 / 32), IT1 = 16 * (N_UP / 32), IT2 = 16 * (N_IN1 / 32);
    for (int it = NGW - 1 - gw; it < IT0 + 2 * IT1 + IT2; it += NGW) {
        int mat, r = it; if (r < IT0) mat = 0; else if ((r -= IT0) < IT1) mat = 1; else if ((r -= IT1) < IT2) mat = 2; else { r -= IT2; mat = 3; }
        const int Ns[4] = {N_IN0, N_UP, N_IN1, N_UP}; const size_t wso[4] = {WS_WIN0, WS_W13_0, WS_WIN1, WS_W13_1};
        const int N = Ns[mat], nblk = N / 32, kb = r / nblk, nb = r % nblk, k0 = 64 * kb, R0 = 32 * nb, l = mat >> 1;
        const FusedSrc s = fused_src(F, mat, R0);
        tile_load(s.p + (size_t)k0 * s.ld, s.ld, scr, F.lane);
        { const int k = k0 + F.lane; const float gn = (mat & 1) ? F.in[I_NFG][l * 1024 + k] : F.in[I_NMG][l * 1024 + k]; const int so = (mat & 1) ? 4096 : 1024;
          scl[F.lane] = gn * (1.0f + mod[(l * 2 + 0) * 6144 + so + k]); scl[64 + F.lane] = gn * (1.0f + mod[(l * 2 + 1) * 6144 + so + k]); }
        LDS_WAIT(); asm volatile("" ::: "memory");
        bf16* dst = (bf16*)(F.ws + wso[mat]) + (size_t)R0 * D + k0;
        float sc0[8], sc1[8];
#pragma unroll
        for (int j = 0; j < 8; ++j) { sc0[j] = scl[8 * (F.lane & 7) + j]; sc1[j] = scl[64 + 8 * (F.lane & 7) + j]; }
        const int c = F.lane & 7;
#pragma unroll
        for (int j = 0; j < 4; ++j) { const int n = (F.lane >> 3) + 8 * j; const LAS float* sp = scr + (8 * c) * 33 + n;
            float v[8];
#pragma unroll
            for (int e = 0; e < 8; ++e) v[e] = sp[e * 33];
            v4u o; o.x = pk2(v[0] * sc0[0], v[1] * sc0[1]); o.y = pk2(v[2] * sc0[2], v[3] * sc0[3]); o.z = pk2(v[4] * sc0[4], v[5] * sc0[5]); o.w = pk2(v[6] * sc0[6], v[7] * sc0[7]);
            *(GAS v4u*)(dst + (size_t)n * D + 8 * c) = o;
            o.x = pk2(v[0] * sc1[0], v[1] * sc1[1]); o.y = pk2(v[2] * sc1[2], v[3] * sc1[3]); o.z = pk2(v[4] * sc1[4], v[5] * sc1[5]); o.w = pk2(v[6] * sc1[6], v[7] * sc1[7]);
            *(GAS v4u*)(dst + (size_t)N * D + (size_t)n * D + 8 * c) = o; }
        LDS_WAIT(); asm volatile("" ::: "memory");
    }
}

__device__ __forceinline__ void s5_carry(Frame& F) {
    for (int task = F.vcu; task < 64; task += F.G) {
        const int b = task >> 5, g = task & 31, p = F.tid & 63, seg = F.tid >> 6;
        const float* X = (const float*)(F.ws + WS_XLOC) + ((size_t)g * NCH + b * 512 + seg * 64) * 128 + p;
        const float* L = (const float*)(F.ws + WS_S5LAM) + (g * 64 + p) * 2; const float lr = L[0], li = L[1];
        float ar = 0.f, ai = 0.f;
#pragma unroll 8
        for (int c = 0; c < 64; ++c) { const float xr = X[(size_t)c * 128], xi = X[(size_t)c * 128 + 64]; const float nr = lr * ar - li * ai + xr, ni = lr * ai + li * ar + xi; ar = nr; ai = ni; }
        float sr = lr, si = li;
#pragma unroll
        for (int q = 0; q < 6; ++q) { const float nr = sr * sr - si * si, ni = 2.f * sr * si; sr = nr; si = ni; }
        LAS float* agg = (LAS float*)(F.lds + RING_OFF);
        agg[(seg * 64 + p) * 2] = ar; agg[(seg * 64 + p) * 2 + 1] = ai;
        __syncthreads();
        float cr = 0.f, ci = 0.f;
        for (int s = 0; s < seg; ++s) { const float xr = agg[(s * 64 + p) * 2], xi = agg[(s * 64 + p) * 2 + 1]; const float nr = sr * cr - si * ci + xr, ni = sr * ci + si * cr + xi; cr = nr; ci = ni; }
        bf16* U = (bf16*)(F.ws + WS_UT) + ((size_t)g * NCH + b * 512 + seg * 64) * UTP + 512 + p;
#pragma unroll 8
        for (int c = 0; c < 64; ++c) { U[(size_t)c * UTP] = (bf16)f2bf(cr); U[(size_t)c * UTP + 64] = (bf16)f2bf(ci);
            const float xr = X[(size_t)c * 128], xi = X[(size_t)c * 128 + 64]; const float nr = lr * cr - li * ci + xr, ni = lr * ci + li * cr + xi; cr = nr; ci = ni; }
        __syncthreads();
    }
}

__device__ __forceinline__ void final_norm(Frame& F) {
    const int gw = F.vcu * NWAVES + F.wave, NGW = F.G * NWAVES; const float* gn = F.in[I_FNORM];
    f32x4 gv[4];
#pragma unroll
    for (int j = 0; j < 4; ++j) gv[j] = ((const f32x4*)gn)[F.lane + 64 * j];
    for (int m = gw; m < T; m += NGW) {
        GAS f32x4* xr = (GAS f32x4*)(F.out + (size_t)m * D) + F.lane; f32x4 v[4]; float s = 0.f;
#pragma unroll
        for (int j = 0; j < 4; ++j) { v[j] = xr[64 * j]; s += (v[j].x * v[j].x + v[j].y * v[j].y) + (v[j].z * v[j].z + v[j].w * v[j].w); }
        const float rs = 1.0f / sqrtf(wave_sum(s) * (1.0f / D) + EPS);
#pragma unroll
        for (int j = 0; j < 4; ++j) xr[64 * j] = v[j] * rs * gv[j];
    }
}
namespace gl {
typedef short bf16x8 __attribute__((ext_vector_type(8)));
typedef short bf16x4 __attribute__((ext_vector_type(4)));
typedef float f32x16 __attribute__((ext_vector_type(16)));
constexpr int P136 = 272, P72 = 144;
constexpr int L_QE = 0, L_QI = 17408, L_KI = 34816, L_KLT = 52224, L_VT = 70656, L_P = 107520, L_TOT = 116736, L_DEC = 120832, L_NG = 121344, L_END = 122368;
static_assert(L_END <= RING_BYTES, "mixer LDS map");
__device__ __forceinline__ bf16x8 frag16(LAS unsigned char* lds, int base, int pitch, int row, int col) { return *(const LAS bf16x8*)(lds + base + row * pitch + col * 2); }
__device__ __forceinline__ unsigned pkbf(float lo, float hi) { return pg8::cvt_pk_bf16(lo, hi); }

#define GL_BAR() do { asm volatile("s_waitcnt lgkmcnt(0)" ::: "memory"); __builtin_amdgcn_s_barrier(); asm volatile("" ::: "memory"); } while (0)
template <int DV, bool GLA, bool PASS2> struct MixPF { unsigned qv[8], kv[8], gv[8]; v4u vt[DV * 8 / 512]; };
template <int DV, bool GLA, bool PASS2>
__device__ __forceinline__ void mix_load(MixPF<DV, GLA, PASS2>& P, int t0, int tid, int w, int h, int c0, const unsigned char* wsb, unsigned zr_off, int zp, int qoff, int koff, int goff, unsigned vt_off, int dvt) {
#pragma unroll
    for (int tt = 0; tt < 8; ++tt) { const unsigned o = zr_off + ((unsigned)(t0 + 8 * w + tt) * (unsigned)zp + (unsigned)(h * 128 + c0)) * 2u;
        P.qv[tt] = PASS2 ? *(const unsigned*)(wsb + (size_t)(o + 2u * qoff)) : 0u; P.kv[tt] = *(const unsigned*)(wsb + (size_t)(o + 2u * koff)); P.gv[tt] = GLA ? *(const unsigned*)(wsb + (size_t)(o + 2u * goff)) : 0u; }
#pragma unroll
    for (int i = 0; i < DV * 8 / 512; ++i) { const int idx = tid + 512 * i, v = idx >> 3, jc = idx & 7; P.vt[i] = *(const v4u*)(wsb + (size_t)(vt_off + (((unsigned)(t0 >> 6) * (unsigned)dvt + (unsigned)(h * DV + v)) * 64u + jc * 8u) * 2u)); }
}
template <int DV, bool GLA, bool PASS2>
__device__ __forceinline__ void mix_unit(Frame& F, int bh, int seg, unsigned zr_off, int zp, int qoff, int koff, int goff, int ooff, unsigned vt_off, int dvt,
                                         float* AGG, float* DSEG, unsigned out_off, int ldo, int ocol0, const float* ng, const float* lbl) {
    const unsigned char* wsb = F.ws;
    constexpr int NV = DV / 32, SW0 = (DV == 128) ? 4 : 0, OTP = DV + 4;
    static_assert(64 * OTP * 4 <= L_VT, "O tile overlays QE..KLT");
    LAS unsigned char* lds = F.lds + RING_OFF;
    const int w = F.wave, lane = F.lane, r = lane & 31, hh = lane >> 5, b = bh >> 2, h = bh & 3, tok0 = b * SEQ + seg * 512, c0 = 2 * lane;
    LAS float* TOT = (LAS float*)(lds + L_TOT); LAS float* DEC = (LAS float*)(lds + L_DEC);
    MixPF<DV, GLA, PASS2> nxt;
    mix_load<DV, GLA, PASS2>(nxt, tok0, F.tid, w, h, c0, wsb, zr_off, zp, qoff, koff, goff, vt_off, dvt);
    float lb[2] = {0.f, 0.f};
    if (!GLA) {
#pragma unroll
        for (int e = 0; e < 2; ++e) { const int c = h * 128 + c0 + e; const float l0 = lbl[c], l1 = lbl[512 + c], l2 = lbl[1024 + c], mx = fmaxf(l0, fmaxf(l1, l2)); const float e0 = __expf(l0 - mx), e1 = __expf(l1 - mx), e2 = __expf(l2 - mx); lb[e] = e0 / (e0 + e1 + e2); } }
    f32x16 S[4];
    const size_t aggbase = ((size_t)(bh * 32 + seg) * 128) * DV;
#pragma unroll
    for (int ct = 0; ct < 4; ++ct)
#pragma unroll
        for (int rr = 0; rr < 16; ++rr) S[ct][rr] = 0.f;
    if (PASS2 && w < NV) {
#pragma unroll
        for (int ct = 0; ct < 4; ++ct)
#pragma unroll
            for (int rr = 0; rr < 16; ++rr) S[ct][rr] = AGG[aggbase + (size_t)(32 * ct + (rr & 3) + 8 * (rr >> 2) + 4 * hh) * DV + 32 * w + r];
    }
    float lsum[2] = {0.f, 0.f};
    LAS float* NG = (LAS float*)(lds + L_NG);
    if (PASS2) { if (F.tid < DV) NG[F.tid] = ng[F.tid]; }
#pragma unroll 1
    for (int ch = 0; ch < 8; ++ch) {
        const int t0 = tok0 + ch * 64;
#pragma unroll
        for (int i = 0; i < DV * 8 / 512; ++i) { const int idx = F.tid + 512 * i, v = idx >> 3, jc = idx & 7; *(LAS v4u*)(lds + L_VT + v * P72 + jc * 16) = nxt.vt[i]; }
        float cl[8][2], qq[8][2], kk[8][2]; float run[2] = {0.f, 0.f};
#pragma unroll
        for (int tt = 0; tt < 8; ++tt)
#pragma unroll
            for (int e = 0; e < 2; ++e) {
                const float kf = e ? pg8::bf_hi(nxt.kv[tt]) : pg8::bf_lo(nxt.kv[tt]), qf = e ? pg8::bf_hi(nxt.qv[tt]) : pg8::bf_lo(nxt.qv[tt]); float lg;
                if (GLA) { lg = (e ? pg8::bf_hi(nxt.gv[tt]) : pg8::bf_lo(nxt.gv[tt])) * 0.0625f; kk[tt][e] = kf; qq[tt][e] = qf; }
                else { const float sg = pg8::fsigmoid(kf), fo = lb[e] + (1.f - lb[e]) * sg; lg = __logf(fo); kk[tt][e] = (1.f - lb[e]) * (1.f - sg); qq[tt][e] = pg8::fsilu(qf); }
                run[e] += lg; cl[tt][e] = run[e]; }
        TOT[w * 128 + c0] = run[0]; TOT[w * 128 + c0 + 1] = run[1];
        GL_BAR();
        float off[2] = {0.f, 0.f}, last[2] = {0.f, 0.f}, ref[2] = {0.f, 0.f};
#pragma unroll
        for (int ww = 0; ww < 8; ++ww) { const float t0_ = TOT[ww * 128 + c0], t1_ = TOT[ww * 128 + c0 + 1];
            if (ww < w) { off[0] += t0_; off[1] += t1_; } if (ww < 4) { ref[0] += t0_; ref[1] += t1_; } last[0] += t0_; last[1] += t1_; }
        float klv[2][8];
#pragma unroll
        for (int tt = 0; tt < 8; ++tt) { float qe[2], qi[2], ki[2];
#pragma unroll
            for (int e = 0; e < 2; ++e) { const float cum = off[e] + cl[tt][e]; klv[e][tt] = kk[tt][e] * __expf(last[e] - cum);
                if (PASS2) { qe[e] = qq[tt][e] * __expf(cum); qi[e] = qq[tt][e] * __expf(cum - ref[e]); ki[e] = kk[tt][e] * __expf(ref[e] - cum); } }
            if (PASS2) { const int o = (8 * w + tt) * P136 + c0 * 2;
                *(LAS unsigned*)(lds + L_QE + o) = pkbf(qe[0], qe[1]); *(LAS unsigned*)(lds + L_QI + o) = pkbf(qi[0], qi[1]); *(LAS unsigned*)(lds + L_KI + o) = pkbf(ki[0], ki[1]); } }
#pragma unroll
        for (int e = 0; e < 2; ++e) { v4u o; o.x = pkbf(klv[e][0], klv[e][1]); o.y = pkbf(klv[e][2], klv[e][3]); o.z = pkbf(klv[e][4], klv[e][5]); o.w = pkbf(klv[e][6], klv[e][7]);
            *(LAS v4u*)(lds + L_KLT + (c0 + e) * P72 + 16 * w) = o; }
        if (w == 0) { DEC[c0] = __expf(last[0]); DEC[c0 + 1] = __expf(last[1]); lsum[0] += last[0]; lsum[1] += last[1]; }
        GL_BAR();
        if (ch + 1 < 8) mix_load<DV, GLA, PASS2>(nxt, t0 + 64, F.tid, w, h, c0, wsb, zr_off, zp, qoff, koff, goff, vt_off, dvt);
        v4u og[DV / 64];
        if (PASS2) {
#pragma unroll
            for (int q = 0; q < DV / 64; ++q) og[q] = *(const v4u*)(wsb + (size_t)(zr_off + ((unsigned)(t0 + (F.tid >> 3)) * (unsigned)zp + (unsigned)(ooff + h * DV + (F.tid & 7) * 8 + 64 * q)) * 2u)); }
        f32x16 O[2];
        if (PASS2) {
            if (w >= SW0 && w < SW0 + 3) {
                const int ti = w - SW0, jt = ti >> 1, it = (ti + 1) >> 1;
                f32x16 X;
#pragma unroll
                for (int rr = 0; rr < 16; ++rr) X[rr] = 0.f;
#pragma unroll
                for (int s = 0; s < 8; ++s) X = __builtin_amdgcn_mfma_f32_32x32x16_bf16(frag16(lds, L_KI, P136, 32 * jt + r, 16 * s + 8 * hh), frag16(lds, L_QI, P136, 32 * it + r, 16 * s + 8 * hh), X, 0, 0, 0);
#pragma unroll
                for (int g = 0; g < 4; ++g) { float x[4];
#pragma unroll
                    for (int e = 0; e < 4; ++e) { const int j = 32 * jt + 8 * g + 4 * hh + e, i = 32 * it + r; x[e] = (j <= i) ? X[4 * g + e] : 0.f; }
                    v2u o; o.x = pkbf(x[0], x[1]); o.y = pkbf(x[2], x[3]);
                    *(LAS v2u*)(lds + L_P + (32 * it + r) * P72 + (32 * jt + 8 * g + 4 * hh) * 2) = o; }
            }
            if (w < NV) {
#pragma unroll
                for (int it = 0; it < 2; ++it)
#pragma unroll
                    for (int rr = 0; rr < 16; ++rr) O[it][rr] = 0.f;
#pragma unroll
                for (int ct = 0; ct < 4; ++ct)
#pragma unroll
                    for (int s = 0; s < 2; ++s) {
                        union { bf16x8 v; unsigned u[4]; } Bs;
#pragma unroll
                        for (int p = 0; p < 4; ++p) Bs.u[p] = pkbf(S[ct][8 * s + 2 * p], S[ct][8 * s + 2 * p + 1]);
#pragma unroll
                        for (int it = 0; it < 2; ++it) { union { bf16x8 v; bf16x4 hlf[2]; } A; const int o = L_QE + (32 * it + r) * P136 + (32 * ct + 16 * s + 4 * hh) * 2;
                            A.hlf[0] = *(const LAS bf16x4*)(lds + o); A.hlf[1] = *(const LAS bf16x4*)(lds + o + 16);
                            O[it] = __builtin_amdgcn_mfma_f32_32x32x16_bf16(A.v, Bs.v, O[it], 0, 0, 0); } }
            }
            GL_BAR();
        }
        if (w < NV) {
            if (PASS2) {
#pragma unroll
                for (int it = 0; it < 2; ++it)
#pragma unroll
                    for (int jt = 0; jt <= it; ++jt)
#pragma unroll
                        for (int s = 0; s < 2; ++s)
                            O[it] = __builtin_amdgcn_mfma_f32_32x32x16_bf16(frag16(lds, L_P, P72, 32 * it + r, 32 * jt + 16 * s + 8 * hh), frag16(lds, L_VT, P72, 32 * w + r, 32 * jt + 16 * s + 8 * hh), O[it], 0, 0, 0);
            }
#pragma unroll
            for (int ct = 0; ct < 4; ++ct) {
#pragma unroll
                for (int g = 0; g < 4; ++g) { const f32x4 d4 = *(const LAS f32x4*)(DEC + 32 * ct + 8 * g + 4 * hh);
#pragma unroll
                    for (int e = 0; e < 4; ++e) S[ct][4 * g + e] *= d4[e]; }
#pragma unroll
                for (int sj = 0; sj < 4; ++sj)
                    S[ct] = __builtin_amdgcn_mfma_f32_32x32x16_bf16(frag16(lds, L_KLT, P72, 32 * ct + r, 16 * sj + 8 * hh), frag16(lds, L_VT, P72, 32 * w + r, 16 * sj + 8 * hh), S[ct], 0, 0, 0);
            }
        }
        GL_BAR();
        if (PASS2) {
            LAS float* OT = (LAS float*)lds;
            if (w < NV) {
#pragma unroll
                for (int it = 0; it < 2; ++it)
#pragma unroll
                    for (int rr = 0; rr < 16; ++rr) OT[(32 * it + (rr & 3) + 8 * (rr >> 2) + 4 * hh) * OTP + 32 * w + r] = O[it][rr];
            }
            GL_BAR();
            const int i = F.tid >> 3, sub = F.tid & 7; float ov[DV / 64][8]; float ss = 0.f;
#pragma unroll
            for (int q = 0; q < DV / 64; ++q) { const f32x4 a = *(const LAS f32x4*)(OT + i * OTP + sub * 8 + 64 * q), bq = *(const LAS f32x4*)(OT + i * OTP + sub * 8 + 64 * q + 4);
#pragma unroll
                for (int e = 0; e < 4; ++e) { ov[q][e] = a[e]; ov[q][4 + e] = bq[e]; ss += a[e] * a[e] + bq[e] * bq[e]; } }
            ss += __shfl_xor(ss, 1); ss += __shfl_xor(ss, 2); ss += __shfl_xor(ss, 4);
            const float rs = 1.0f / sqrtf(ss * (1.0f / DV) + EPS);
#pragma unroll
            for (int q = 0; q < DV / 64; ++q) { const int col = sub * 8 + 64 * q; const v4u gw = og[q];
                const float g8[8] = {pg8::bf_lo(gw.x), pg8::bf_hi(gw.x), pg8::bf_lo(gw.y), pg8::bf_hi(gw.y), pg8::bf_lo(gw.z), pg8::bf_hi(gw.z), pg8::bf_lo(gw.w), pg8::bf_hi(gw.w)};
                const f32x4 n0 = *(const LAS f32x4*)(NG + col), n1 = *(const LAS f32x4*)(NG + col + 4);
                float y[8];
#pragma unroll
                for (int e = 0; e < 8; ++e) y[e] = ov[q][e] * rs * (e < 4 ? n0[e] : n1[e - 4]) * pg8::fsilu(g8[e]);
                v4u o; o.x = pkbf(y[0], y[1]); o.y = pkbf(y[2], y[3]); o.z = pkbf(y[4], y[5]); o.w = pkbf(y[6], y[7]);
                *(v4u*)(F.ws + (size_t)(out_off + ((unsigned)(t0 + i) * (unsigned)ldo + (unsigned)(ocol0 + h * DV + col)) * 2u)) = o; }
        }
    }
    if (!PASS2) {
        if (w < NV) {
#pragma unroll
            for (int ct = 0; ct < 4; ++ct)
#pragma unroll
                for (int rr = 0; rr < 16; ++rr) AGG[aggbase + (size_t)(32 * ct + (rr & 3) + 8 * (rr >> 2) + 4 * hh) * DV + 32 * w + r] = S[ct][rr];
        }
        if (w == 0) { DSEG[(bh * 32 + seg) * 128 + c0] = __expf(lsum[0]); DSEG[(bh * 32 + seg) * 128 + c0 + 1] = __expf(lsum[1]); }
    }
}
template <int DV> __device__ __forceinline__ void mix_carry(Frame& F, float* AGG, const float* DSEG) {
    constexpr int PER = 128 * DV;
    for (int idx = F.vcu * (NWAVES * 64) + F.tid; idx < 8 * PER; idx += F.G * NWAVES * 64) {
        const int bh = idx / PER, rem = idx % PER, c = rem / DV; float a[32], d[32];
#pragma unroll
        for (int s = 0; s < 32; ++s) { a[s] = AGG[(size_t)(bh * 32 + s) * PER + rem]; d[s] = DSEG[(bh * 32 + s) * 128 + c]; }
        float cur = 0.f;
#pragma unroll
        for (int s = 0; s < 32; ++s) { AGG[(size_t)(bh * 32 + s) * PER + rem] = cur; cur = d[s] * cur + a[s]; }
    }
}
}
constexpr int N_PHASES = 18;
__global__ void __launch_bounds__(NWAVES * 64, 2) mk_fwd(Args args) {
    extern __shared__ __attribute__((aligned(16))) unsigned char lds[];
    Frame F;
    F.lds = (LAS unsigned char*)lds;
    F.MISC = (volatile LAS unsigned*)(F.lds + MISC_OFF);
    F.tid = threadIdx.x; F.lane = F.tid & 63; F.wave = __builtin_amdgcn_readfirstlane(F.tid >> 6);
    F.G = gridDim.x; { const int bx = blockIdx.x; F.vcu = (F.G % 8 == 0) ? (bx % 8) * (F.G / 8) + bx / 8 : bx; }
    F.in = args.in; F.out = args.out; F.ws = args.ws;
    F.ctl = (gu32*)(args.ws + WS_CTL);
    for (int u = F.tid; u < (LDS_BYTES - LDSCTL_OFF) / 4; u += NWAVES * 64) ((LAS unsigned*)(F.lds + LDSCTL_OFF))[u] = 0u;
    __syncthreads();
    const int lo = args.ph_lo, hi = args.ph_hi;
    XcdBarrier bar; bar.bar = (unsigned*)(F.ctl + CW_BAR); bar.x = 0; bar.st = nullptr;
    if (hi - lo > 1) bar = xcd_barrier_post((unsigned*)(F.ctl + CW_BAR), F.MISC + 8);
#define IN(k) (lo <= (k) && (k) < hi)
#define SEAM(k) do { if (IN(k) && IN((k) + 1)) xcd_barrier(bar); } while (0)
    unsigned char* ws = args.ws;
    float* rowsq = (float*)(ws + WS_ROWSQ); bf16* xb = (bf16*)(ws + WS_XB); const float* mod = (const float*)(ws + WS_MOD); const float* cv = (const float*)(ws + WS_CV);
    const int bid = (int)blockIdx.x;

    if (IN(0)) { p0_prologue_a(F); } SEAM(0);
    if (IN(1)) { p1_prologue_b(F); } SEAM(1);
    if (IN(2)) {
        pg8::Gemm g{xb, (const bf16*)(ws + WS_WIN0), D, D, D}; pg8::StaticOrder S; S.init(T, N_IN0, F.G, bid, 64, (size_t)N_IN0 * D * 2);
        pg8::EpiIn0 E{rowsq, cv + CV_IN0, (bf16*)(ws + WS_UT), (bf16*)(ws + WS_QFG), (bf16*)(ws + WS_VT0)};
        pg8::gemm_phase<pg8::EpiIn0, pg8::StaticOrder, true>(F.lds + RING_OFF, g, S, E);
    } SEAM(2);
    if (IN(3)) {
        { const int un = F.vcu; if (un < 256)
            gl::mix_unit<128, false, false>(F, un >> 5, un & 31, (unsigned)WS_QFG, 1536, 0, 512, 0, 1024, (unsigned)WS_VT0, 512, (float*)(ws + WS_HGA), (float*)(ws + WS_HGD), 0u, 0, 0, nullptr, F.in[I_LBLOG]); }
        __syncthreads();
        pg8::Gemm g{(const bf16*)(ws + WS_UT), (const bf16*)(ws + WS_S5F), UTP, 512, 512}; pg8::GroupOrder S; S.init(4, 1, S5G, F.G, F.vcu, (size_t)NCH * UTP * 2, (size_t)256 * 512 * 2);
        pg8::EpiS5X E{(float*)(ws + WS_XLOC)};
        pg8::gemm_phase<pg8::EpiS5X, pg8::GroupOrder, true>(F.lds + RING_OFF, g, S, E);
    } SEAM(3);
    if (IN(4)) { s5_carry(F); gl::mix_carry<128>(F, (float*)(ws + WS_HGA), (const float*)(ws + WS_HGD)); } SEAM(4);
    if (IN(5)) {
        { const int un = F.vcu; if (un < 256)
            gl::mix_unit<128, false, true>(F, un >> 5, un & 31, (unsigned)WS_QFG, 1536, 0, 512, 0, 1024, (unsigned)WS_VT0, 512, (float*)(ws + WS_HGA), (float*)(ws + WS_HGD), (unsigned)WS_MIXED, D, 512, F.in[I_HGNORM], F.in[I_LBLOG]); }
        __syncthreads();
        pg8::Gemm g{(const bf16*)(ws + WS_UT), (const bf16*)(ws + WS_S5T), UTP, UTP, UTP}; pg8::GroupOrder S; S.init(4, 2, S5G, F.G, F.vcu, (size_t)NCH * UTP * 2, (size_t)512 * UTP * 2);
        pg8::EpiS5Y E{(bf16*)(ws + WS_YGELU)};
        pg8::gemm_phase<pg8::EpiS5Y, pg8::GroupOrder, true>(F.lds + RING_OFF, g, S, E);
    } SEAM(5);
    if (IN(6)) {
        pg8::Gemm g{(const bf16*)(ws + WS_YGELU), (const bf16*)(ws + WS_WGLU), 512, 512, 512}; pg8::StaticOrder S; S.init(T, 512, F.G, bid, 64, 0);
        pg8::EpiGlu E{(const bf16*)(ws + WS_YGELU), F.in[I_BGLU], (bf16*)(ws + WS_MIXED), D};
        pg8::gemm_phase<pg8::EpiGlu, pg8::StaticOrder, true>(F.lds + RING_OFF, g, S, E);
    } SEAM(6);
    if (IN(7)) {
        pg8::Gemm g{(const bf16*)(ws + WS_MIXED), (const bf16*)(ws + WS_WOUT0), D, D, D}; pg8::StaticOrder S; S.init(T, D, F.G, bid, 64, 0);
        pg8::EpiResid E{F.in[I_X], F.out, xb, rowsq, mod + 2048, 6144};
        pg8::gemm_phase<pg8::EpiResid, pg8::StaticOrder, true>(F.lds + RING_OFF, g, S, E);
    } SEAM(7);
    if (IN(8)) {
        pg8::Gemm g{xb, (const bf16*)(ws + WS_W13_0), D, D, D}; pg8::StaticOrder S; S.init(T, N_UP, F.G, bid, 64, (size_t)N_UP * D * 2);
        pg8::EpiFfnUp E{rowsq, cv + CV_UP0, (bf16*)(ws + WS_HID)};
        pg8::gemm_phase<pg8::EpiFfnUp, pg8::StaticOrder, true>(F.lds + RING_OFF, g, S, E);
    } SEAM(8);
    if (IN(9)) {
        pg8::Gemm g{(const bf16*)(ws + WS_HID), (const bf16*)(ws + WS_W2_0), FF, FF, FF}; pg8::StaticOrder S; S.init(T, D, F.G, bid, 64, 0);
        pg8::EpiResid E{F.out, F.out, xb, rowsq, mod + 5120, 6144};
        pg8::gemm_phase<pg8::EpiResid, pg8::StaticOrder, true>(F.lds + RING_OFF, g, S, E);
    } SEAM(9);
    if (IN(10)) {
        pg8::Gemm g{xb, (const bf16*)(ws + WS_WIN1), D, D, D}; pg8::StaticOrder S; S.init(T, N_IN1, F.G, bid, 64, (size_t)N_IN1 * D * 2);
        pg8::EpiIn1 E{rowsq, cv + CV_IN1, F.in[I_ODBA], (bf16*)(ws + WS_Z1), (bf16*)(ws + WS_VT1)};
        pg8::gemm_phase<pg8::EpiIn1, pg8::StaticOrder, true>(F.lds + RING_OFF, g, S, E);
    } SEAM(10);
    if (IN(11)) {
        { const int un = F.vcu; if (un < 256)
            gl::mix_unit<256, true, false>(F, un >> 5, un & 31, (unsigned)WS_Z1, 2560, 0, 512, 2048, 1024, (unsigned)WS_VT1, 1024, (float*)(ws + WS_GLA_A), (float*)(ws + WS_GLA_D), 0u, 0, 0, nullptr, nullptr); }
    } SEAM(11);
    if (IN(12)) { gl::mix_carry<256>(F, (float*)(ws + WS_GLA_A), (const float*)(ws + WS_GLA_D)); } SEAM(12);
    if (IN(13)) {
        { const int un = F.vcu; if (un < 256)
            gl::mix_unit<256, true, true>(F, un >> 5, un & 31, (unsigned)WS_Z1, 2560, 0, 512, 2048, 1024, (unsigned)WS_VT1, 1024, (float*)(ws + WS_GLA_A), (float*)(ws + WS_GLA_D), (unsigned)WS_MIXED2, D, 0, F.in[I_GLANORM], nullptr); }
    } SEAM(13);
    if (IN(14)) {
        pg8::Gemm g{(const bf16*)(ws + WS_MIXED2), (const bf16*)(ws + WS_WOUT1), D, D, D}; pg8::StaticOrder S; S.init(T, D, F.G, bid, 64, 0);
        pg8::EpiResid E{F.out, F.out, xb, rowsq, mod + 2 * 6144 + 2048, 6144};
        pg8::gemm_phase<pg8::EpiResid, pg8::StaticOrder, true>(F.lds + RING_OFF, g, S, E);
    } SEAM(14);
    if (IN(15)) {
        pg8::Gemm g{xb, (const bf16*)(ws + WS_W13_1), D, D, D}; pg8::StaticOrder S; S.init(T, N_UP, F.G, bid, 64, (size_t)N_UP * D * 2);
        pg8::EpiFfnUp E{rowsq, cv + CV_UP1, (bf16*)(ws + WS_HID)};
        pg8::gemm_phase<pg8::EpiFfnUp, pg8::StaticOrder, true>(F.lds + RING_OFF, g, S, E);
    } SEAM(15);
    if (IN(16)) {
        pg8::Gemm g{(const bf16*)(ws + WS_HID), (const bf16*)(ws + WS_W2_1), FF, FF, FF}; pg8::StaticOrder S; S.init(T, D, F.G, bid, 64, 0);
        pg8::EpiResid E{F.out, F.out, xb, rowsq, mod + 2 * 6144 + 5120, 6144};
        pg8::gemm_phase<pg8::EpiResid, pg8::StaticOrder, true>(F.lds + RING_OFF, g, S, E);
    } SEAM(16);
    if (IN(17)) { final_norm(F); }
#undef IN
#undef SEAM
}


extern "C" void kernel_launch(void* const* d_in, const int* in_sizes, int n_in, void* d_out, int out_size, void* d_ws, size_t ws_size, hipStream_t stream) {
    static int grid = 0;
    if (grid == 0) {
        if (n_in != 30 || in_sizes[0] != T * D || out_size != T * D || ws_size < WS_END) { fprintf(stderr, "kernel_launch: unexpected shapes: n_in %d in0 %d out %d ws %zu (need %zu)\n", n_in, n_in > 0 ? in_sizes[0] : -1, out_size, ws_size, (size_t)WS_END); grid = -1; return; }
        int dev = 0, cus = 0, per_cu = 0;
        if (hipGetDevice(&dev) != hipSuccess || hipDeviceGetAttribute(&cus, hipDeviceAttributeMultiprocessorCount, dev) != hipSuccess) { fprintf(stderr, "kernel_launch: device query failed\n"); grid = -1; return; }
        if (hipFuncSetAttribute((const void*)mk_fwd, hipFuncAttributeMaxDynamicSharedMemorySize, LDS_BYTES) != hipSuccess) { fprintf(stderr, "kernel_launch: hipFuncSetAttribute failed\n"); grid = -1; return; }
        if (hipOccupancyMaxActiveBlocksPerMultiprocessor(&per_cu, (const void*)mk_fwd, NWAVES * 64, LDS_BYTES) != hipSuccess || per_cu < 1) { fprintf(stderr, "kernel_launch: occupancy query reports %d workgroups per CU; nothing launched\n", per_cu); (void)hipGetLastError(); grid = -1; return; }
        if (cus < 256) { fprintf(stderr, "kernel_launch: this kernel needs 256 CUs (found %d); nothing launched\n", cus); grid = -1; return; }
        grid = 256;
    }
    if (grid < 0) return;
    (void)hipMemsetAsync((char*)d_ws + WS_CTL, 0, CTL_ZERO_BYTES, stream);
    Args a{};
    for (int i = 0; i < 30; ++i) a.in[i] = (const float*)d_in[i];
    a.out = (float*)d_out; a.ws = (unsigned char*)d_ws;
#ifdef PROBE_RANGES
    static const int ranges[][2] = PROBE_RANGES;
    for (unsigned i = 0; i < sizeof(ranges) / sizeof(ranges[0]); ++i) { if (i) (void)hipMemsetAsync((char*)d_ws + WS_CTL, 0, CTL_ZERO_BYTES, stream);
        a.ph_lo = ranges[i][0]; a.ph_hi = ranges[i][1]; hipLaunchKernelGGL(mk_fwd, dim3(grid), dim3(NWAVES * 64), LDS_BYTES, stream, a); }
#else
    a.ph_lo = 0; a.ph_hi = N_PHASES;
    hipLaunchKernelGGL(mk_fwd, dim3(grid), dim3(NWAVES * 64), LDS_BYTES, stream, a);
#endif
}
```

```cpp
#include <hip/hip_runtime.h>
#include <cstdio>
#include <cstdint>
#include <cmath>
namespace pg8 {
#define PG8_LAS __attribute__((address_space(3)))
typedef unsigned short bf16_t;
typedef short bf16x8 __attribute__((ext_vector_type(8)));
typedef float f32x4 __attribute__((ext_vector_type(4)));
typedef unsigned u32x4 __attribute__((ext_vector_type(4)));
typedef unsigned u32x2 __attribute__((ext_vector_type(2)));
constexpr int BM = 256, BK = 64, HALF = 128, HTB = HALF * BK * 2  , STAGE_BYTES = 8 * HTB, NXCD = 8, WGM = 8;

__host__ __device__ __forceinline__ int lds_byte(int r, int c) { const int st = (r >> 4) * 2 + (c >> 5), rr = r & 15, cc = c & 31, ob = rr * 64 + cc * 2; return st * 1024 + (ob ^ (((ob >> 9) & 1) << 5)); }
__host__ __device__ __forceinline__ void stage_rc(int b, int& R, int& C) { const int st = b / 1024, sb = b % 1024, swz = sb ^ (((sb >> 9) & 1) << 5); R = (st >> 1) * 16 + swz / 64; C = (st & 1) * 32 + (swz % 64) / 2; }
__host__ __device__ __forceinline__ int perm32(int rho) { const int n = rho >> 4, i = rho & 15; return 8 * (i >> 2) + 4 * n + (i & 3); }

struct Unit { int pm, pn, g; size_t aoff, boff; };
struct Gemm { const bf16_t* A; const bf16_t* Bt; int lda, ldb, K; };

struct StaticOrder {
    int nM, nN, nwg, G, c, pm_per_batch; size_t bstride;
    __device__ void init(int M, int N, int G_, int c_, int pmpb, size_t bs) { nM = M / BM; nN = N / BM; nwg = nM * nN; G = G_; c = c_; pm_per_batch = pmpb; bstride = bs; }
    __device__ bool next(int i, Unit& u) const {
        const long L = (long)i * G + c; if (L >= nwg) return false;
        int wgid = (int)L; { const int q = nwg / NXCD, r = nwg % NXCD, xcd = wgid % NXCD, off = wgid / NXCD; wgid = (xcd < r ? xcd * (q + 1) : r * (q + 1) + (xcd - r) * q) + off; }
        const int nig = WGM * nN, gid = wgid / nig, fm = gid * WGM, gsz = (nM - fm) < WGM ? (nM - fm) : WGM;
        u.pm = fm + ((wgid % nig) % gsz); u.pn = (wgid % nig) / gsz; u.g = u.pm / pm_per_batch; u.aoff = 0; u.boff = (size_t)u.g * bstride; return true;
    }
};
struct GroupOrder {
    int nM, nN, ngroups, G, c; size_t astride, bstride;
    __device__ void init(int nM_, int nN_, int ng, int G_, int c_, size_t as, size_t bs) { nM = nM_; nN = nN_; ngroups = ng; G = G_; c = c_; astride = as; bstride = bs; }
    __device__ bool next(int i, Unit& u) const {
        const long L = (long)i * G + c; if (L >= (long)ngroups * nM * nN) return false;
        const int g = (int)(L / (nM * nN)), r = (int)(L % (nM * nN)); u.g = g; u.pm = r / nN; u.pn = r % nN; u.aoff = (size_t)g * astride; u.boff = (size_t)g * bstride; return true;
    }
};

__device__ __forceinline__ unsigned cvt_pk_bf16(float lo, float hi) { unsigned r; asm volatile("v_cvt_pk_bf16_f32 %0, %1, %2" : "=v"(r) : "v"(lo), "v"(hi)); return r; }
__device__ __forceinline__ float bf_lo(unsigned w) { return __uint_as_float(w << 16); }
__device__ __forceinline__ float bf_hi(unsigned w) { return __uint_as_float(w & 0xffff0000u); }
__device__ __forceinline__ float fsigmoid(float x) { return __builtin_amdgcn_rcpf(1.0f + __expf(-x)); }
__device__ __forceinline__ float fsilu(float x) { return x * fsigmoid(x); }
__device__ __forceinline__ float fgelu_tanh(float y) { return y * fsigmoid(1.5957691216f * (y + 0.044715f * y * y * y)); }
__device__ __forceinline__ float flogsigmoid(float x) { return fminf(x, 0.f) - __logf(1.0f + __expf(-fabsf(x))); }
__device__ __forceinline__ float row_rstd(const float* rowsq, int row) {
    const f32x4* p = (const f32x4*)(rowsq + (size_t)row * 16); const f32x4 a = p[0], b = p[1], c = p[2], d = p[3];
    const float s = ((a[0] + a[1]) + (a[2] + a[3])) + ((b[0] + b[1]) + (b[2] + b[3])) + ((c[0] + c[1]) + (c[2] + c[3])) + ((d[0] + d[1]) + (d[2] + d[3]));
    return 1.0f / sqrtf(s * (1.0f / 1024.0f) + 1e-6f);
}

__device__ __forceinline__ void rowstats8(const float* rowsq, int row0  , int fq, float (&rs)[2][4]) {
    f32x4 p[2][4];
#pragma unroll
    for (int ai = 0; ai < 2; ++ai)
#pragma unroll
        for (int m = 0; m < 4; ++m) p[ai][m] = *(const f32x4*)(rowsq + (size_t)(row0 + ai * HALF + m * 16) * 16 + 4 * fq);
#pragma unroll
    for (int ai = 0; ai < 2; ++ai)
#pragma unroll
        for (int m = 0; m < 4; ++m) { float s = (p[ai][m][0] + p[ai][m][1]) + (p[ai][m][2] + p[ai][m][3]); s += __shfl_xor(s, 16); s += __shfl_xor(s, 32); rs[ai][m] = 1.0f / sqrtf(s * (1.0f / 1024.0f) + 1e-6f); }
}


struct EpiIn0 {
    static constexpr bool PERM = true, AFTER_DRAIN = false;
    const float* rowsq; const float* cvec; bf16_t* Ut; bf16_t* QFG; bf16_t* VT;
    __device__ __forceinline__ void operator()(const f32x4 (&acc)[2][2][4][2], const Unit& u, int wr, int wc, int fr, int fq) const {
        f32x4 cv[2][2];
#pragma unroll
        for (int bj = 0; bj < 2; ++bj)
#pragma unroll
            for (int n = 0; n < 2; ++n) cv[bj][n] = *(const f32x4*)(cvec + u.g * 2560 + u.pn * BM + bj * HALF + wc * 32 + 8 * fq + 4 * n);
float rs8[2][4]; rowstats8(rowsq, u.pm * BM + wr * 64 + fr, fq, rs8);
#pragma unroll
        for (int ai = 0; ai < 2; ++ai)
#pragma unroll
        for (int m = 0; m < 4; ++m) { const int row = u.pm * BM + ai * HALF + wr * 64 + m * 16 + fr;
            const float rs = rs8[ai][m];
#pragma unroll
            for (int bj = 0; bj < 2; ++bj) { const int c0 = u.pn * BM + bj * HALF + wc * 32 + 8 * fq;
                const f32x4 v0 = acc[ai][bj][m][0] * rs + cv[bj][0], v1 = acc[ai][bj][m][1] * rs + cv[bj][1];
                u32x4 w; w.x = cvt_pk_bf16(v0[0], v0[1]); w.y = cvt_pk_bf16(v0[2], v0[3]); w.z = cvt_pk_bf16(v1[0], v1[1]); w.w = cvt_pk_bf16(v1[2], v1[3]);
                if (u.pn == 6 || u.pn == 7) { bf16_t* d = VT + ((size_t)(row >> 6) * 512 + (c0 - 1536)) * 64 + (row & 63);
                    d[0] = (bf16_t)w.x; d[64] = (bf16_t)(w.x >> 16); d[128] = (bf16_t)w.y; d[192] = (bf16_t)(w.y >> 16); d[256] = (bf16_t)w.z; d[320] = (bf16_t)(w.z >> 16); d[384] = (bf16_t)w.w; d[448] = (bf16_t)(w.w >> 16); }
                else { bf16_t* dst = (u.pn < 2) ? Ut + ((size_t)((c0 >> 4) * 1024 + (row >> 5)) * 640 + (row & 31) * 16 + (c0 & 15)) : QFG + (size_t)row * 1536 + (u.pn < 6 ? c0 - 512 : c0 - 1024);
                    *(u32x4*)dst = w; } }
        }
    }
};
struct EpiS5X {
    static constexpr bool PERM = false, AFTER_DRAIN = false;
    float* Xloc;
    __device__ __forceinline__ void operator()(const f32x4 (&acc)[2][2][4][2], const Unit& u, int wr, int wc, int fr, int fq) const {
#pragma unroll
        for (int ai = 0; ai < 2; ++ai)
#pragma unroll
        for (int m = 0; m < 4; ++m) { const int row = u.pm * BM + ai * HALF + wr * 64 + m * 16 + fr;
#pragma unroll
            for (int n = 0; n < 2; ++n) *(f32x4*)(Xloc + ((size_t)u.g * 1024 + row) * 128 + wc * 32 + 16 * n + 4 * fq) = acc[ai][0][m][n];
        }
    }
};
struct EpiS5Y {
    static constexpr bool PERM = true, AFTER_DRAIN = false;
    bf16_t* Y;
    __device__ __forceinline__ void operator()(const f32x4 (&acc)[2][2][4][2], const Unit& u, int wr, int wc, int fr, int fq) const {
#pragma unroll
        for (int ai = 0; ai < 2; ++ai)
#pragma unroll
        for (int m = 0; m < 4; ++m) { const int row = u.pm * BM + ai * HALF + wr * 64 + m * 16 + fr;
#pragma unroll
            for (int bj = 0; bj < 2; ++bj) { const int c0 = u.pn * BM + bj * HALF + wc * 32 + 8 * fq;
                const f32x4 a0 = acc[ai][bj][m][0], a1 = acc[ai][bj][m][1];
                u32x4 w; w.x = cvt_pk_bf16(fgelu_tanh(a0[0]), fgelu_tanh(a0[1])); w.y = cvt_pk_bf16(fgelu_tanh(a0[2]), fgelu_tanh(a0[3]));
                w.z = cvt_pk_bf16(fgelu_tanh(a1[0]), fgelu_tanh(a1[1])); w.w = cvt_pk_bf16(fgelu_tanh(a1[2]), fgelu_tanh(a1[3]));
                *(u32x4*)(Y + ((size_t)row * 32 + (c0 >> 4)) * 512 + u.g * 16 + (c0 & 15)) = w; }
        }
    }
};
struct EpiGlu {
    static constexpr bool PERM = true, AFTER_DRAIN = false;
    const bf16_t* Y; const float* bias; bf16_t* O; int ldo;
    __device__ __forceinline__ void operator()(const f32x4 (&acc)[2][2][4][2], const Unit& u, int wr, int wc, int fr, int fq) const {
        f32x4 bv[2][2];
#pragma unroll
        for (int bj = 0; bj < 2; ++bj)
#pragma unroll
            for (int n = 0; n < 2; ++n) bv[bj][n] = *(const f32x4*)(bias + u.pn * BM + bj * HALF + wc * 32 + 8 * fq + 4 * n);
#pragma unroll
        for (int ai = 0; ai < 2; ++ai)
#pragma unroll
        for (int m = 0; m < 4; ++m) { const int row = u.pm * BM + ai * HALF + wr * 64 + m * 16 + fr;
#pragma unroll
            for (int bj = 0; bj < 2; ++bj) { const int c0 = u.pn * BM + bj * HALF + wc * 32 + 8 * fq;
                const u32x4 yw = *(const u32x4*)(Y + (size_t)row * 512 + c0);
                const f32x4 a0 = acc[ai][bj][m][0] + bv[bj][0], a1 = acc[ai][bj][m][1] + bv[bj][1];
                u32x4 w; w.x = cvt_pk_bf16(bf_lo(yw.x) * fsigmoid(a0[0]), bf_hi(yw.x) * fsigmoid(a0[1])); w.y = cvt_pk_bf16(bf_lo(yw.y) * fsigmoid(a0[2]), bf_hi(yw.y) * fsigmoid(a0[3]));
                w.z = cvt_pk_bf16(bf_lo(yw.z) * fsigmoid(a1[0]), bf_hi(yw.z) * fsigmoid(a1[1])); w.w = cvt_pk_bf16(bf_lo(yw.w) * fsigmoid(a1[2]), bf_hi(yw.w) * fsigmoid(a1[3]));
                *(u32x4*)(O + (size_t)row * ldo + c0) = w; }
        }
    }
};
struct EpiResid {
    static constexpr bool PERM = true, AFTER_DRAIN = false;
    const float* xold; float* xnew; bf16_t* xb; float* rowsq; const float* gate; int gstride;
    __device__ __forceinline__ void operator()(const f32x4 (&acc)[2][2][4][2], const Unit& u, int wr, int wc, int fr, int fq) const {
        f32x4 gv[2][2];
#pragma unroll
        for (int bj = 0; bj < 2; ++bj)
#pragma unroll
            for (int n = 0; n < 2; ++n) gv[bj][n] = *(const f32x4*)(gate + u.g * gstride + u.pn * BM + bj * HALF + wc * 32 + 8 * fq + 4 * n);
#pragma unroll
        for (int ai = 0; ai < 2; ++ai)
#pragma unroll
        for (int m = 0; m < 4; ++m) { const int row = u.pm * BM + ai * HALF + wr * 64 + m * 16 + fr;
            float sq = 0.f;
#pragma unroll
            for (int bj = 0; bj < 2; ++bj) { const size_t off = (size_t)row * 1024 + u.pn * BM + bj * HALF + wc * 32 + 8 * fq;
                const f32x4 x0 = *(const f32x4*)(xold + off), x1 = *(const f32x4*)(xold + off + 4);
                const f32x4 v0 = x0 + gv[bj][0] * acc[ai][bj][m][0], v1 = x1 + gv[bj][1] * acc[ai][bj][m][1];
                *(f32x4*)(xnew + off) = v0; *(f32x4*)(xnew + off + 4) = v1;
                sq += (v0[0] * v0[0] + v0[1] * v0[1]) + (v0[2] * v0[2] + v0[3] * v0[3]) + (v1[0] * v1[0] + v1[1] * v1[1]) + (v1[2] * v1[2] + v1[3] * v1[3]);
                u32x4 w; w.x = cvt_pk_bf16(v0[0], v0[1]); w.y = cvt_pk_bf16(v0[2], v0[3]); w.z = cvt_pk_bf16(v1[0], v1[1]); w.w = cvt_pk_bf16(v1[2], v1[3]);
                *(u32x4*)(xb + off) = w; }
            sq += __shfl_xor(sq, 16); sq += __shfl_xor(sq, 32);
            if (fq == 0) rowsq[(size_t)row * 16 + u.pn * 4 + wc] = sq;
        }
    }
};
struct EpiFfnUp {
    static constexpr bool PERM = true, AFTER_DRAIN = false;
    const float* rowsq; const float* cvec; bf16_t* H;
    __device__ __forceinline__ void operator()(const f32x4 (&acc)[2][2][4][2], const Unit& u, int wr, int wc, int fr, int fq) const {
        f32x4 cv[2][2];
#pragma unroll
        for (int bj = 0; bj < 2; ++bj)
#pragma unroll
            for (int n = 0; n < 2; ++n) cv[bj][n] = *(const f32x4*)(cvec + u.g * 5632 + u.pn * BM + bj * HALF + wc * 32 + 8 * fq + 4 * n);
float rs8[2][4]; rowstats8(rowsq, u.pm * BM + wr * 64 + fr, fq, rs8);
#pragma unroll
        for (int ai = 0; ai < 2; ++ai)
#pragma unroll
        for (int m = 0; m < 4; ++m) { const int row = u.pm * BM + ai * HALF + wr * 64 + m * 16 + fr;
            const float rs = rs8[ai][m];
            const f32x4 a0 = acc[ai][0][m][0] * rs + cv[0][0], a1 = acc[ai][0][m][1] * rs + cv[0][1], b0 = acc[ai][1][m][0] * rs + cv[1][0], b1 = acc[ai][1][m][1] * rs + cv[1][1];
            u32x4 w; w.x = cvt_pk_bf16(fsilu(a0[0]) * b0[0], fsilu(a0[1]) * b0[1]); w.y = cvt_pk_bf16(fsilu(a0[2]) * b0[2], fsilu(a0[3]) * b0[3]);
            w.z = cvt_pk_bf16(fsilu(a1[0]) * b1[0], fsilu(a1[1]) * b1[1]); w.w = cvt_pk_bf16(fsilu(a1[2]) * b1[2], fsilu(a1[3]) * b1[3]);
            *(u32x4*)(H + (size_t)row * 2816 + u.pn * HALF + wc * 32 + 8 * fq) = w;
        }
    }
};
struct EpiIn1 {
    static constexpr bool PERM = true, AFTER_DRAIN = false;
    const float* rowsq; const float* cvec; const float* ba; bf16_t* Z; bf16_t* VT;
    __device__ __forceinline__ void operator()(const f32x4 (&acc)[2][2][4][2], const Unit& u, int wr, int wc, int fr, int fq) const {
        f32x4 cv[2][2];
#pragma unroll
        for (int bj = 0; bj < 2; ++bj)
#pragma unroll
            for (int n = 0; n < 2; ++n) { const int c = u.pn * BM + bj * HALF + wc * 32 + 8 * fq + 4 * n; cv[bj][n] = *(const f32x4*)(cvec + u.g * 3584 + c); if (u.pn >= 12) cv[bj][n] += *(const f32x4*)(ba + c - 3072); }
float rs8[2][4]; rowstats8(rowsq, u.pm * BM + wr * 64 + fr, fq, rs8);
#pragma unroll
        for (int ai = 0; ai < 2; ++ai)
#pragma unroll
        for (int m = 0; m < 4; ++m) { const int row = u.pm * BM + ai * HALF + wr * 64 + m * 16 + fr;
            const float rs = rs8[ai][m];
#pragma unroll
            for (int bj = 0; bj < 2; ++bj) { const int c0 = u.pn * BM + bj * HALF + wc * 32 + 8 * fq;
                f32x4 v0 = acc[ai][bj][m][0] * rs + cv[bj][0], v1 = acc[ai][bj][m][1] * rs + cv[bj][1];
                if (u.pn < 2) { v0 = v0 * 0.08838834764831845f; v1 = v1 * 0.08838834764831845f; }
                if (u.pn >= 12) {
#pragma unroll
                    for (int e = 0; e < 4; ++e) { v0[e] = flogsigmoid(v0[e]); v1[e] = flogsigmoid(v1[e]); } }
                u32x4 w; w.x = cvt_pk_bf16(v0[0], v0[1]); w.y = cvt_pk_bf16(v0[2], v0[3]); w.z = cvt_pk_bf16(v1[0], v1[1]); w.w = cvt_pk_bf16(v1[2], v1[3]);
                if (u.pn >= 4 && u.pn < 8) { bf16_t* d = VT + ((size_t)(row >> 6) * 1024 + (c0 - 1024)) * 64 + (row & 63);
                    d[0] = (bf16_t)w.x; d[64] = (bf16_t)(w.x >> 16); d[128] = (bf16_t)w.y; d[192] = (bf16_t)(w.y >> 16); d[256] = (bf16_t)w.z; d[320] = (bf16_t)(w.z >> 16); d[384] = (bf16_t)w.w; d[448] = (bf16_t)(w.w >> 16); }
                else *(u32x4*)(Z + (size_t)row * 2560 + (u.pn < 4 ? c0 : c0 - 1024)) = w; }
        }
    }
};

template <class Epi, class Sched, bool ALIGN_EPI>
__device__ __forceinline__ void gemm_phase(PG8_LAS unsigned char* lds, const Gemm g, const Sched& S, const Epi& E) {
    const int tid = threadIdx.x, wid = __builtin_amdgcn_readfirstlane(tid >> 6), lane = tid & 63, wr = wid >> 2, wc = wid & 3, fr = lane & 15, fq = lane >> 4;
    const int K = g.K, nt = K / BK;
    unsigned voffA[2], voffB[2];
#pragma unroll
    for (int i = 0; i < 2; ++i) { int R, C; stage_rc(tid * 16 + i * 8192, R, C); const int Rb = Epi::PERM ? ((R & ~31) + perm32(R & 31)) : R;
        voffA[i] = (unsigned)(R * g.lda + C) * 2u; voffB[i] = (unsigned)(Rb * g.ldb + C) * 2u; }
    const size_t kstep = (size_t)(BK * 2);
    const size_t hstepA = (size_t)HALF * g.lda * 2, hstepB = (size_t)HALF * g.ldb * 2;
    const unsigned ldsw = (unsigned)wid * 1024u;
    const int aoff = lds_byte(wr * 64 + fr, fq * 8), boff = lds_byte(wc * 32 + fr, fq * 8);
#define PG8_SA(b, h) (((b) * 2 + (h)) * HTB)
#define PG8_SB(b, h) ((4 + (b) * 2 + (h)) * HTB)
#define PG8_STAGE(bufoff, gbase, voff) do { _Pragma("unroll") for (int _i = 0; _i < 2; ++_i) \
        __builtin_amdgcn_global_load_lds((const unsigned*)((const char*)(gbase) + (voff)[_i]), (PG8_LAS unsigned*)(lds + (bufoff) + ldsw + _i * 8192), 16, 0, 0); } while (0)
#define PG8_LDA(dst, b, h) do { _Pragma("unroll") for (int m = 0; m < 4; ++m) _Pragma("unroll") for (int k = 0; k < 2; ++k) dst[m][k] = *(const PG8_LAS bf16x8*)(lds + PG8_SA(b, h) + aoff + m * 2048 + k * 1024); } while (0)
#define PG8_LDB(dst, b, h) do { _Pragma("unroll") for (int n = 0; n < 2; ++n) _Pragma("unroll") for (int k = 0; k < 2; ++k) dst[n][k] = *(const PG8_LAS bf16x8*)(lds + PG8_SB(b, h) + boff + n * 2048 + k * 1024); } while (0)
#define PG8_MMA(ai, bj, At, Bt) do { __builtin_amdgcn_s_setprio(1); _Pragma("unroll") for (int m = 0; m < 4; ++m) _Pragma("unroll") for (int n = 0; n < 2; ++n) _Pragma("unroll") for (int k = 0; k < 2; ++k) \
        acc[ai][bj][m][n] = __builtin_amdgcn_mfma_f32_16x16x32_bf16(Bt[n][k], At[m][k], acc[ai][bj][m][n], 0, 0, 0); __builtin_amdgcn_s_setprio(0); } while (0)
#define PG8_WAIT_V(n) asm volatile("s_waitcnt vmcnt(" #n ")" ::: "memory")
#define PG8_WAIT_L(n) asm volatile("s_waitcnt lgkmcnt(" #n ")" ::: "memory")
#define PG8_BAR __builtin_amdgcn_s_barrier()
#define PG8_SCHED __builtin_amdgcn_sched_barrier(0)
    Unit cur, nxt; int ui = 0;
    if (!S.next(0, cur)) return;
    f32x4 acc[2][2][4][2];
#pragma unroll
    for (int a = 0; a < 2; ++a)
#pragma unroll
        for (int b = 0; b < 2; ++b)
#pragma unroll
            for (int m = 0; m < 4; ++m)
#pragma unroll
                for (int n = 0; n < 2; ++n) acc[a][b][m][n] = (f32x4){0.f, 0.f, 0.f, 0.f};
    bf16x8 At[4][2], B0[2][2], B1[2][2];
    const char* cA = (const char*)g.A + cur.aoff + (size_t)cur.pm * 2 * hstepA; const char* cB = (const char*)g.Bt + cur.boff + (size_t)cur.pn * 2 * hstepB;
    PG8_STAGE(PG8_SB(0, 0), cB, voffB); PG8_STAGE(PG8_SB(0, 1), cB + hstepB, voffB); PG8_STAGE(PG8_SA(0, 0), cA, voffA); PG8_STAGE(PG8_SA(0, 1), cA + hstepA, voffA);
    if (wr == 1) PG8_BAR;
    PG8_WAIT_V(2); PG8_BAR;
    PG8_STAGE(PG8_SB(1, 0), cB + kstep, voffB); PG8_STAGE(PG8_SA(1, 0), cA + kstep, voffA); PG8_STAGE(PG8_SB(1, 1), cB + hstepB + kstep, voffB);
    PG8_WAIT_V(6); PG8_BAR;
    for (;;) {
        const bool has_next = S.next(ui + 1, nxt);
        const char* nA = has_next ? (const char*)g.A + nxt.aoff + (size_t)nxt.pm * 2 * hstepA : cA; const char* nB = has_next ? (const char*)g.Bt + nxt.boff + (size_t)nxt.pn * 2 * hstepB : cB;
        for (int t = 0; t < nt; t += 2) {
            const bool last = (t == nt - 2);
            const char* a1 = cA + (size_t)(t + 1) * kstep;
            const char* a2 = last ? nA : cA + (size_t)(t + 2) * kstep; const char* b2 = last ? nB : cB + (size_t)(t + 2) * kstep;
            const char* a3 = a2 + kstep; const char* b3 = b2 + kstep;
            PG8_LDB(B0, 0, 0); PG8_LDB(B1, 0, 1); PG8_SCHED; PG8_LDA(At, 0, 0); PG8_STAGE(PG8_SA(1, 1), a1 + hstepA, voffA);
            PG8_WAIT_V(8); PG8_WAIT_L(0); PG8_BAR; PG8_MMA(0, 0, At, B0); PG8_MMA(0, 1, At, B1); PG8_BAR; PG8_SCHED;
            PG8_LDA(At, 0, 1); PG8_STAGE(PG8_SB(0, 0), b2, voffB); PG8_STAGE(PG8_SB(0, 1), b2 + hstepB, voffB); PG8_STAGE(PG8_SA(0, 0), a2, voffA);
            PG8_WAIT_V(8); PG8_WAIT_L(0); PG8_BAR; PG8_MMA(1, 0, At, B0); PG8_MMA(1, 1, At, B1); PG8_BAR; PG8_SCHED;
            PG8_LDB(B0, 1, 0); PG8_LDB(B1, 1, 1); PG8_SCHED; PG8_LDA(At, 1, 0); PG8_STAGE(PG8_SA(0, 1), a2 + hstepA, voffA);
            PG8_WAIT_V(8); PG8_WAIT_L(0); PG8_BAR; PG8_MMA(0, 0, At, B0); PG8_MMA(0, 1, At, B1); PG8_BAR; PG8_SCHED;
            PG8_LDA(At, 1, 1); PG8_STAGE(PG8_SB(1, 0), b3, voffB); PG8_STAGE(PG8_SB(1, 1), b3 + hstepB, voffB); PG8_STAGE(PG8_SA(1, 0), a3, voffA);
            PG8_WAIT_V(8); PG8_WAIT_L(0); PG8_BAR; PG8_MMA(1, 0, At, B0); PG8_MMA(1, 1, At, B1); PG8_BAR; PG8_SCHED;
        }
        if constexpr (ALIGN_EPI) { if (wr == 0) PG8_BAR; }
        E(acc, cur, wr, wc, fr, fq);
        if (!has_next) break;
#pragma unroll
        for (int a = 0; a < 2; ++a)
#pragma unroll
            for (int b = 0; b < 2; ++b)
#pragma unroll
                for (int m = 0; m < 4; ++m)
#pragma unroll
                    for (int n = 0; n < 2; ++n) acc[a][b][m][n] = (f32x4){0.f, 0.f, 0.f, 0.f};
        cur = nxt; cA = nA; cB = nB; ++ui;
        if constexpr (ALIGN_EPI) { if (wr == 1) PG8_BAR; }
    }
    PG8_WAIT_V(0);
    if constexpr (!ALIGN_EPI) { if (wr == 0) PG8_BAR; }
    PG8_BAR;
#undef PG8_SA
#undef PG8_SB
#undef PG8_STAGE
#undef PG8_LDA
#undef PG8_LDB
#undef PG8_MMA
#undef PG8_WAIT_V
#undef PG8_WAIT_L
#undef PG8_BAR
#undef PG8_SCHED
}
}
constexpr int NWAVES = 8;
constexpr int BATCH = 2, SEQ = 16384, D = 1024, T = BATCH * SEQ;
constexpr int FF = 2816, S5W = 512, S5G = 32, S5P = 64, LC = 32, NCH = T / LC  , UTP = LC * 16 + 128  ;
constexpr int N_IN0 = 2560, N_IN1 = 3584, N_UP = 5632;
constexpr float EPS = 1e-6f;
constexpr size_t MiB = 1u << 20;
constexpr size_t WS_CTL = 0, CTL_ZERO_BYTES = 1 * MiB;
constexpr size_t WS_MOD = 1 * MiB;
constexpr size_t WS_CV = 1 * MiB + 128 * 1024;
constexpr int CV_IN0 = 0, CV_UP0 = 2 * N_IN0, CV_IN1 = CV_UP0 + 2 * N_UP, CV_UP1 = CV_IN1 + 2 * N_IN1;
constexpr size_t WS_S5LAM = 1 * MiB + 512 * 1024;
constexpr size_t WS_WIN0 = 2 * MiB, WS_WOUT0 = 12 * MiB, WS_WGLU = 14 * MiB, WS_S5F = 15 * MiB, WS_S5T = 23 * MiB, WS_W13_0 = 43 * MiB, WS_W2_0 = 65 * MiB,
                 WS_WIN1 = 71 * MiB, WS_WOUT1 = 85 * MiB, WS_W13_1 = 87 * MiB, WS_W2_1 = 109 * MiB;
constexpr size_t WS_ROWSQ = 115 * MiB, WS_XB = 117 * MiB, WS_POOL = 181 * MiB, WS_END = 512 * MiB;
constexpr size_t WS_UT = WS_POOL, WS_QFG = 221 * MiB, WS_VT0 = 317 * MiB, WS_XLOC = 349 * MiB, WS_YGELU = 365 * MiB, WS_MIXED = 397 * MiB, WS_HGA = 461 * MiB, WS_HGD = 477 * MiB;
constexpr size_t WS_WA = 349 * MiB;
constexpr size_t WS_HID = WS_POOL;
constexpr size_t WS_Z1 = WS_POOL, WS_VT1 = 341 * MiB, WS_MIXED2 = 405 * MiB, WS_GLA_A = 469 * MiB, WS_GLA_D = 501 * MiB;
static_assert(WS_WIN0 + (size_t)2 * N_IN0 * D * 2 <= WS_WOUT0 && WS_S5F + (size_t)S5G * 256 * 512 * 2 <= WS_S5T && WS_S5T + (size_t)S5G * 512 * UTP * 2 <= WS_W13_0 && WS_W13_0 + (size_t)2 * N_UP * D * 2 <= WS_W2_0 &&
              WS_W2_0 + (size_t)D * FF * 2 <= WS_WIN1 && WS_WIN1 + (size_t)2 * N_IN1 * D * 2 <= WS_WOUT1 && WS_W13_1 + (size_t)2 * N_UP * D * 2 <= WS_W2_1 && WS_W2_1 + (size_t)D * FF * 2 <= WS_ROWSQ, "weights map");
static_assert(WS_UT + (size_t)S5G * NCH * UTP * 2 <= WS_QFG && WS_QFG + (size_t)T * 1536 * 2 <= WS_VT0 && WS_VT0 + (size_t)T * 512 * 2 <= WS_XLOC && WS_XLOC + (size_t)S5G * NCH * 128 * 4 <= WS_YGELU && WS_YGELU + (size_t)T * 512 * 2 <= WS_MIXED &&
              WS_MIXED + (size_t)T * D * 2 <= WS_HGA && WS_HGA + (size_t)8 * 32 * 128 * 128 * 4 <= WS_HGD && WS_HID + (size_t)T * FF * 2 <= WS_END && WS_Z1 + (size_t)T * 2560 * 2 <= WS_VT1 && WS_VT1 + (size_t)T * D * 2 <= WS_MIXED2 &&
              WS_MIXED2 + (size_t)T * D * 2 <= WS_GLA_A && WS_GLA_A + (size_t)8 * 32 * 128 * 256 * 4 <= WS_GLA_D && WS_GLA_D + 8 * 32 * 128 * 4 <= WS_END, "pool map");
constexpr int CW_BAR = 4096;

constexpr int RING_OFF = 0, RING_BYTES = 131072;
constexpr int LDSCTL_OFF = RING_BYTES, MISC_OFF = LDSCTL_OFF + 320;
constexpr int LDS_BYTES = 147456;
static_assert(MISC_OFF + 128 <= LDS_BYTES, "LDS map");

#define GAS __attribute__((address_space(1)))
#define LAS __attribute__((address_space(3)))
typedef unsigned short bf16;
typedef unsigned v4u __attribute__((ext_vector_type(4)));
typedef unsigned v2u __attribute__((ext_vector_type(2)));
typedef float f32x4 __attribute__((ext_vector_type(4)));
typedef GAS unsigned gu32;
#define RLX_AGENT __ATOMIC_RELAXED, __HIP_MEMORY_SCOPE_AGENT
#define LDS_WAIT() asm volatile("s_waitcnt lgkmcnt(0)" ::: "memory")
#define VM_WAIT() asm volatile("s_waitcnt vmcnt(0)" ::: "memory")
__device__ __forceinline__ unsigned f2bf(float f) { unsigned u = __builtin_bit_cast(unsigned, f); return (u + 0x7fffu + ((u >> 16) & 1u)) >> 16; }
__device__ __forceinline__ unsigned pk2(float lo, float hi) { return f2bf(lo) | (f2bf(hi) << 16); }
__device__ __forceinline__ float bf2f(bf16 v) { return __uint_as_float((unsigned)v << 16); }

#define XB_TMO      128
#define XB_XCNT(j)  (256  + 64 * (j))
#define XB_XSUB(j)  (1280 + 64 * (j))
#define XB_XGEN(j)  (2304 + 64 * (j))
#define XB_TOP      3328
#define XB_TOPGEN   3392
#define XCD_BAR_WORDS 3456
#define XB_SPIN_CAP (1u << 18)
__device__ __forceinline__ unsigned xb_ld(unsigned* p)              { return __hip_atomic_load(p, __ATOMIC_RELAXED, __HIP_MEMORY_SCOPE_AGENT); }
__device__ __forceinline__ unsigned xb_add(unsigned* p, unsigned v) { return __hip_atomic_fetch_add(p, v, __ATOMIC_RELAXED, __HIP_MEMORY_SCOPE_AGENT); }
__device__ __forceinline__ unsigned xb_xcc_id() { return (unsigned)__builtin_amdgcn_s_getreg((3 << 11) | 20) & 0xFu; }
#define XB_SPIN(cond, bar) do { unsigned _sp = 0; while (cond) { __builtin_amdgcn_s_sleep(1); \
    if ((++_sp & 255u) == 0u) { if (xb_ld(&(bar)[XB_TMO])) break; if (_sp > XB_SPIN_CAP) { atomicAdd(&(bar)[XB_TMO], 1u); break; } } } } while (0)
struct XcdBarrier { unsigned* bar; unsigned x; volatile LAS unsigned* st; };
__device__ __forceinline__ XcdBarrier xcd_barrier_post(unsigned* bar, volatile LAS unsigned* st) {
    XcdBarrier b; b.bar = bar; b.x = xb_xcc_id(); b.st = st;
    if (threadIdx.x == 0) (void)xb_add(&bar[XB_XCNT(b.x)], 1u);
    return b;
}
__device__ __forceinline__ void xcd_barrier_complete(unsigned* bar, unsigned x, unsigned& nloc, unsigned& nx) {
    const unsigned G = gridDim.x * gridDim.y * gridDim.z;
    unsigned sum, cnt, mine, sp = 0u;
    for (;;) {
        sum = 0u; cnt = 0u; mine = 0u;
#pragma unroll
        for (unsigned j = 0; j < 16; ++j) { const unsigned c = xb_ld(&bar[XB_XCNT(j)]); sum += c; cnt += (c > 0u) ? 1u : 0u; mine = (j == x) ? c : mine; }
        if (sum == G) break;
        __builtin_amdgcn_s_sleep(1);
        if ((++sp & 255u) == 0u) { if (xb_ld(&bar[XB_TMO])) break; if (sp > XB_SPIN_CAP) { atomicAdd(&bar[XB_TMO], 1u); break; } }
    }
    nloc = mine > 0u ? mine : 1u; nx = cnt > 0u ? cnt : 1u;
}
__device__ __forceinline__ void xcd_barrier(const XcdBarrier& b) {
    asm volatile("s_waitcnt vmcnt(0)" ::: "memory");
    __syncthreads();
    if (threadIdx.x == 0) {
        unsigned* bar = b.bar;
        __builtin_amdgcn_s_waitcnt(0);
        unsigned nloc = b.st[0], nx = b.st[1];
        if (nloc == 0u) { xcd_barrier_complete(bar, b.x, nloc, nx); b.st[0] = nloc; b.st[1] = nx; }
        const unsigned old = xb_add(&bar[XB_XSUB(b.x)], 1u);
        const unsigned gen = old / nloc;
        if (old + 1u == (gen + 1u) * nloc) {
            __builtin_amdgcn_fence(__ATOMIC_RELEASE, "agent");
            asm volatile("s_waitcnt vmcnt(0)" ::: "memory");
            const unsigned og = xb_add(&bar[XB_TOP], 1u);
            const unsigned tg = og / nx;
            if (og + 1u == (tg + 1u) * nx) xb_add(&bar[XB_TOPGEN], 1u);
            else XB_SPIN(xb_ld(&bar[XB_TOPGEN]) == tg, bar);
            __builtin_amdgcn_fence(__ATOMIC_ACQUIRE, "agent");
            xb_add(&bar[XB_XGEN(b.x)], 1u);
            asm volatile("s_waitcnt vmcnt(0)" ::: "memory");
        } else {
            XB_SPIN(xb_ld(&bar[XB_XGEN(b.x)]) == gen, bar);
            __builtin_amdgcn_fence(__ATOMIC_ACQUIRE, "agent");
            asm volatile("s_waitcnt vmcnt(0)" ::: "memory");
        }
    }
    __syncthreads();
}

struct Args { const float* in[30]; float* out; unsigned char* ws; int ph_lo, ph_hi; };
enum InIdx { I_X = 0, I_C, I_ADAW, I_ADAB, I_NMG, I_NFG, I_EVWIN, I_EVWOUT, I_LAMRE, I_LAMIM, I_BRE, I_BIM, I_CRE, I_CIM, I_S5D, I_LOGSTEP, I_WGLU, I_BGLU, I_LBLOG, I_HGNORM,
             I_ODWIN, I_ODWA1, I_ODWA2, I_ODBA, I_GLANORM, I_ODWOUT, I_W1, I_W3, I_W2, I_FNORM };
struct Frame {
    LAS unsigned char* lds;
    volatile LAS unsigned* MISC;
    gu32* ctl;
    int tid, lane, wave, vcu, G;
    const float* const* in; float* out; unsigned char* ws;
};
__device__ __forceinline__ float wave_sum(float v) {
#pragma unroll
    for (int o = 1; o < 64; o <<= 1) v += __shfl_xor(v, o);
    return v;
}
__device__ __forceinline__ float dsilu(float x) { return x / (1.0f + expf(-x)); }

__device__ __forceinline__ void tile_store(const LAS float* scr, bf16* dst  , int ldk, const float* sc  , int lane) {
    const int c = lane & 7;
    float s8[8];
#pragma unroll
    for (int j = 0; j < 8; ++j) s8[j] = sc ? sc[8 * c + j] : 1.0f;
#pragma unroll
    for (int j = 0; j < 4; ++j) { const int n = (lane >> 3) + 8 * j; const LAS float* s = scr + (8 * c) * 33 + n;
        v4u o; o.x = pk2(s[0 * 33] * s8[0], s[1 * 33] * s8[1]); o.y = pk2(s[2 * 33] * s8[2], s[3 * 33] * s8[3]); o.z = pk2(s[4 * 33] * s8[4], s[5 * 33] * s8[5]); o.w = pk2(s[6 * 33] * s8[6], s[7 * 33] * s8[7]);
        *(GAS v4u*)(dst + (size_t)n * ldk + 8 * c) = o; }
}
__device__ __forceinline__ void tile_load(const float* W  , int ldw, LAS float* scr, int lane) {
    const int nn = (lane & 7) * 4, kr = lane >> 3; f32x4 v[8];
#pragma unroll
    for (int i = 0; i < 8; ++i) v[i] = *(const GAS f32x4*)(W + (size_t)(kr + 8 * i) * ldw + nn);
#pragma unroll
    for (int i = 0; i < 8; ++i) { LAS float* d = scr + (kr + 8 * i) * 33 + nn; d[0] = v[i].x; d[1] = v[i].y; d[2] = v[i].z; d[3] = v[i].w; }
}
__device__ __forceinline__ void p_transpose_item(const float* W, int K, int N, bf16* WT, LAS float* scr, int item, int lane) {
    const int nblk = N / 32, kb = item / nblk, nb = item % nblk, k0 = 64 * kb, n0 = 32 * nb;
    tile_load(W + (size_t)k0 * N + n0, N, scr, lane);
    LDS_WAIT(); asm volatile("" ::: "memory");
    tile_store(scr, WT + (size_t)n0 * K + k0, K, nullptr, lane);
    LDS_WAIT(); asm volatile("" ::: "memory");
}

__device__ __forceinline__ void s5_constants(Frame& F, int g) {
    LAS float* PW = (LAS float*)(F.lds + RING_OFF);
    LAS float* BB = (LAS float*)(F.lds + RING_OFF + 17408);
    LAS float* CC = (LAS float*)(F.lds + RING_OFF + 25600);
    LAS float* KD = (LAS float*)(F.lds + RING_OFF + 33792);
    LAS float* QQ = (LAS float*)(F.lds + RING_OFF + 66560);
    const float* lam_re = F.in[I_LAMRE] + g * 64; const float* lam_im = F.in[I_LAMIM] + g * 64;
    const float* b_re = F.in[I_BRE] + g * 1024; const float* b_im = F.in[I_BIM] + g * 1024;
    const float* c_re = F.in[I_CRE] + g * 1024; const float* c_im = F.in[I_CIM] + g * 1024;
    if (F.tid < 64) { const int p = F.tid; const double dl = exp((double)F.in[I_LOGSTEP][g]);
        const double lr = lam_re[p], li = lam_im[p]; const double mag = exp(lr * dl); double sn, cs; sincos(li * dl, &sn, &cs);
        const double ar = mag * cs, ai = mag * sn;
        const double nr = ar - 1.0, ni = ai, den = lr * lr + li * li;
        QQ[p * 2] = (float)((nr * lr + ni * li) / den); QQ[p * 2 + 1] = (float)((ni * lr - nr * li) / den);
        double pr = 1.0, pi = 0.0;
        for (int d = 0; d <= LC; ++d) { PW[(d * 64 + p) * 2] = (float)pr; PW[(d * 64 + p) * 2 + 1] = (float)pi; const double tr = pr * ar - pi * ai, ti = pr * ai + pi * ar; pr = tr; pi = ti; } }
    for (int idx = F.tid; idx < 1024; idx += NWAVES * 64) { CC[idx * 2] = c_re[idx]; CC[idx * 2 + 1] = c_im[idx]; }
    __syncthreads();
    for (int idx = F.tid; idx < 1024; idx += NWAVES * 64) { const int p = idx >> 4; const float qr = QQ[p * 2], qi = QQ[p * 2 + 1], br = b_re[idx], bi = b_im[idx];
        BB[idx * 2] = qr * br - qi * bi; BB[idx * 2 + 1] = qr * bi + qi * br; }
    __syncthreads();
    { const int d = F.tid >> 4, ho0 = ((F.tid >> 2) & 3) * 4, hi0 = (F.tid & 3) * 4; float acc[4][4];
#pragma unroll
      for (int a = 0; a < 4; ++a)
#pragma unroll
          for (int q = 0; q < 4; ++q) acc[a][q] = 0.f;
      for (int p = 0; p < 64; ++p) { const float pr = PW[(d * 64 + p) * 2], pi = PW[(d * 64 + p) * 2 + 1]; float xr[4], xi[4];
#pragma unroll
          for (int a = 0; a < 4; ++a) { const float cr = CC[((ho0 + a) * 64 + p) * 2], ci = CC[((ho0 + a) * 64 + p) * 2 + 1]; xr[a] = cr * pr - ci * pi; xi[a] = cr * pi + ci * pr; }
          const f32x4 b0 = *(const LAS f32x4*)(BB + (p * 16 + hi0) * 2), b1 = *(const LAS f32x4*)(BB + (p * 16 + hi0) * 2 + 4);
          const float br[4] = {b0[0], b0[2], b1[0], b1[2]}, bi[4] = {b0[1], b0[3], b1[1], b1[3]};
#pragma unroll
          for (int a = 0; a < 4; ++a)
#pragma unroll
              for (int q = 0; q < 4; ++q) acc[a][q] += xr[a] * br[q] - xi[a] * bi[q]; }
#pragma unroll
      for (int a = 0; a < 4; ++a)
#pragma unroll
          for (int q = 0; q < 4; ++q) { float v = acc[a][q]; if (d == 0 && ho0 + a == hi0 + q) v += F.in[I_S5D][g * 16 + ho0 + a]; KD[(d * 16 + ho0 + a) * 16 + hi0 + q] = v; } }
    __syncthreads();
    bf16* Tg = (bf16*)(F.ws + WS_S5T) + (size_t)g * 512 * UTP;
    for (int idx = F.tid; idx < 512 * 64; idx += NWAVES * 64) { const int n = idx >> 6, kc = idx & 63, l = n >> 4, ho = n & 15, j = kc >> 1, hi0 = (kc & 1) * 8;
        v4u o = (v4u){0u, 0u, 0u, 0u};
        if (j <= l) { const LAS float* k = KD + ((l - j) * 16 + ho) * 16 + hi0; o.x = pk2(k[0], k[1]); o.y = pk2(k[2], k[3]); o.z = pk2(k[4], k[5]); o.w = pk2(k[6], k[7]); }
        *(GAS v4u*)(Tg + (size_t)n * UTP + kc * 8) = o; }
    for (int idx = F.tid; idx < 512 * 16; idx += NWAVES * 64) { const int n = idx >> 4, pc = idx & 15, l = n >> 4, ho = n & 15, im = pc >> 3, p0 = (pc & 7) * 8; float v[8];
#pragma unroll
        for (int e = 0; e < 8; ++e) { const int p = p0 + e; const float cr = CC[(ho * 64 + p) * 2], ci = CC[(ho * 64 + p) * 2 + 1], pr = PW[((l + 1) * 64 + p) * 2], pi = PW[((l + 1) * 64 + p) * 2 + 1];
            v[e] = im ? -(cr * pi + ci * pr) : (cr * pr - ci * pi); }
        v4u o; o.x = pk2(v[0], v[1]); o.y = pk2(v[2], v[3]); o.z = pk2(v[4], v[5]); o.w = pk2(v[6], v[7]);
        *(GAS v4u*)(Tg + (size_t)n * UTP + 512 + pc * 8) = o; }
    bf16* Fg = (bf16*)(F.ws + WS_S5F) + (size_t)g * 256 * 512;
    for (int idx = F.tid; idx < 256 * 64; idx += NWAVES * 64) { const int r = idx >> 6, kc = idx & 63, j = kc >> 1, hi0 = (kc & 1) * 8;
        v4u o = (v4u){0u, 0u, 0u, 0u};
        if (r < 128) { const int p = r & 63, im = r >> 6; const float pr = PW[((LC - 1 - j) * 64 + p) * 2], pi = PW[((LC - 1 - j) * 64 + p) * 2 + 1]; float v[8];
#pragma unroll
            for (int e = 0; e < 8; ++e) { const float br = BB[(p * 16 + hi0 + e) * 2], bi = BB[(p * 16 + hi0 + e) * 2 + 1]; v[e] = im ? (pr * bi + pi * br) : (pr * br - pi * bi); }
            o.x = pk2(v[0], v[1]); o.y = pk2(v[2], v[3]); o.z = pk2(v[4], v[5]); o.w = pk2(v[6], v[7]); }
        *(GAS v4u*)(Fg + (size_t)r * 512 + kc * 8) = o; }
    if (F.tid < 64) { float* L = (float*)(F.ws + WS_S5LAM) + (g * 64 + F.tid) * 2; L[0] = PW[(LC * 64 + F.tid) * 2]; L[1] = PW[(LC * 64 + F.tid) * 2 + 1]; }
    __syncthreads();
}
template <class WF, class VF> __device__ __forceinline__ void gemv64(Frame& F, WF wf, VF vf, float& o0, float& o1) {
    LAS float* red = (LAS float*)(F.lds + RING_OFF);
    float a0 = 0.f, a1 = 0.f; const int kb = F.wave * 128;
#pragma unroll 16
    for (int k = 0; k < 128; ++k) { const float w = wf(kb + k); a0 += vf(0, kb + k) * w; a1 += vf(1, kb + k) * w; }
    red[(F.wave * 2 + 0) * 64 + F.lane] = a0; red[(F.wave * 2 + 1) * 64 + F.lane] = a1;
    __syncthreads();
    o0 = 0.f; o1 = 0.f;
    if (F.wave == 0) {
#pragma unroll
        for (int w = 0; w < 8; ++w) { o0 += red[(w * 2 + 0) * 64 + F.lane]; o1 += red[(w * 2 + 1) * 64 + F.lane]; } }
    __syncthreads();
}
__device__ __forceinline__ void p0_prologue_a(Frame& F) {
    for (int t = F.vcu * NWAVES * 64 + F.tid; t < 1024 * 128; t += F.G * NWAVES * 64) { const int k = t >> 7, n4 = (t & 127) * 4;
        const f32x4* a1 = (const f32x4*)(F.in[I_ODWA1] + k * 16); const float* a2 = F.in[I_ODWA2] + n4; f32x4 acc = (f32x4){0.f, 0.f, 0.f, 0.f};
#pragma unroll
        for (int r4 = 0; r4 < 4; ++r4) { const f32x4 av = a1[r4];
#pragma unroll
            for (int e = 0; e < 4; ++e) acc += *(const f32x4*)(a2 + (size_t)(r4 * 4 + e) * 512) * av[e]; }
        *(f32x4*)((float*)(F.ws + WS_WA) + (size_t)k * 512 + n4) = acc; }
    if (F.vcu < 32) { s5_constants(F, F.vcu); return; }
    if (F.vcu < 32 + 192) {
        const int task = F.vcu - 32, l = task / 96, n = (task % 96) * 64 + F.lane;
        const float* W = F.in[I_ADAW] + (size_t)l * 1024 * 6144 + n; const float* cc = F.in[I_C];
        LAS float* sc = (LAS float*)(F.lds + RING_OFF + 8192);
        for (int i = F.tid; i < 2048; i += NWAVES * 64) sc[i] = dsilu(cc[i]);
        __syncthreads();
        float o0, o1;
        gemv64(F, [&](int k) { return W[(size_t)k * 6144]; }, [&](int b, int k) { return sc[b * 1024 + k]; }, o0, o1);
        if (F.wave == 0) { const float bb = F.in[I_ADAB][l * 6144 + n]; float* mod = (float*)(F.ws + WS_MOD) + l * 2 * 6144; mod[n] = o0 + bb; mod[6144 + n] = o1 + bb; }
    }
    LAS float* scr = (LAS float*)(F.lds + RING_OFF + 16384 + F.wave * 12288);
    const int gw = (F.vcu - 32) * NWAVES + F.wave, NGW = (F.G - 32) * NWAVES;
    constexpr int I_O = (D / 64) * (D / 32), I_G = (512 / 64) * (512 / 32), I_2 = (FF / 64) * (D / 32);
    constexpr int NITEMS = 2 * I_O + I_G + 2 * I_2;
    for (int it = NGW - 1 - gw; it < NITEMS; it += NGW) {
        int r = it;
        if (r < I_O) { p_transpose_item(F.in[I_EVWOUT], D, D, (bf16*)(F.ws + WS_WOUT0), scr, r, F.lane); continue; } r -= I_O;
        if (r < I_O) { p_transpose_item(F.in[I_ODWOUT], D, D, (bf16*)(F.ws + WS_WOUT1), scr, r, F.lane); continue; } r -= I_O;
        if (r < I_G) { p_transpose_item(F.in[I_WGLU], 512, 512, (bf16*)(F.ws + WS_WGLU), scr, r, F.lane); continue; } r -= I_G;
        if (r < I_2) { p_transpose_item(F.in[I_W2], FF, D, (bf16*)(F.ws + WS_W2_0), scr, r, F.lane); continue; } r -= I_2;
        p_transpose_item(F.in[I_W2] + (size_t)FF * D, FF, D, (bf16*)(F.ws + WS_W2_1), scr, r, F.lane);
    }
    const float* x = F.in[I_X]; bf16* xb = (bf16*)(F.ws + WS_XB); float* rowsq = (float*)(F.ws + WS_ROWSQ);
    for (int m0 = NGW - 1 - gw; m0 < T; m0 += 4 * NGW) {
        f32x4 v[4][4];
#pragma unroll
        for (int q = 0; q < 4; ++q) { const int m = m0 + q * NGW; if (m < T) { const GAS f32x4* xr = (const GAS f32x4*)(x + (size_t)m * D) + F.lane;
#pragma unroll
                for (int j = 0; j < 4; ++j) v[q][j] = xr[64 * j]; } }
#pragma unroll
        for (int q = 0; q < 4; ++q) { const int m = m0 + q * NGW; if (m < T) { float s = 0.f;
#pragma unroll
                for (int j = 0; j < 4; ++j) s += (v[q][j].x * v[q][j].x + v[q][j].y * v[q][j].y) + (v[q][j].z * v[q][j].z + v[q][j].w * v[q][j].w);
                s = wave_sum(s);
                GAS unsigned long long* o8 = (GAS unsigned long long*)(xb + (size_t)m * D) + F.lane;
#pragma unroll
                for (int j = 0; j < 4; ++j) o8[64 * j] = (unsigned long long)pk2(v[q][j].x, v[q][j].y) | ((unsigned long long)pk2(v[q][j].z, v[q][j].w) << 32);
                if (F.lane < 16) rowsq[(size_t)m * 16 + F.lane] = F.lane == 0 ? s : 0.f; } }
    }
}

struct FusedSrc { const float* p; int ld; };
__device__ __forceinline__ FusedSrc fused_src(Frame& F, int mat, int R0) {
    FusedSrc s;
    if (mat == 0) { s.p = F.in[I_EVWIN] + R0; s.ld = N_IN0; }
    else if (mat == 2) { if (R0 < 3072) { s.p = F.in[I_ODWIN] + R0; s.ld = 3072; } else { s.p = (const float*)(F.ws + WS_WA) + (R0 - 3072); s.ld = 512; } }
    else { const int l = mat >> 1, pn = R0 >> 8, half = (R0 >> 7) & 1, i0 = R0 & 127; s.p = (half ? F.in[I_W3] : F.in[I_W1]) + (size_t)l * D * FF + 128 * pn + i0; s.ld = FF; }
    return s;
}
__device__ __forceinline__ void p1_prologue_b(Frame& F) {
    const float* mod = (const float*)(F.ws + WS_MOD);
    for (int task = F.vcu; task < 272; task += F.G) {
        int mat, nb = task; if (nb < 40) mat = 0; else if ((nb -= 40) < 88) mat = 1; else if ((nb -= 88) < 56) mat = 2; else { nb -= 56; mat = 3; }
        const int l = mat >> 1, sh = (mat & 1) ? 3072 : 0, R = nb * 64 + F.lane; const FusedSrc s = fused_src(F, mat, nb * 64);
        LAS float* sc = (LAS float*)(F.lds + RING_OFF + 8192);
        for (int i = F.tid; i < 2048; i += NWAVES * 64) sc[i] = mod[(l * 2 + (i >> 10)) * 6144 + sh + (i & 1023)];
        __syncthreads();
        float o0, o1;
        gemv64(F, [&](int k) { return s.p[(size_t)k * s.ld + F.lane]; }, [&](int b, int k) { return sc[b * 1024 + k]; }, o0, o1);
        if (F.wave == 0) { const int Ns[4] = {N_IN0, N_UP, N_IN1, N_UP}; const int offs[4] = {CV_IN0, CV_UP0, CV_IN1, CV_UP1};
            float* cv = (float*)(F.ws + WS_CV) + offs[mat]; cv[R] = o0; cv[Ns[mat] + R] = o1; }
    }
    LAS float* scr = (LAS float*)(F.lds + RING_OFF + 16384 + F.wave * 12288);
    LAS float* scl = scr + 64 * 33;
    const int gw = F.vcu * NWAVES + F.wave, NGW = F.G * NWAVES;
    constexpr int IT0 = 16 * (N_IN0 / 32), IT1 = 16 * (N_UP / 32), IT2 = 16 * (N_IN1 / 32);
    for (int it = NGW - 1 - gw; it < IT0 + 2 * IT1 + IT2; it += NGW) {
        int mat, r = it; if (r < IT0) mat = 0; else if ((r -= IT0) < IT1) mat = 1; else if ((r -= IT1) < IT2) mat = 2; else { r -= IT2; mat = 3; }
        const int Ns[4] = {N_IN0, N_UP, N_IN1, N_UP}; const size_t wso[4] = {WS_WIN0, WS_W13_0, WS_WIN1, WS_W13_1};
        const int N = Ns[mat], nblk = N / 32, kb = r / nblk, nb = r % nblk, k0 = 64 * kb, R0 = 32 * nb, l = mat >> 1;
        const FusedSrc s = fused_src(F, mat, R0);
        tile_load(s.p + (size_t)k0 * s.ld, s.ld, scr, F.lane);
        { const int k = k0 + F.lane; const float gn = (mat & 1) ? F.in[I_NFG][l * 1024 + k] : F.in[I_NMG][l * 1024 + k]; const int so = (mat & 1) ? 4096 : 1024;
          scl[F.lane] = gn * (1.0f + mod[(l * 2 + 0) * 6144 + so + k]); scl[64 + F.lane] = gn * (1.0f + mod[(l * 2 + 1) * 6144 + so + k]); }
        LDS_WAIT(); asm volatile("" ::: "memory");
        bf16* dst = (bf16*)(F.ws + wso[mat]) + (size_t)R0 * D + k0;
        float sc0[8], sc1[8];
#pragma unroll
        for (int j = 0; j < 8; ++j) { sc0[j] = scl[8 * (F.lane & 7) + j]; sc1[j] = scl[64 + 8 * (F.lane & 7) + j]; }
        const int c = F.lane & 7;
#pragma unroll
        for (int j = 0; j < 4; ++j) { const int n = (F.lane >> 3) + 8 * j; const LAS float* sp = scr + (8 * c) * 33 + n;
            float v[8];
#pragma unroll
            for (int e = 0; e < 8; ++e) v[e] = sp[e * 33];
            v4u o; o.x = pk2(v[0] * sc0[0], v[1] * sc0[1]); o.y = pk2(v[2] * sc0[2], v[3] * sc0[3]); o.z = pk2(v[4] * sc0[4], v[5] * sc0[5]); o.w = pk2(v[6] * sc0[6], v[7] * sc0[7]);
            *(GAS v4u*)(dst + (size_t)n * D + 8 * c) = o;
            o.x = pk2(v[0] * sc1[0], v[1] * sc1[1]); o.y = pk2(v[2] * sc1[2], v[3] * sc1[3]); o.z = pk2(v[4] * sc1[4], v[5] * sc1[5]); o.w = pk2(v[6] * sc1[6], v[7] * sc1[7]);
            *(GAS v4u*)(dst + (size_t)N * D + (size_t)n * D + 8 * c) = o; }
        LDS_WAIT(); asm volatile("" ::: "memory");
    }
}

__device__ __forceinline__ void s5_carry(Frame& F) {
    for (int task = F.vcu; task < 64; task += F.G) {
        const int b = task >> 5, g = task & 31, p = F.tid & 63, seg = F.tid >> 6;
        const float* X = (const float*)(F.ws + WS_XLOC) + ((size_t)g * NCH + b * 512 + seg * 64) * 128 + p;
        const float* L = (const float*)(F.ws + WS_S5LAM) + (g * 64 + p) * 2; const float lr = L[0], li = L[1];
        float ar = 0.f, ai = 0.f;
#pragma unroll 8
        for (int c = 0; c < 64; ++c) { const float xr = X[(size_t)c * 128], xi = X[(size_t)c * 128 + 64]; const float nr = lr * ar - li * ai + xr, ni = lr * ai + li * ar + xi; ar = nr; ai = ni; }
        float sr = lr, si = li;
#pragma unroll
        for (int q = 0; q < 6; ++q) { const float nr = sr * sr - si * si, ni = 2.f * sr * si; sr = nr; si = ni; }
        LAS float* agg = (LAS float*)(F.lds + RING_OFF);
        agg[(seg * 64 + p) * 2] = ar; agg[(seg * 64 + p) * 2 + 1] = ai;
        __syncthreads();
        float cr = 0.f, ci = 0.f;
        for (int s = 0; s < seg; ++s) { const float xr = agg[(s * 64 + p) * 2], xi = agg[(s * 64 + p) * 2 + 1]; const float nr = sr * cr - si * ci + xr, ni = sr * ci + si * cr + xi; cr = nr; ci = ni; }
        bf16* U = (bf16*)(F.ws + WS_UT) + ((size_t)g * NCH + b * 512 + seg * 64) * UTP + 512 + p;
#pragma unroll 8
        for (int c = 0; c < 64; ++c) { U[(size_t)c * UTP] = (bf16)f2bf(cr); U[(size_t)c * UTP + 64] = (bf16)f2bf(ci);
            const float xr = X[(size_t)c * 128], xi = X[(size_t)c * 128 + 64]; const float nr = lr * cr - li * ci + xr, ni = lr * ci + li * cr + xi; cr = nr; ci = ni; }
        __syncthreads();
    }
}

__device__ __forceinline__ void final_norm(Frame& F) {
    const int gw = F.vcu * NWAVES + F.wave, NGW = F.G * NWAVES; const float* gn = F.in[I_FNORM];
    f32x4 gv[4];
#pragma unroll
    for (int j = 0; j < 4; ++j) gv[j] = ((const f32x4*)gn)[F.lane + 64 * j];
    for (int m = gw; m < T; m += NGW) {
        GAS f32x4* xr = (GAS f32x4*)(F.out + (size_t)m * D) + F.lane; f32x4 v[4]; float s = 0.f;
#pragma unroll
        for (int j = 0; j < 4; ++j) { v[j] = xr[64 * j]; s += (v[j].x * v[j].x + v[j].y * v[j].y) + (v[j].z * v[j].z + v[j].w * v[j].w); }
        const float rs = 1.0f / sqrtf(wave_sum(s) * (1.0f / D) + EPS);
#pragma unroll
        for (int j = 0; j < 4; ++j) xr[64 * j] = v[j] * rs * gv[j];
    }
}
namespace gl {
typedef short bf16x8 __attribute__((ext_vector_type(8)));
typedef short bf16x4 __attribute__((ext_vector_type(4)));
typedef float f32x16 __attribute__((ext_vector_type(16)));
constexpr int P136 = 272, P72 = 144;
constexpr int L_QE = 0, L_QI = 17408, L_KI = 34816, L_KLT = 52224, L_VT = 70656, L_P = 107520, L_TOT = 116736, L_DEC = 120832, L_NG = 121344, L_END = 122368;
static_assert(L_END <= RING_BYTES, "mixer LDS map");
__device__ __forceinline__ bf16x8 frag16(LAS unsigned char* lds, int base, int pitch, int row, int col) { return *(const LAS bf16x8*)(lds + base + row * pitch + col * 2); }
__device__ __forceinline__ unsigned pkbf(float lo, float hi) { return pg8::cvt_pk_bf16(lo, hi); }

#define GL_BAR() do { asm volatile("s_waitcnt lgkmcnt(0)" ::: "memory"); __builtin_amdgcn_s_barrier(); asm volatile("" ::: "memory"); } while (0)
template <int DV, bool GLA, bool PASS2> struct MixPF { unsigned qv[8], kv[8], gv[8]; v4u vt[DV * 8 / 512]; };
template <int DV, bool GLA, bool PASS2>
__device__ __forceinline__ void mix_load(MixPF<DV, GLA, PASS2>& P, int t0, int tid, int w, int h, int c0, const unsigned char* wsb, unsigned zr_off, int zp, int qoff, int koff, int goff, unsigned vt_off, int dvt) {
#pragma unroll
    for (int tt = 0; tt < 8; ++tt) { const unsigned o = zr_off + ((unsigned)(t0 + 8 * w + tt) * (unsigned)zp + (unsigned)(h * 128 + c0)) * 2u;
        P.qv[tt] = PASS2 ? *(const unsigned*)(wsb + (size_t)(o + 2u * qoff)) : 0u; P.kv[tt] = *(const unsigned*)(wsb + (size_t)(o + 2u * koff)); P.gv[tt] = GLA ? *(const unsigned*)(wsb + (size_t)(o + 2u * goff)) : 0u; }
#pragma unroll
    for (int i = 0; i < DV * 8 / 512; ++i) { const int idx = tid + 512 * i, v = idx >> 3, jc = idx & 7; P.vt[i] = *(const v4u*)(wsb + (size_t)(vt_off + (((unsigned)(t0 >> 6) * (unsigned)dvt + (unsigned)(h * DV + v)) * 64u + jc * 8u) * 2u)); }
}
template <int DV, bool GLA, bool PASS2>
__device__ __forceinline__ void mix_unit(Frame& F, int bh, int seg, unsigned zr_off, int zp, int qoff, int koff, int goff, int ooff, unsigned vt_off, int dvt,
                                         float* AGG, float* DSEG, unsigned out_off, int ldo, int ocol0, const float* ng, const float* lbl) {
    const unsigned char* wsb = F.ws;
    constexpr int NV = DV / 32, SW0 = (DV == 128) ? 4 : 0, OTP = DV + 4;
    static_assert(64 * OTP * 4 <= L_VT, "O tile overlays QE..KLT");
    LAS unsigned char* lds = F.lds + RING_OFF;
    const int w = F.wave, lane = F.lane, r = lane & 31, hh = lane >> 5, b = bh >> 2, h = bh & 3, tok0 = b * SEQ + seg * 512, c0 = 2 * lane;
    LAS float* TOT = (LAS float*)(lds + L_TOT); LAS float* DEC = (LAS float*)(lds + L_DEC);
    MixPF<DV, GLA, PASS2> nxt;
    mix_load<DV, GLA, PASS2>(nxt, tok0, F.tid, w, h, c0, wsb, zr_off, zp, qoff, koff, goff, vt_off, dvt);
    float lb[2] = {0.f, 0.f};
    if (!GLA) {
#pragma unroll
        for (int e = 0; e < 2; ++e) { const int c = h * 128 + c0 + e; const float l0 = lbl[c], l1 = lbl[512 + c], l2 = lbl[1024 + c], mx = fmaxf(l0, fmaxf(l1, l2)); const float e0 = __expf(l0 - mx), e1 = __expf(l1 - mx), e2 = __expf(l2 - mx); lb[e] = e0 / (e0 + e1 + e2); } }
    f32x16 S[4];
    const size_t aggbase = ((size_t)(bh * 32 + seg) * 128) * DV;
#pragma unroll
    for (int ct = 0; ct < 4; ++ct)
#pragma unroll
        for (int rr = 0; rr < 16; ++rr) S[ct][rr] = 0.f;
    if (PASS2 && w < NV) {
#pragma unroll
        for (int ct = 0; ct < 4; ++ct)
#pragma unroll
            for (int rr = 0; rr < 16; ++rr) S[ct][rr] = AGG[aggbase + (size_t)(32 * ct + (rr & 3) + 8 * (rr >> 2) + 4 * hh) * DV + 32 * w + r];
    }
    float lsum[2] = {0.f, 0.f};
    LAS float* NG = (LAS float*)(lds + L_NG);
    if (PASS2) { if (F.tid < DV) NG[F.tid] = ng[F.tid]; }
#pragma unroll 1
    for (int ch = 0; ch < 8; ++ch) {
        const int t0 = tok0 + ch * 64;
#pragma unroll
        for (int i = 0; i < DV * 8 / 512; ++i) { const int idx = F.tid + 512 * i, v = idx >> 3, jc = idx & 7; *(LAS v4u*)(lds + L_VT + v * P72 + jc * 16) = nxt.vt[i]; }
        float cl[8][2], qq[8][2], kk[8][2]; float run[2] = {0.f, 0.f};
#pragma unroll
        for (int tt = 0; tt < 8; ++tt)
#pragma unroll
            for (int e = 0; e < 2; ++e) {
                const float kf = e ? pg8::bf_hi(nxt.kv[tt]) : pg8::bf_lo(nxt.kv[tt]), qf = e ? pg8::bf_hi(nxt.qv[tt]) : pg8::bf_lo(nxt.qv[tt]); float lg;
                if (GLA) { lg = (e ? pg8::bf_hi(nxt.gv[tt]) : pg8::bf_lo(nxt.gv[tt])) * 0.0625f; kk[tt][e] = kf; qq[tt][e] = qf; }
                else { const float sg = pg8::fsigmoid(kf), fo = lb[e] + (1.f - lb[e]) * sg; lg = __logf(fo); kk[tt][e] = (1.f - lb[e]) * (1.f - sg); qq[tt][e] = pg8::fsilu(qf); }
                run[e] += lg; cl[tt][e] = run[e]; }
        TOT[w * 128 + c0] = run[0]; TOT[w * 128 + c0 + 1] = run[1];
        GL_BAR();
        float off[2] = {0.f, 0.f}, last[2] = {0.f, 0.f}, ref[2] = {0.f, 0.f};
#pragma unroll
        for (int ww = 0; ww < 8; ++ww) { const float t0_ = TOT[ww * 128 + c0], t1_ = TOT[ww * 128 + c0 + 1];
            if (ww < w) { off[0] += t0_; off[1] += t1_; } if (ww < 4) { ref[0] += t0_; ref[1] += t1_; } last[0] += t0_; last[1] += t1_; }
        float klv[2][8];
#pragma unroll
        for (int tt = 0; tt < 8; ++tt) { float qe[2], qi[2], ki[2];
#pragma unroll
            for (int e = 0; e < 2; ++e) { const float cum = off[e] + cl[tt][e]; klv[e][tt] = kk[tt][e] * __expf(last[e] - cum);
                if (PASS2) { qe[e] = qq[tt][e] * __expf(cum); qi[e] = qq[tt][e] * __expf(cum - ref[e]); ki[e] = kk[tt][e] * __expf(ref[e] - cum); } }
            if (PASS2) { const int o = (8 * w + tt) * P136 + c0 * 2;
                *(LAS unsigned*)(lds + L_QE + o) = pkbf(qe[0], qe[1]); *(LAS unsigned*)(lds + L_QI + o) = pkbf(qi[0], qi[1]); *(LAS unsigned*)(lds + L_KI + o) = pkbf(ki[0], ki[1]); } }
#pragma unroll
        for (int e = 0; e < 2; ++e) { v4u o; o.x = pkbf(klv[e][0], klv[e][1]); o.y = pkbf(klv[e][2], klv[e][3]); o.z = pkbf(klv[e][4], klv[e][5]); o.w = pkbf(klv[e][6], klv[e][7]);
            *(LAS v4u*)(lds + L_KLT + (c0 + e) * P72 + 16 * w) = o; }
        if (w == 0) { DEC[c0] = __expf(last[0]); DEC[c0 + 1] = __expf(last[1]); lsum[0] += last[0]; lsum[1] += last[1]; }
        GL_BAR();
        if (ch + 1 < 8) mix_load<DV, GLA, PASS2>(nxt, t0 + 64, F.tid, w, h, c0, wsb, zr_off, zp, qoff, koff, goff, vt_off, dvt);
        v4u og[DV / 64];
        if (PASS2) {
#pragma unroll
            for (int q = 0; q < DV / 64; ++q) og[q] = *(const v4u*)(wsb + (size_t)(zr_off + ((unsigned)(t0 + (F.tid >> 3)) * (unsigned)zp + (unsigned)(ooff + h * DV + (F.tid & 7) * 8 + 64 * q)) * 2u)); }
        f32x16 O[2];
        if (PASS2) {
            if (w >= SW0 && w < SW0 + 3) {
                const int ti = w - SW0, jt = ti >> 1, it = (ti + 1) >> 1;
                f32x16 X;
#pragma unroll
                for (int rr = 0; rr < 16; ++rr) X[rr] = 0.f;
#pragma unroll
                for (int s = 0; s < 8; ++s) X = __builtin_amdgcn_mfma_f32_32x32x16_bf16(frag16(lds, L_KI, P136, 32 * jt + r, 16 * s + 8 * hh), frag16(lds, L_QI, P136, 32 * it + r, 16 * s + 8 * hh), X, 0, 0, 0);
#pragma unroll
                for (int g = 0; g < 4; ++g) { float x[4];
#pragma unroll
                    for (int e = 0; e < 4; ++e) { const int j = 32 * jt + 8 * g + 4 * hh + e, i = 32 * it + r; x[e] = (j <= i) ? X[4 * g + e] : 0.f; }
                    v2u o; o.x = pkbf(x[0], x[1]); o.y = pkbf(x[2], x[3]);
                    *(LAS v2u*)(lds + L_P + (32 * it + r) * P72 + (32 * jt + 8 * g + 4 * hh) * 2) = o; }
            }
            if (w < NV) {
#pragma unroll
                for (int it = 0; it < 2; ++it)
#pragma unroll
                    for (int rr = 0; rr < 16; ++rr) O[it][rr] = 0.f;
#pragma unroll
                for (int ct = 0; ct < 4; ++ct)
#pragma unroll
                    for (int s = 0; s < 2; ++s) {
                        union { bf16x8 v; unsigned u[4]; } Bs;
#pragma unroll
                        for (int p = 0; p < 4; ++p) Bs.u[p] = pkbf(S[ct][8 * s + 2 * p], S[ct][8 * s + 2 * p + 1]);
#pragma unroll
                        for (int it = 0; it < 2; ++it) { union { bf16x8 v; bf16x4 hlf[2]; } A; const int o = L_QE + (32 * it + r) * P136 + (32 * ct + 16 * s + 4 * hh) * 2;
                            A.hlf[0] = *(const LAS bf16x4*)(lds + o); A.hlf[1] = *(const LAS bf16x4*)(lds + o + 16);
                            O[it] = __builtin_amdgcn_mfma_f32_32x32x16_bf16(A.v, Bs.v, O[it], 0, 0, 0); } }
            }
            GL_BAR();
        }
        if (w < NV) {
            if (PASS2) {
#pragma unroll
                for (int it = 0; it < 2; ++it)
#pragma unroll
                    for (int jt = 0; jt <= it; ++jt)
#pragma unroll
                        for (int s = 0; s < 2; ++s)
                            O[it] = __builtin_amdgcn_mfma_f32_32x32x16_bf16(frag16(lds, L_P, P72, 32 * it + r, 32 * jt + 16 * s + 8 * hh), frag16(lds, L_VT, P72, 32 * w + r, 32 * jt + 16 * s + 8 * hh), O[it], 0, 0, 0);
            }
#pragma unroll
            for (int ct = 0; ct < 4; ++ct) {
#pragma unroll
                for (int g = 0; g < 4; ++g) { const f32x4 d4 = *(const LAS f32x4*)(DEC + 32 * ct + 8 * g + 4 * hh);
#pragma unroll
                    for (int e = 0; e < 4; ++e) S[ct][4 * g + e] *= d4[e]; }
#pragma unroll
                for (int sj = 0; sj < 4; ++sj)
                    S[ct] = __builtin_amdgcn_mfma_f32_32x32x16_bf16(frag16(lds, L_KLT, P72, 32 * ct + r, 16 * sj + 8 * hh), frag16(lds, L_VT, P72, 32 * w + r, 16 * sj + 8 * hh), S[ct], 0, 0, 0);
            }
        }
        GL_BAR();
        if (PASS2) {
            LAS float* OT = (LAS float*)lds;
            if (w < NV) {
#pragma unroll
                for (int it = 0; it < 2; ++it)
#pragma unroll
                    for (int rr = 0; rr < 16; ++rr) OT[(32 * it + (rr & 3) + 8 * (rr >> 2) + 4 * hh) * OTP + 32 * w + r] = O[it][rr];
            }
            GL_BAR();
            const int i = F.tid >> 3, sub = F.tid & 7; float ov[DV / 64][8]; float ss = 0.f;
#pragma unroll
            for (int q = 0; q < DV / 64; ++q) { const f32x4 a = *(const LAS f32x4*)(OT + i * OTP + sub * 8 + 64 * q), bq = *(const LAS f32x4*)(OT + i * OTP + sub * 8 + 64 * q + 4);
#pragma unroll
                for (int e = 0; e < 4; ++e) { ov[q][e] = a[e]; ov[q][4 + e] = bq[e]; ss += a[e] * a[e] + bq[e] * bq[e]; } }
            ss += __shfl_xor(ss, 1); ss += __shfl_xor(ss, 2); ss += __shfl_xor(ss, 4);
            const float rs = 1.0f / sqrtf(ss * (1.0f / DV) + EPS);
#pragma unroll
            for (int q = 0; q < DV / 64; ++q) { const int col = sub * 8 + 64 * q; const v4u gw = og[q];
                const float g8[8] = {pg8::bf_lo(gw.x), pg8::bf_hi(gw.x), pg8::bf_lo(gw.y), pg8::bf_hi(gw.y), pg8::bf_lo(gw.z), pg8::bf_hi(gw.z), pg8::bf_lo(gw.w), pg8::bf_hi(gw.w)};
                const f32x4 n0 = *(const LAS f32x4*)(NG + col), n1 = *(const LAS f32x4*)(NG + col + 4);
                float y[8];
#pragma unroll
                for (int e = 0; e < 8; ++e) y[e] = ov[q][e] * rs * (e < 4 ? n0[e] : n1[e - 4]) * pg8::fsilu(g8[e]);
                v4u o; o.x = pkbf(y[0], y[1]); o.y = pkbf(y[2], y[3]); o.z = pkbf(y[4], y[5]); o.w = pkbf(y[6], y[7]);
                *(v4u*)(F.ws + (size_t)(out_off + ((unsigned)(t0 + i) * (unsigned)ldo + (unsigned)(ocol0 + h * DV + col)) * 2u)) = o; }
        }
    }
    if (!PASS2) {
        if (w < NV) {
#pragma unroll
            for (int ct = 0; ct < 4; ++ct)
#pragma unroll
                for (int rr = 0; rr < 16; ++rr) AGG[aggbase + (size_t)(32 * ct + (rr & 3) + 8 * (rr >> 2) + 4 * hh) * DV + 32 * w + r] = S[ct][rr];
        }
        if (w == 0) { DSEG[(bh * 32 + seg) * 128 + c0] = __expf(lsum[0]); DSEG[(bh * 32 + seg) * 128 + c0 + 1] = __expf(lsum[1]); }
    }
}
template <int DV> __device__ __forceinline__ void mix_carry(Frame& F, float* AGG, const float* DSEG) {
    constexpr int PER = 128 * DV;
    for (int idx = F.vcu * (NWAVES * 64) + F.tid; idx < 8 * PER; idx += F.G * NWAVES * 64) {
        const int bh = idx / PER, rem = idx % PER, c = rem / DV; float a[32], d[32];
#pragma unroll
        for (int s = 0; s < 32; ++s) { a[s] = AGG[(size_t)(bh * 32 + s) * PER + rem]; d[s] = DSEG[(bh * 32 + s) * 128 + c]; }
        float cur = 0.f;
#pragma unroll
        for (int s = 0; s < 32; ++s) { AGG[(size_t)(bh * 32 + s) * PER + rem] = cur; cur = d[s] * cur + a[s]; }
    }
}
}
constexpr int N_PHASES = 18;
__global__ void __launch_bounds__(NWAVES * 64, 2) mk_fwd(Args args) {
    extern __shared__ __attribute__((aligned(16))) unsigned char lds[];
    Frame F;
    F.lds = (LAS unsigned char*)lds;
    F.MISC = (volatile LAS unsigned*)(F.lds + MISC_OFF);
    F.tid = threadIdx.x; F.lane = F.tid & 63; F.wave = __builtin_amdgcn_readfirstlane(F.tid >> 6);
    F.G = gridDim.x; { const int bx = blockIdx.x; F.vcu = (F.G % 8 == 0) ? (bx % 8) * (F.G / 8) + bx / 8 : bx; }
    F.in = args.in; F.out = args.out; F.ws = args.ws;
    F.ctl = (gu32*)(args.ws + WS_CTL);
    for (int u = F.tid; u < (LDS_BYTES - LDSCTL_OFF) / 4; u += NWAVES * 64) ((LAS unsigned*)(F.lds + LDSCTL_OFF))[u] = 0u;
    __syncthreads();
    const int lo = args.ph_lo, hi = args.ph_hi;
    XcdBarrier bar; bar.bar = (unsigned*)(F.ctl + CW_BAR); bar.x = 0; bar.st = nullptr;
    if (hi - lo > 1) bar = xcd_barrier_post((unsigned*)(F.ctl + CW_BAR), F.MISC + 8);
#define IN(k) (lo <= (k) && (k) < hi)
#define SEAM(k) do { if (IN(k) && IN((k) + 1)) xcd_barrier(bar); } while (0)
    unsigned char* ws = args.ws;
    float* rowsq = (float*)(ws + WS_ROWSQ); bf16* xb = (bf16*)(ws + WS_XB); const float* mod = (const float*)(ws + WS_MOD); const float* cv = (const float*)(ws + WS_CV);
    const int bid = (int)blockIdx.x;

    if (IN(0)) { p0_prologue_a(F); } SEAM(0);
    if (IN(1)) { p1_prologue_b(F); } SEAM(1);
    if (IN(2)) {
        pg8::Gemm g{xb, (const bf16*)(ws + WS_WIN0), D, D, D}; pg8::StaticOrder S; S.init(T, N_IN0, F.G, bid, 64, (size_t)N_IN0 * D * 2);
        pg8::EpiIn0 E{rowsq, cv + CV_IN0, (bf16*)(ws + WS_UT), (bf16*)(ws + WS_QFG), (bf16*)(ws + WS_VT0)};
        pg8::gemm_phase<pg8::EpiIn0, pg8::StaticOrder, true>(F.lds + RING_OFF, g, S, E);
    } SEAM(2);
    if (IN(3)) {
        { const int un = F.vcu; if (un < 256)
            gl::mix_unit<128, false, false>(F, un >> 5, un & 31, (unsigned)WS_QFG, 1536, 0, 512, 0, 1024, (unsigned)WS_VT0, 512, (float*)(ws + WS_HGA), (float*)(ws + WS_HGD), 0u, 0, 0, nullptr, F.in[I_LBLOG]); }
        __syncthreads();
        pg8::Gemm g{(const bf16*)(ws + WS_UT), (const bf16*)(ws + WS_S5F), UTP, 512, 512}; pg8::GroupOrder S; S.init(4, 1, S5G, F.G, F.vcu, (size_t)NCH * UTP * 2, (size_t)256 * 512 * 2);
        pg8::EpiS5X E{(float*)(ws + WS_XLOC)};
        pg8::gemm_phase<pg8::EpiS5X, pg8::GroupOrder, true>(F.lds + RING_OFF, g, S, E);
    } SEAM(3);
    if (IN(4)) { s5_carry(F); gl::mix_carry<128>(F, (float*)(ws + WS_HGA), (const float*)(ws + WS_HGD)); } SEAM(4);
    if (IN(5)) {
        { const int un = F.vcu; if (un < 256)
            gl::mix_unit<128, false, true>(F, un >> 5, un & 31, (unsigned)WS_QFG, 1536, 0, 512, 0, 1024, (unsigned)WS_VT0, 512, (float*)(ws + WS_HGA), (float*)(ws + WS_HGD), (unsigned)WS_MIXED, D, 512, F.in[I_HGNORM], F.in[I_LBLOG]); }
        __syncthreads();
        pg8::Gemm g{(const bf16*)(ws + WS_UT), (const bf16*)(ws + WS_S5T), UTP, UTP, UTP}; pg8::GroupOrder S; S.init(4, 2, S5G, F.G, F.vcu, (size_t)NCH * UTP * 2, (size_t)512 * UTP * 2);
        pg8::EpiS5Y E{(bf16*)(ws + WS_YGELU)};
        pg8::gemm_phase<pg8::EpiS5Y, pg8::GroupOrder, true>(F.lds + RING_OFF, g, S, E);
    } SEAM(5);
    if (IN(6)) {
        pg8::Gemm g{(const bf16*)(ws + WS_YGELU), (const bf16*)(ws + WS_WGLU), 512, 512, 512}; pg8::StaticOrder S; S.init(T, 512, F.G, bid, 64, 0);
        pg8::EpiGlu E{(const bf16*)(ws + WS_YGELU), F.in[I_BGLU], (bf16*)(ws + WS_MIXED), D};
        pg8::gemm_phase<pg8::EpiGlu, pg8::StaticOrder, true>(F.lds + RING_OFF, g, S, E);
    } SEAM(6);
    if (IN(7)) {
        pg8::Gemm g{(const bf16*)(ws + WS_MIXED), (const bf16*)(ws + WS_WOUT0), D, D, D}; pg8::StaticOrder S; S.init(T, D, F.G, bid, 64, 0);
        pg8::EpiResid E{F.in[I_X], F.out, xb, rowsq, mod + 2048, 6144};
        pg8::gemm_phase<pg8::EpiResid, pg8::StaticOrder, true>(F.lds + RING_OFF, g, S, E);
    } SEAM(7);
    if (IN(8)) {
        pg8::Gemm g{xb, (const bf16*)(ws + WS_W13_0), D, D, D}; pg8::StaticOrder S; S.init(T, N_UP, F.G, bid, 64, (size_t)N_UP * D * 2);
        pg8::EpiFfnUp E{rowsq, cv + CV_UP0, (bf16*)(ws + WS_HID)};
        pg8::gemm_phase<pg8::EpiFfnUp, pg8::StaticOrder, true>(F.lds + RING_OFF, g, S, E);
    } SEAM(8);
    if (IN(9)) {
        pg8::Gemm g{(const bf16*)(ws + WS_HID), (const bf16*)(ws + WS_W2_0), FF, FF, FF}; pg8::StaticOrder S; S.init(T, D, F.G, bid, 64, 0);
        pg8::EpiResid E{F.out, F.out, xb, rowsq, mod + 5120, 6144};
        pg8::gemm_phase<pg8::EpiResid, pg8::StaticOrder, true>(F.lds + RING_OFF, g, S, E);
    } SEAM(9);
    if (IN(10)) {
        pg8::Gemm g{xb, (const bf16*)(ws + WS_WIN1), D, D, D}; pg8::StaticOrder S; S.init(T, N_IN1, F.G, bid, 64, (size_t)N_IN1 * D * 2);
        pg8::EpiIn1 E{rowsq, cv + CV_IN1, F.in[I_ODBA], (bf16*)(ws + WS_Z1), (bf16*)(ws + WS_VT1)};
        pg8::gemm_phase<pg8::EpiIn1, pg8::StaticOrder, true>(F.lds + RING_OFF, g, S, E);
    } SEAM(10);
    if (IN(11)) {
        { const int un = F.vcu; if (un < 256)
            gl::mix_unit<256, true, false>(F, un >> 5, un & 31, (unsigned)WS_Z1, 2560, 0, 512, 2048, 1024, (unsigned)WS_VT1, 1024, (float*)(ws + WS_GLA_A), (float*)(ws + WS_GLA_D), 0u, 0, 0, nullptr, nullptr); }
    } SEAM(11);
    if (IN(12)) { gl::mix_carry<256>(F, (float*)(ws + WS_GLA_A), (const float*)(ws + WS_GLA_D)); } SEAM(12);
    if (IN(13)) {
        { const int un = F.vcu; if (un < 256)
            gl::mix_unit<256, true, true>(F, un >> 5, un & 31, (unsigned)WS_Z1, 2560, 0, 512, 2048, 1024, (unsigned)WS_VT1, 1024, (float*)(ws + WS_GLA_A), (float*)(ws + WS_GLA_D), (unsigned)WS_MIXED2, D, 0, F.in[I_GLANORM], nullptr); }
    } SEAM(13);
    if (IN(14)) {
        pg8::Gemm g{(const bf16*)(ws + WS_MIXED2), (const bf16*)(ws + WS_WOUT1), D, D, D}; pg8::StaticOrder S; S.init(T, D, F.G, bid, 64, 0);
        pg8::EpiResid E{F.out, F.out, xb, rowsq, mod + 2 * 6144 + 2048, 6144};
        pg8::gemm_phase<pg8::EpiResid, pg8::StaticOrder, true>(F.lds + RING_OFF, g, S, E);
    } SEAM(14);
    if (IN(15)) {
        pg8::Gemm g{xb, (const bf16*)(ws + WS_W13_1), D, D, D}; pg8::StaticOrder S; S.init(T, N_UP, F.G, bid, 64, (size_t)N_UP * D * 2);
        pg8::EpiFfnUp E{rowsq, cv + CV_UP1, (bf16*)(ws + WS_HID)};
        pg8::gemm_phase<pg8::EpiFfnUp, pg8::StaticOrder, true>(F.lds + RING_OFF, g, S, E);
    } SEAM(15);
    if (IN(16)) {
        pg8::Gemm g{(const bf16*)(ws + WS_HID), (const bf16*)(ws + WS_W2_1), FF, FF, FF}; pg8::StaticOrder S; S.init(T, D, F.G, bid, 64, 0);
        pg8::EpiResid E{F.out, F.out, xb, rowsq, mod + 2 * 6144 + 5120, 6144};
        pg8::gemm_phase<pg8::EpiResid, pg8::StaticOrder, true>(F.lds + RING_OFF, g, S, E);
    } SEAM(16);
    if (IN(17)) { final_norm(F); }
#undef IN
#undef SEAM
}


extern "C" void kernel_launch(void* const* d_in, const int* in_sizes, int n_in, void* d_out, int out_size, void* d_ws, size_t ws_size, hipStream_t stream) {
    static int grid = 0;
    if (grid == 0) {
        if (n_in != 30 || in_sizes[0] != T * D || out_size != T * D || ws_size < WS_END) { fprintf(stderr, "kernel_launch: unexpected shapes: n_in %d in0 %d out %d ws %zu (need %zu)\n", n_in, n_in > 0 ? in_sizes[0] : -1, out_size, ws_size, (size_t)WS_END); grid = -1; return; }
        int dev = 0, cus = 0, per_cu = 0;
        if (hipGetDevice(&dev) != hipSuccess || hipDeviceGetAttribute(&cus, hipDeviceAttributeMultiprocessorCount, dev) != hipSuccess) { fprintf(stderr, "kernel_launch: device query failed\n"); grid = -1; return; }
        if (hipFuncSetAttribute((const void*)mk_fwd, hipFuncAttributeMaxDynamicSharedMemorySize, LDS_BYTES) != hipSuccess) { fprintf(stderr, "kernel_launch: hipFuncSetAttribute failed\n"); grid = -1; return; }
        if (hipOccupancyMaxActiveBlocksPerMultiprocessor(&per_cu, (const void*)mk_fwd, NWAVES * 64, LDS_BYTES) != hipSuccess || per_cu < 1) { fprintf(stderr, "kernel_launch: occupancy query reports %d workgroups per CU; nothing launched\n", per_cu); (void)hipGetLastError(); grid = -1; return; }
        if (cus < 256) { fprintf(stderr, "kernel_launch: this kernel needs 256 CUs (found %d); nothing launched\n", cus); grid = -1; return; }
        grid = 256;
    }
    if (grid < 0) return;
    (void)hipMemsetAsync((char*)d_ws + WS_CTL, 0, CTL_ZERO_BYTES, stream);
    Args a{};
    for (int i = 0; i < 30; ++i) a.in[i] = (const float*)d_in[i];
    a.out = (float*)d_out; a.ws = (unsigned char*)d_ws;
#ifdef PROBE_RANGES
    static const int ranges[][2] = PROBE_RANGES;
    for (unsigned i = 0; i < sizeof(ranges) / sizeof(ranges[0]); ++i) { if (i) (void)hipMemsetAsync((char*)d_ws + WS_CTL, 0, CTL_ZERO_BYTES, stream);
        a.ph_lo = ranges[i][0]; a.ph_hi = ranges[i][1]; hipLaunchKernelGGL(mk_fwd, dim3(grid), dim3(NWAVES * 64), LDS_BYTES, stream, a); }
#else
    a.ph_lo = 0; a.ph_hi = N_PHASES;
    hipLaunchKernelGGL(mk_fwd, dim3(grid), dim3(NWAVES * 64), LDS_BYTES, stream, a);
#endif
}
```

```cpp
#ifndef PROBE_EPI2_FFNUP
#define PROBE_EPI2_FFNUP false
#endif
#include <hip/hip_runtime.h>
#include <cstdio>
#include <cstdint>
#include <cmath>
namespace pg8 {
#define PG8_LAS __attribute__((address_space(3)))
typedef unsigned short bf16_t;
typedef short bf16x8 __attribute__((ext_vector_type(8)));
typedef float f32x4 __attribute__((ext_vector_type(4)));
typedef unsigned u32x4 __attribute__((ext_vector_type(4)));
typedef unsigned u32x2 __attribute__((ext_vector_type(2)));
constexpr int BM = 256, BK = 64, HALF = 128, HTB = HALF * BK * 2  , STAGE_BYTES = 8 * HTB, NXCD = 8, WGM = 8;

__host__ __device__ __forceinline__ int lds_byte(int r, int c) { const int st = (r >> 4) * 2 + (c >> 5), rr = r & 15, cc = c & 31, ob = rr * 64 + cc * 2; return st * 1024 + (ob ^ (((ob >> 9) & 1) << 5)); }
__host__ __device__ __forceinline__ void stage_rc(int b, int& R, int& C) { const int st = b / 1024, sb = b % 1024, swz = sb ^ (((sb >> 9) & 1) << 5); R = (st >> 1) * 16 + swz / 64; C = (st & 1) * 32 + (swz % 64) / 2; }
__host__ __device__ __forceinline__ int perm32(int rho) { const int n = rho >> 4, i = rho & 15; return 8 * (i >> 2) + 4 * n + (i & 3); }

struct Unit { int pm, pn, g; size_t aoff, boff; };
struct Gemm { const bf16_t* A; const bf16_t* Bt; int lda, ldb, K; };

struct StaticOrder {
    int nM, nN, nwg, G, c, pm_per_batch; size_t bstride;
    __device__ void init(int M, int N, int G_, int c_, int pmpb, size_t bs) { nM = M / BM; nN = N / BM; nwg = nM * nN; G = G_; c = c_; pm_per_batch = pmpb; bstride = bs; }
    __device__ bool next(int i, Unit& u) const {
        const long L = (long)i * G + c; if (L >= nwg) return false;
        int wgid = (int)L; { const int q = nwg / NXCD, r = nwg % NXCD, xcd = wgid % NXCD, off = wgid / NXCD; wgid = (xcd < r ? xcd * (q + 1) : r * (q + 1) + (xcd - r) * q) + off; }
        const int nig = WGM * nN, gid = wgid / nig, fm = gid * WGM, gsz = (nM - fm) < WGM ? (nM - fm) : WGM;
        u.pm = fm + ((wgid % nig) % gsz); u.pn = (wgid % nig) / gsz; u.g = u.pm / pm_per_batch; u.aoff = 0; u.boff = (size_t)u.g * bstride; return true;
    }
};
struct GroupOrder {
    int nM, nN, ngroups, G, c; size_t astride, bstride;
    __device__ void init(int nM_, int nN_, int ng, int G_, int c_, size_t as, size_t bs) { nM = nM_; nN = nN_; ngroups = ng; G = G_; c = c_; astride = as; bstride = bs; }
    __device__ bool next(int i, Unit& u) const {
        const long L = (long)i * G + c; if (L >= (long)ngroups * nM * nN) return false;
        const int g = (int)(L / (nM * nN)), r = (int)(L % (nM * nN)); u.g = g; u.pm = r / nN; u.pn = r % nN; u.aoff = (size_t)g * astride; u.boff = (size_t)g * bstride; return true;
    }
};

__device__ __forceinline__ unsigned cvt_pk_bf16(float lo, float hi) { unsigned r; asm volatile("v_cvt_pk_bf16_f32 %0, %1, %2" : "=v"(r) : "v"(lo), "v"(hi)); return r; }
__device__ __forceinline__ float xsum16(float s) { const unsigned u = __builtin_bit_cast(unsigned, s); const auto r = __builtin_amdgcn_permlane16_swap(u, u, false, false); return __builtin_bit_cast(float, (unsigned)r[0]) + __builtin_bit_cast(float, (unsigned)r[1]); }
__device__ __forceinline__ float xsum32(float s) { const unsigned u = __builtin_bit_cast(unsigned, s); const auto r = __builtin_amdgcn_permlane32_swap(u, u, false, false); return __builtin_bit_cast(float, (unsigned)r[0]) + __builtin_bit_cast(float, (unsigned)r[1]); }
template <int CTRL> __device__ __forceinline__ float dppf(float v) { return __builtin_bit_cast(float, __builtin_amdgcn_update_dpp(0, __builtin_bit_cast(int, v), CTRL, 0xf, 0xf, true)); }
__device__ __forceinline__ float sum8(float s) { s += dppf<0xB1>(s); s += dppf<0x4E>(s); s += dppf<0x141>(s); return s; }
__device__ __forceinline__ float sum64(float s) { s = sum8(s); s += dppf<0x140>(s); s = xsum16(s); return xsum32(s); }
__device__ __forceinline__ float bf_lo(unsigned w) { return __uint_as_float(w << 16); }
__device__ __forceinline__ float bf_hi(unsigned w) { return __uint_as_float(w & 0xffff0000u); }
__device__ __forceinline__ float fsigmoid(float x) { return __builtin_amdgcn_rcpf(1.0f + __expf(-x)); }
__device__ __forceinline__ float fsilu(float x) { return x * fsigmoid(x); }
__device__ __forceinline__ float fgelu_tanh(float y) { return y * fsigmoid(1.5957691216f * (y + 0.044715f * y * y * y)); }
__device__ __forceinline__ float flogsigmoid(float x) { return fminf(x, 0.f) - __logf(1.0f + __expf(-fabsf(x))); }
__device__ __forceinline__ float row_rstd(const float* rowsq, int row) {
    const f32x4* p = (const f32x4*)(rowsq + (size_t)row * 16); const f32x4 a = p[0], b = p[1], c = p[2], d = p[3];
    const float s = ((a[0] + a[1]) + (a[2] + a[3])) + ((b[0] + b[1]) + (b[2] + b[3])) + ((c[0] + c[1]) + (c[2] + c[3])) + ((d[0] + d[1]) + (d[2] + d[3]));
    return 1.0f / sqrtf(s * (1.0f / 1024.0f) + 1e-6f);
}

__device__ __forceinline__ void rowstats8(const float* rowsq, int row0  , int fq, float (&rs)[2][4]) {
    f32x4 p[2][4];
#pragma unroll
    for (int ai = 0; ai < 2; ++ai)
#pragma unroll
        for (int m = 0; m < 4; ++m) p[ai][m] = *(const f32x4*)(rowsq + (size_t)(row0 + ai * HALF + m * 16) * 16 + 4 * fq);
#pragma unroll
    for (int ai = 0; ai < 2; ++ai)
#pragma unroll
        for (int m = 0; m < 4; ++m) { float s = (p[ai][m][0] + p[ai][m][1]) + (p[ai][m][2] + p[ai][m][3]); s = xsum32(xsum16(s)); rs[ai][m] = 1.0f / sqrtf(s * (1.0f / 1024.0f) + 1e-6f); }
}


struct EpiIn0 {
    static constexpr bool PERM = true, AFTER_DRAIN = false, PROBE2 = false;
    const float* rowsq; const float* cvec; bf16_t* Ut; bf16_t* QFG; bf16_t* VT;
    __device__ __forceinline__ void operator()(const f32x4 (&acc)[2][2][4][2], const Unit& u, int wr, int wc, int fr, int fq) const {
        f32x4 cv[2][2];
#pragma unroll
        for (int bj = 0; bj < 2; ++bj)
#pragma unroll
            for (int n = 0; n < 2; ++n) cv[bj][n] = *(const f32x4*)(cvec + u.g * 2560 + u.pn * BM + bj * HALF + wc * 32 + 8 * fq + 4 * n);
float rs8[2][4]; rowstats8(rowsq, u.pm * BM + wr * 64 + fr, fq, rs8);
#pragma unroll
        for (int ai = 0; ai < 2; ++ai)
#pragma unroll
        for (int m = 0; m < 4; ++m) { const int row = u.pm * BM + ai * HALF + wr * 64 + m * 16 + fr;
            const float rs = rs8[ai][m];
#pragma unroll
            for (int bj = 0; bj < 2; ++bj) { const int c0 = u.pn * BM + bj * HALF + wc * 32 + 8 * fq;
                const f32x4 v0 = acc[ai][bj][m][0] * rs + cv[bj][0], v1 = acc[ai][bj][m][1] * rs + cv[bj][1];
                u32x4 w; w.x = cvt_pk_bf16(v0[0], v0[1]); w.y = cvt_pk_bf16(v0[2], v0[3]); w.z = cvt_pk_bf16(v1[0], v1[1]); w.w = cvt_pk_bf16(v1[2], v1[3]);
                if (u.pn == 6 || u.pn == 7) { bf16_t* d = VT + ((size_t)(row >> 6) * 512 + (c0 - 1536)) * 64 + (row & 63);
                    d[0] = (bf16_t)w.x; d[64] = (bf16_t)(w.x >> 16); d[128] = (bf16_t)w.y; d[192] = (bf16_t)(w.y >> 16); d[256] = (bf16_t)w.z; d[320] = (bf16_t)(w.z >> 16); d[384] = (bf16_t)w.w; d[448] = (bf16_t)(w.w >> 16); }
                else { bf16_t* dst = (u.pn < 2) ? Ut + ((size_t)((c0 >> 4) * 1024 + (row >> 5)) * 640 + (row & 31) * 16 + (c0 & 15)) : QFG + (size_t)row * 1536 + (u.pn < 6 ? c0 - 512 : c0 - 1024);
                    *(u32x4*)dst = w; } }
        }
    }
};
struct EpiS5X {
    static constexpr bool PERM = false, AFTER_DRAIN = false, PROBE2 = false;
    float* Xloc;
    __device__ __forceinline__ void operator()(const f32x4 (&acc)[2][2][4][2], const Unit& u, int wr, int wc, int fr, int fq) const {
#pragma unroll
        for (int ai = 0; ai < 2; ++ai)
#pragma unroll
        for (int m = 0; m < 4; ++m) { const int row = u.pm * BM + ai * HALF + wr * 64 + m * 16 + fr;
#pragma unroll
            for (int n = 0; n < 2; ++n) *(f32x4*)(Xloc + ((size_t)u.g * 1024 + row) * 128 + wc * 32 + 16 * n + 4 * fq) = acc[ai][0][m][n];
        }
    }
};
struct EpiS5Y {
    static constexpr bool PERM = true, AFTER_DRAIN = false, PROBE2 = false;
    bf16_t* Y;
    __device__ __forceinline__ void operator()(const f32x4 (&acc)[2][2][4][2], const Unit& u, int wr, int wc, int fr, int fq) const {
#pragma unroll
        for (int ai = 0; ai < 2; ++ai)
#pragma unroll
        for (int m = 0; m < 4; ++m) { const int row = u.pm * BM + ai * HALF + wr * 64 + m * 16 + fr;
#pragma unroll
            for (int bj = 0; bj < 2; ++bj) { const int c0 = u.pn * BM + bj * HALF + wc * 32 + 8 * fq;
                const f32x4 a0 = acc[ai][bj][m][0], a1 = acc[ai][bj][m][1];
                u32x4 w; w.x = cvt_pk_bf16(fgelu_tanh(a0[0]), fgelu_tanh(a0[1])); w.y = cvt_pk_bf16(fgelu_tanh(a0[2]), fgelu_tanh(a0[3]));
                w.z = cvt_pk_bf16(fgelu_tanh(a1[0]), fgelu_tanh(a1[1])); w.w = cvt_pk_bf16(fgelu_tanh(a1[2]), fgelu_tanh(a1[3]));
                *(u32x4*)(Y + ((size_t)row * 32 + (c0 >> 4)) * 512 + u.g * 16 + (c0 & 15)) = w; }
        }
    }
};
struct EpiGlu {
    static constexpr bool PERM = true, AFTER_DRAIN = false, PROBE2 = false;
    const bf16_t* Y; const float* bias; bf16_t* O; int ldo;
    __device__ __forceinline__ void operator()(const f32x4 (&acc)[2][2][4][2], const Unit& u, int wr, int wc, int fr, int fq) const {
        f32x4 bv[2][2];
#pragma unroll
        for (int bj = 0; bj < 2; ++bj)
#pragma unroll
            for (int n = 0; n < 2; ++n) bv[bj][n] = *(const f32x4*)(bias + u.pn * BM + bj * HALF + wc * 32 + 8 * fq + 4 * n);
#pragma unroll
        for (int ai = 0; ai < 2; ++ai)
#pragma unroll
        for (int m = 0; m < 4; ++m) { const int row = u.pm * BM + ai * HALF + wr * 64 + m * 16 + fr;
#pragma unroll
            for (int bj = 0; bj < 2; ++bj) { const int c0 = u.pn * BM + bj * HALF + wc * 32 + 8 * fq;
                const u32x4 yw = *(const u32x4*)(Y + (size_t)row * 512 + c0);
                const f32x4 a0 = acc[ai][bj][m][0] + bv[bj][0], a1 = acc[ai][bj][m][1] + bv[bj][1];
                u32x4 w; w.x = cvt_pk_bf16(bf_lo(yw.x) * fsigmoid(a0[0]), bf_hi(yw.x) * fsigmoid(a0[1])); w.y = cvt_pk_bf16(bf_lo(yw.y) * fsigmoid(a0[2]), bf_hi(yw.y) * fsigmoid(a0[3]));
                w.z = cvt_pk_bf16(bf_lo(yw.z) * fsigmoid(a1[0]), bf_hi(yw.z) * fsigmoid(a1[1])); w.w = cvt_pk_bf16(bf_lo(yw.w) * fsigmoid(a1[2]), bf_hi(yw.w) * fsigmoid(a1[3]));
                *(u32x4*)(O + (size_t)row * ldo + c0) = w; }
        }
    }
};
struct EpiResid {
    static constexpr bool PERM = true, AFTER_DRAIN = false, PROBE2 = false;
    const float* xold; float* xnew; bf16_t* xb; float* rowsq; const float* gate; int gstride;
    __device__ __forceinline__ void operator()(const f32x4 (&acc)[2][2][4][2], const Unit& u, int wr, int wc, int fr, int fq) const {
        f32x4 gv[2][2];
#pragma unroll
        for (int bj = 0; bj < 2; ++bj)
#pragma unroll
            for (int n = 0; n < 2; ++n) gv[bj][n] = *(const f32x4*)(gate + u.g * gstride + u.pn * BM + bj * HALF + wc * 32 + 8 * fq + 4 * n);
#pragma unroll
        for (int ai = 0; ai < 2; ++ai)
#pragma unroll
        for (int m = 0; m < 4; ++m) { const int row = u.pm * BM + ai * HALF + wr * 64 + m * 16 + fr;
            float sq = 0.f;
#pragma unroll
            for (int bj = 0; bj < 2; ++bj) { const size_t off = (size_t)row * 1024 + u.pn * BM + bj * HALF + wc * 32 + 8 * fq;
                const f32x4 x0 = *(const f32x4*)(xold + off), x1 = *(const f32x4*)(xold + off + 4);
                const f32x4 v0 = x0 + gv[bj][0] * acc[ai][bj][m][0], v1 = x1 + gv[bj][1] * acc[ai][bj][m][1];
                *(f32x4*)(xnew + off) = v0; *(f32x4*)(xnew + off + 4) = v1;
                sq += (v0[0] * v0[0] + v0[1] * v0[1]) + (v0[2] * v0[2] + v0[3] * v0[3]) + (v1[0] * v1[0] + v1[1] * v1[1]) + (v1[2] * v1[2] + v1[3] * v1[3]);
                u32x4 w; w.x = cvt_pk_bf16(v0[0], v0[1]); w.y = cvt_pk_bf16(v0[2], v0[3]); w.z = cvt_pk_bf16(v1[0], v1[1]); w.w = cvt_pk_bf16(v1[2], v1[3]);
                *(u32x4*)(xb + off) = w; }
            sq = xsum32(xsum16(sq));
            if (fq == 0) rowsq[(size_t)row * 16 + u.pn * 4 + wc] = sq;
        }
    }
};
struct EpiFfnUp {
    static constexpr bool PERM = true, AFTER_DRAIN = false, PROBE2 = PROBE_EPI2_FFNUP;
    const float* rowsq; const float* cvec; bf16_t* H;
    __device__ __forceinline__ void operator()(const f32x4 (&acc)[2][2][4][2], const Unit& u, int wr, int wc, int fr, int fq) const {
        f32x4 cv[2][2];
#pragma unroll
        for (int bj = 0; bj < 2; ++bj)
#pragma unroll
            for (int n = 0; n < 2; ++n) cv[bj][n] = *(const f32x4*)(cvec + u.g * 5632 + u.pn * BM + bj * HALF + wc * 32 + 8 * fq + 4 * n);
float rs8[2][4]; rowstats8(rowsq, u.pm * BM + wr * 64 + fr, fq, rs8);
#pragma unroll
        for (int ai = 0; ai < 2; ++ai)
#pragma unroll
        for (int m = 0; m < 4; ++m) { const int row = u.pm * BM + ai * HALF + wr * 64 + m * 16 + fr;
            const float rs = rs8[ai][m];
            const f32x4 a0 = acc[ai][0][m][0] * rs + cv[0][0], a1 = acc[ai][0][m][1] * rs + cv[0][1], b0 = acc[ai][1][m][0] * rs + cv[1][0], b1 = acc[ai][1][m][1] * rs + cv[1][1];
            u32x4 w; w.x = cvt_pk_bf16(fsilu(a0[0]) * b0[0], fsilu(a0[1]) * b0[1]); w.y = cvt_pk_bf16(fsilu(a0[2]) * b0[2], fsilu(a0[3]) * b0[3]);
            w.z = cvt_pk_bf16(fsilu(a1[0]) * b1[0], fsilu(a1[1]) * b1[1]); w.w = cvt_pk_bf16(fsilu(a1[2]) * b1[2], fsilu(a1[3]) * b1[3]);
            *(u32x4*)(H + (size_t)row * 2816 + u.pn * HALF + wc * 32 + 8 * fq) = w;
        }
    }
};
struct EpiIn1 {
    static constexpr bool PERM = true, AFTER_DRAIN = false, PROBE2 = false;
    const float* rowsq; const float* cvec; const float* ba; bf16_t* Z; bf16_t* VT;
    __device__ __forceinline__ void operator()(const f32x4 (&acc)[2][2][4][2], const Unit& u, int wr, int wc, int fr, int fq) const {
        f32x4 cv[2][2];
#pragma unroll
        for (int bj = 0; bj < 2; ++bj)
#pragma unroll
            for (int n = 0; n < 2; ++n) { const int c = u.pn * BM + bj * HALF + wc * 32 + 8 * fq + 4 * n; cv[bj][n] = *(const f32x4*)(cvec + u.g * 3584 + c); if (u.pn >= 12) cv[bj][n] += *(const f32x4*)(ba + c - 3072); }
float rs8[2][4]; rowstats8(rowsq, u.pm * BM + wr * 64 + fr, fq, rs8);
#pragma unroll
        for (int ai = 0; ai < 2; ++ai)
#pragma unroll
        for (int m = 0; m < 4; ++m) { const int row = u.pm * BM + ai * HALF + wr * 64 + m * 16 + fr;
            const float rs = rs8[ai][m];
#pragma unroll
            for (int bj = 0; bj < 2; ++bj) { const int c0 = u.pn * BM + bj * HALF + wc * 32 + 8 * fq;
                f32x4 v0 = acc[ai][bj][m][0] * rs + cv[bj][0], v1 = acc[ai][bj][m][1] * rs + cv[bj][1];
                if (u.pn < 2) { v0 = v0 * 0.08838834764831845f; v1 = v1 * 0.08838834764831845f; }
                if (u.pn >= 12) {
#pragma unroll
                    for (int e = 0; e < 4; ++e) { v0[e] = flogsigmoid(v0[e]); v1[e] = flogsigmoid(v1[e]); } }
                u32x4 w; w.x = cvt_pk_bf16(v0[0], v0[1]); w.y = cvt_pk_bf16(v0[2], v0[3]); w.z = cvt_pk_bf16(v1[0], v1[1]); w.w = cvt_pk_bf16(v1[2], v1[3]);
                if (u.pn >= 4 && u.pn < 8) { bf16_t* d = VT + ((size_t)(row >> 6) * 1024 + (c0 - 1024)) * 64 + (row & 63);
                    d[0] = (bf16_t)w.x; d[64] = (bf16_t)(w.x >> 16); d[128] = (bf16_t)w.y; d[192] = (bf16_t)(w.y >> 16); d[256] = (bf16_t)w.z; d[320] = (bf16_t)(w.z >> 16); d[384] = (bf16_t)w.w; d[448] = (bf16_t)(w.w >> 16); }
                else *(u32x4*)(Z + (size_t)row * 2560 + (u.pn < 4 ? c0 : c0 - 1024)) = w; }
        }
    }
};

template <class Epi, class Sched, bool ALIGN_EPI>
__device__ __forceinline__ void gemm_phase(PG8_LAS unsigned char* lds, const Gemm g, const Sched& S, const Epi& E) {
    const int tid = threadIdx.x, wid = __builtin_amdgcn_readfirstlane(tid >> 6), lane = tid & 63, wr = wid >> 2, wc = wid & 3, fr = lane & 15, fq = lane >> 4;
    const int K = g.K, nt = K / BK;
    unsigned voffA[2], voffB[2];
#pragma unroll
    for (int i = 0; i < 2; ++i) { int R, C; stage_rc(tid * 16 + i * 8192, R, C); const int Rb = Epi::PERM ? ((R & ~31) + perm32(R & 31)) : R;
        voffA[i] = (unsigned)(R * g.lda + C) * 2u; voffB[i] = (unsigned)(Rb * g.ldb + C) * 2u; }
    const size_t kstep = (size_t)(BK * 2);
    const size_t hstepA = (size_t)HALF * g.lda * 2, hstepB = (size_t)HALF * g.ldb * 2;
    const unsigned ldsw = (unsigned)wid * 1024u;
    const int aoff = lds_byte(wr * 64 + fr, fq * 8), boff = lds_byte(wc * 32 + fr, fq * 8);
#define PG8_SA(b, h) (((b) * 2 + (h)) * HTB)
#define PG8_SB(b, h) ((4 + (b) * 2 + (h)) * HTB)
#define PG8_STAGE(bufoff, gbase, voff) do { _Pragma("unroll") for (int _i = 0; _i < 2; ++_i) \
        __builtin_amdgcn_global_load_lds((const unsigned*)((const char*)(gbase) + (voff)[_i]), (PG8_LAS unsigned*)(lds + (bufoff) + ldsw + _i * 8192), 16, 0, 0); } while (0)
#define PG8_LDA(dst, b, h) do { _Pragma("unroll") for (int m = 0; m < 4; ++m) _Pragma("unroll") for (int k = 0; k < 2; ++k) dst[m][k] = *(const PG8_LAS bf16x8*)(lds + PG8_SA(b, h) + aoff + m * 2048 + k * 1024); } while (0)
#define PG8_LDB(dst, b, h) do { _Pragma("unroll") for (int n = 0; n < 2; ++n) _Pragma("unroll") for (int k = 0; k < 2; ++k) dst[n][k] = *(const PG8_LAS bf16x8*)(lds + PG8_SB(b, h) + boff + n * 2048 + k * 1024); } while (0)
#define PG8_MMA(ai, bj, At, Bt) do { __builtin_amdgcn_s_setprio(1); _Pragma("unroll") for (int m = 0; m < 4; ++m) _Pragma("unroll") for (int n = 0; n < 2; ++n) _Pragma("unroll") for (int k = 0; k < 2; ++k) \
        acc[ai][bj][m][n] = __builtin_amdgcn_mfma_f32_16x16x32_bf16(Bt[n][k], At[m][k], acc[ai][bj][m][n], 0, 0, 0); __builtin_amdgcn_s_setprio(0); } while (0)
#define PG8_WAIT_V(n) asm volatile("s_waitcnt vmcnt(" #n ")" ::: "memory")
#define PG8_WAIT_L(n) asm volatile("s_waitcnt lgkmcnt(" #n ")" ::: "memory")
#define PG8_BAR __builtin_amdgcn_s_barrier()
#define PG8_SCHED __builtin_amdgcn_sched_barrier(0)
    Unit cur, nxt; int ui = 0;
    if (!S.next(0, cur)) return;
    f32x4 acc[2][2][4][2];
#pragma unroll
    for (int a = 0; a < 2; ++a)
#pragma unroll
        for (int b = 0; b < 2; ++b)
#pragma unroll
            for (int m = 0; m < 4; ++m)
#pragma unroll
                for (int n = 0; n < 2; ++n) acc[a][b][m][n] = (f32x4){0.f, 0.f, 0.f, 0.f};
    bf16x8 At[4][2], B0[2][2], B1[2][2];
    const char* cA = (const char*)g.A + cur.aoff + (size_t)cur.pm * 2 * hstepA; const char* cB = (const char*)g.Bt + cur.boff + (size_t)cur.pn * 2 * hstepB;
    PG8_STAGE(PG8_SB(0, 0), cB, voffB); PG8_STAGE(PG8_SB(0, 1), cB + hstepB, voffB); PG8_STAGE(PG8_SA(0, 0), cA, voffA); PG8_STAGE(PG8_SA(0, 1), cA + hstepA, voffA);
    if (wr == 1) PG8_BAR;
    PG8_WAIT_V(2); PG8_BAR;
    PG8_STAGE(PG8_SB(1, 0), cB + kstep, voffB); PG8_STAGE(PG8_SA(1, 0), cA + kstep, voffA); PG8_STAGE(PG8_SB(1, 1), cB + hstepB + kstep, voffB);
    PG8_WAIT_V(6); PG8_BAR;
    for (;;) {
        const bool has_next = S.next(ui + 1, nxt);
        const char* nA = has_next ? (const char*)g.A + nxt.aoff + (size_t)nxt.pm * 2 * hstepA : cA; const char* nB = has_next ? (const char*)g.Bt + nxt.boff + (size_t)nxt.pn * 2 * hstepB : cB;
        for (int t = 0; t < nt; t += 2) {
            const bool last = (t == nt - 2);
            const char* a1 = cA + (size_t)(t + 1) * kstep;
            const char* a2 = last ? nA : cA + (size_t)(t + 2) * kstep; const char* b2 = last ? nB : cB + (size_t)(t + 2) * kstep;
            const char* a3 = a2 + kstep; const char* b3 = b2 + kstep;
            PG8_LDB(B0, 0, 0); PG8_LDB(B1, 0, 1); PG8_SCHED; PG8_LDA(At, 0, 0); PG8_STAGE(PG8_SA(1, 1), a1 + hstepA, voffA);
            PG8_WAIT_V(8); PG8_WAIT_L(0); PG8_BAR; PG8_MMA(0, 0, At, B0); PG8_MMA(0, 1, At, B1); PG8_BAR; PG8_SCHED;
            PG8_LDA(At, 0, 1); PG8_STAGE(PG8_SB(0, 0), b2, voffB); PG8_STAGE(PG8_SB(0, 1), b2 + hstepB, voffB); PG8_STAGE(PG8_SA(0, 0), a2, voffA);
            PG8_WAIT_V(8); PG8_WAIT_L(0); PG8_BAR; PG8_MMA(1, 0, At, B0); PG8_MMA(1, 1, At, B1); PG8_BAR; PG8_SCHED;
            PG8_LDB(B0, 1, 0); PG8_LDB(B1, 1, 1); PG8_SCHED; PG8_LDA(At, 1, 0); PG8_STAGE(PG8_SA(0, 1), a2 + hstepA, voffA);
            PG8_WAIT_V(8); PG8_WAIT_L(0); PG8_BAR; PG8_MMA(0, 0, At, B0); PG8_MMA(0, 1, At, B1); PG8_BAR; PG8_SCHED;
            PG8_LDA(At, 1, 1); PG8_STAGE(PG8_SB(1, 0), b3, voffB); PG8_STAGE(PG8_SB(1, 1), b3 + hstepB, voffB); PG8_STAGE(PG8_SA(1, 0), a3, voffA);
            PG8_WAIT_V(8); PG8_WAIT_L(0); PG8_BAR; PG8_MMA(1, 0, At, B0); PG8_MMA(1, 1, At, B1); PG8_BAR; PG8_SCHED;
        }
        if constexpr (ALIGN_EPI) { if (wr == 0) PG8_BAR; }
        E(acc, cur, wr, wc, fr, fq);
        if constexpr (Epi::PROBE2) { asm volatile("" ::: "memory"); E(acc, cur, wr, wc, fr, fq); }
        if (!has_next) break;
#pragma unroll
        for (int a = 0; a < 2; ++a)
#pragma unroll
            for (int b = 0; b < 2; ++b)
#pragma unroll
                for (int m = 0; m < 4; ++m)
#pragma unroll
                    for (int n = 0; n < 2; ++n) acc[a][b][m][n] = (f32x4){0.f, 0.f, 0.f, 0.f};
        cur = nxt; cA = nA; cB = nB; ++ui;
        if constexpr (ALIGN_EPI) { if (wr == 1) PG8_BAR; }
    }
    PG8_WAIT_V(0);
    if constexpr (!ALIGN_EPI) { if (wr == 0) PG8_BAR; }
    PG8_BAR;
#undef PG8_SA
#undef PG8_SB
#undef PG8_STAGE
#undef PG8_LDA
#undef PG8_LDB
#undef PG8_MMA
#undef PG8_WAIT_V
#undef PG8_WAIT_L
#undef PG8_BAR
#undef PG8_SCHED
}
}
constexpr int NWAVES = 8;
constexpr int BATCH = 2, SEQ = 16384, D = 1024, T = BATCH * SEQ;
constexpr int FF = 2816, S5W = 512, S5G = 32, S5P = 64, LC = 32, NCH = T / LC  , UTP = LC * 16 + 128  ;
constexpr int N_IN0 = 2560, N_IN1 = 3584, N_UP = 5632;
constexpr float EPS = 1e-6f;
constexpr size_t MiB = 1u << 20;
constexpr size_t WS_CTL = 0, CTL_ZERO_BYTES = 1 * MiB;
constexpr size_t WS_MOD = 1 * MiB;
constexpr size_t WS_CV = 1 * MiB + 128 * 1024;
constexpr int CV_IN0 = 0, CV_UP0 = 2 * N_IN0, CV_IN1 = CV_UP0 + 2 * N_UP, CV_UP1 = CV_IN1 + 2 * N_IN1;
constexpr size_t WS_S5LAM = 1 * MiB + 512 * 1024;
constexpr size_t WS_WIN0 = 2 * MiB, WS_WOUT0 = 12 * MiB, WS_WGLU = 14 * MiB, WS_S5F = 15 * MiB, WS_S5T = 23 * MiB, WS_W13_0 = 43 * MiB, WS_W2_0 = 65 * MiB,
                 WS_WIN1 = 71 * MiB, WS_WOUT1 = 85 * MiB, WS_W13_1 = 87 * MiB, WS_W2_1 = 109 * MiB;
constexpr size_t WS_ROWSQ = 115 * MiB, WS_XB = 117 * MiB, WS_POOL = 181 * MiB, WS_END = 512 * MiB;
constexpr size_t WS_UT = WS_POOL, WS_QFG = 221 * MiB, WS_VT0 = 317 * MiB, WS_XLOC = 349 * MiB, WS_YGELU = 365 * MiB, WS_MIXED = 397 * MiB, WS_HGA = 461 * MiB, WS_HGD = 477 * MiB;
constexpr size_t WS_WA = 349 * MiB;
constexpr size_t WS_HID = WS_POOL;
constexpr size_t WS_Z1 = WS_POOL, WS_VT1 = 341 * MiB, WS_MIXED2 = 405 * MiB, WS_GLA_A = 469 * MiB, WS_GLA_D = 501 * MiB;
static_assert(WS_WIN0 + (size_t)2 * N_IN0 * D * 2 <= WS_WOUT0 && WS_S5F + (size_t)S5G * 256 * 512 * 2 <= WS_S5T && WS_S5T + (size_t)S5G * 512 * UTP * 2 <= WS_W13_0 && WS_W13_0 + (size_t)2 * N_UP * D * 2 <= WS_W2_0 &&
              WS_W2_0 + (size_t)D * FF * 2 <= WS_WIN1 && WS_WIN1 + (size_t)2 * N_IN1 * D * 2 <= WS_WOUT1 && WS_W13_1 + (size_t)2 * N_UP * D * 2 <= WS_W2_1 && WS_W2_1 + (size_t)D * FF * 2 <= WS_ROWSQ, "weights map");
static_assert(WS_UT + (size_t)S5G * NCH * UTP * 2 <= WS_QFG && WS_QFG + (size_t)T * 1536 * 2 <= WS_VT0 && WS_VT0 + (size_t)T * 512 * 2 <= WS_XLOC && WS_XLOC + (size_t)S5G * NCH * 128 * 4 <= WS_YGELU && WS_YGELU + (size_t)T * 512 * 2 <= WS_MIXED &&
              WS_MIXED + (size_t)T * D * 2 <= WS_HGA && WS_HGA + (size_t)8 * 32 * 128 * 128 * 4 <= WS_HGD && WS_HID + (size_t)T * FF * 2 <= WS_END && WS_Z1 + (size_t)T * 2560 * 2 <= WS_VT1 && WS_VT1 + (size_t)T * D * 2 <= WS_MIXED2 &&
              WS_MIXED2 + (size_t)T * D * 2 <= WS_GLA_A && WS_GLA_A + (size_t)8 * 32 * 128 * 256 * 4 <= WS_GLA_D && WS_GLA_D + 8 * 32 * 128 * 4 <= WS_END, "pool map");
constexpr int CW_BAR = 4096;

constexpr int RING_OFF = 0, RING_BYTES = 131072;
constexpr int LDSCTL_OFF = RING_BYTES, MISC_OFF = LDSCTL_OFF + 320;
constexpr int LDS_BYTES = 147456;
static_assert(MISC_OFF + 128 <= LDS_BYTES, "LDS map");

#define GAS __attribute__((address_space(1)))
#define LAS __attribute__((address_space(3)))
typedef unsigned short bf16;
typedef unsigned v4u __attribute__((ext_vector_type(4)));
typedef unsigned v2u __attribute__((ext_vector_type(2)));
typedef float f32x4 __attribute__((ext_vector_type(4)));
typedef GAS unsigned gu32;
#define RLX_AGENT __ATOMIC_RELAXED, __HIP_MEMORY_SCOPE_AGENT
#define LDS_WAIT() asm volatile("s_waitcnt lgkmcnt(0)" ::: "memory")
#define VM_WAIT() asm volatile("s_waitcnt vmcnt(0)" ::: "memory")
__device__ __forceinline__ unsigned f2bf(float f) { unsigned u = __builtin_bit_cast(unsigned, f); return (u + 0x7fffu + ((u >> 16) & 1u)) >> 16; }
__device__ __forceinline__ unsigned pk2(float lo, float hi) { return f2bf(lo) | (f2bf(hi) << 16); }
__device__ __forceinline__ float bf2f(bf16 v) { return __uint_as_float((unsigned)v << 16); }

#define XB_TMO      128
#define XB_XCNT(j)  (256  + 64 * (j))
#define XB_XSUB(j)  (1280 + 64 * (j))
#define XB_XGEN(j)  (2304 + 64 * (j))
#define XB_TOP      3328
#define XB_TOPGEN   3392
#define XCD_BAR_WORDS 3456
#define XB_SPIN_CAP (1u << 18)
__device__ __forceinline__ unsigned xb_ld(unsigned* p)              { return __hip_atomic_load(p, __ATOMIC_RELAXED, __HIP_MEMORY_SCOPE_AGENT); }
__device__ __forceinline__ unsigned xb_add(unsigned* p, unsigned v) { return __hip_atomic_fetch_add(p, v, __ATOMIC_RELAXED, __HIP_MEMORY_SCOPE_AGENT); }
__device__ __forceinline__ unsigned xb_xcc_id() { return (unsigned)__builtin_amdgcn_s_getreg((3 << 11) | 20) & 0xFu; }
#define XB_SPIN(cond, bar) do { unsigned _sp = 0; while (cond) { __builtin_amdgcn_s_sleep(1); \
    if ((++_sp & 255u) == 0u) { if (xb_ld(&(bar)[XB_TMO])) break; if (_sp > XB_SPIN_CAP) { atomicAdd(&(bar)[XB_TMO], 1u); break; } } } } while (0)
struct XcdBarrier { unsigned* bar; unsigned x; volatile LAS unsigned* st; };
__device__ __forceinline__ XcdBarrier xcd_barrier_post(unsigned* bar, volatile LAS unsigned* st) {
    XcdBarrier b; b.bar = bar; b.x = xb_xcc_id(); b.st = st;
    if (threadIdx.x == 0) (void)xb_add(&bar[XB_XCNT(b.x)], 1u);
    return b;
}
__device__ __forceinline__ void xcd_barrier_complete(unsigned* bar, unsigned x, unsigned& nloc, unsigned& nx) {
    const unsigned G = gridDim.x * gridDim.y * gridDim.z;
    unsigned sum, cnt, mine, sp = 0u;
    for (;;) {
        sum = 0u; cnt = 0u; mine = 0u;
#pragma unroll
        for (unsigned j = 0; j < 16; ++j) { const unsigned c = xb_ld(&bar[XB_XCNT(j)]); sum += c; cnt += (c > 0u) ? 1u : 0u; mine = (j == x) ? c : mine; }
        if (sum == G) break;
        __builtin_amdgcn_s_sleep(1);
        if ((++sp & 255u) == 0u) { if (xb_ld(&bar[XB_TMO])) break; if (sp > XB_SPIN_CAP) { atomicAdd(&bar[XB_TMO], 1u); break; } }
    }
    nloc = mine > 0u ? mine : 1u; nx = cnt > 0u ? cnt : 1u;
}
__device__ __forceinline__ void xcd_barrier(const XcdBarrier& b) {
    asm volatile("s_waitcnt vmcnt(0)" ::: "memory");
    __syncthreads();
    if (threadIdx.x == 0) {
        unsigned* bar = b.bar;
        __builtin_amdgcn_s_waitcnt(0);
        unsigned nloc = b.st[0], nx = b.st[1];
        if (nloc == 0u) { xcd_barrier_complete(bar, b.x, nloc, nx); b.st[0] = nloc; b.st[1] = nx; }
        const unsigned old = xb_add(&bar[XB_XSUB(b.x)], 1u);
        const unsigned gen = old / nloc;
        if (old + 1u == (gen + 1u) * nloc) {
            __builtin_amdgcn_fence(__ATOMIC_RELEASE, "agent");
            asm volatile("s_waitcnt vmcnt(0)" ::: "memory");
            const unsigned og = xb_add(&bar[XB_TOP], 1u);
            const unsigned tg = og / nx;
            if (og + 1u == (tg + 1u) * nx) xb_add(&bar[XB_TOPGEN], 1u);
            else XB_SPIN(xb_ld(&bar[XB_TOPGEN]) == tg, bar);
            __builtin_amdgcn_fence(__ATOMIC_ACQUIRE, "agent");
            xb_add(&bar[XB_XGEN(b.x)], 1u);
            asm volatile("s_waitcnt vmcnt(0)" ::: "memory");
        } else {
            XB_SPIN(xb_ld(&bar[XB_XGEN(b.x)]) == gen, bar);
            __builtin_amdgcn_fence(__ATOMIC_ACQUIRE, "agent");
            asm volatile("s_waitcnt vmcnt(0)" ::: "memory");
        }
    }
    __syncthreads();
}

struct Args { const float* in[30]; float* out; unsigned char* ws; int ph_lo, ph_hi; };
enum InIdx { I_X = 0, I_C, I_ADAW, I_ADAB, I_NMG, I_NFG, I_EVWIN, I_EVWOUT, I_LAMRE, I_LAMIM, I_BRE, I_BIM, I_CRE, I_CIM, I_S5D, I_LOGSTEP, I_WGLU, I_BGLU, I_LBLOG, I_HGNORM,
             I_ODWIN, I_ODWA1, I_ODWA2, I_ODBA, I_GLANORM, I_ODWOUT, I_W1, I_W3, I_W2, I_FNORM };
struct Frame {
    LAS unsigned char* lds;
    volatile LAS unsigned* MISC;
    gu32* ctl;
    int tid, lane, wave, vcu, G;
    const float* const* in; float* out; unsigned char* ws;
};
__device__ __forceinline__ float wave_sum(float v) { return pg8::sum64(v); }
__device__ __forceinline__ float dsilu(float x) { return x / (1.0f + expf(-x)); }

__device__ __forceinline__ void tile_store(const LAS float* scr, bf16* dst  , int ldk, const float* sc  , int lane) {
    const int c = lane & 7;
    float s8[8];
#pragma unroll
    for (int j = 0; j < 8; ++j) s8[j] = sc ? sc[8 * c + j] : 1.0f;
#pragma unroll
    for (int j = 0; j < 4; ++j) { const int n = (lane >> 3) + 8 * j; const LAS float* s = scr + (8 * c) * 33 + n;
        v4u o; o.x = pk2(s[0 * 33] * s8[0], s[1 * 33] * s8[1]); o.y = pk2(s[2 * 33] * s8[2], s[3 * 33] * s8[3]); o.z = pk2(s[4 * 33] * s8[4], s[5 * 33] * s8[5]); o.w = pk2(s[6 * 33] * s8[6], s[7 * 33] * s8[7]);
        *(GAS v4u*)(dst + (size_t)n * ldk + 8 * c) = o; }
}
__device__ __forceinline__ void tile_load(const float* W  , int ldw, LAS float* scr, int lane) {
    const int nn = (lane & 7) * 4, kr = lane >> 3; f32x4 v[8];
#pragma unroll
    for (int i = 0; i < 8; ++i) v[i] = *(const GAS f32x4*)(W + (size_t)(kr + 8 * i) * ldw + nn);
#pragma unroll
    for (int i = 0; i < 8; ++i) { LAS float* d = scr + (kr + 8 * i) * 33 + nn; d[0] = v[i].x; d[1] = v[i].y; d[2] = v[i].z; d[3] = v[i].w; }
}
__device__ __forceinline__ void p_transpose_item(const float* W, int K, int N, bf16* WT, LAS float* scr, int item, int lane) {
    const int nblk = N / 32, kb = item / nblk, nb = item % nblk, k0 = 64 * kb, n0 = 32 * nb;
    tile_load(W + (size_t)k0 * N + n0, N, scr, lane);
    LDS_WAIT(); asm volatile("" ::: "memory");
    tile_store(scr, WT + (size_t)n0 * K + k0, K, nullptr, lane);
    LDS_WAIT(); asm volatile("" ::: "memory");
}

__device__ __forceinline__ void s5_constants(Frame& F, int g) {
    LAS float* PW = (LAS float*)(F.lds + RING_OFF);
    LAS float* BB = (LAS float*)(F.lds + RING_OFF + 17408);
    LAS float* CC = (LAS float*)(F.lds + RING_OFF + 25600);
    LAS float* KD = (LAS float*)(F.lds + RING_OFF + 33792);
    LAS float* QQ = (LAS float*)(F.lds + RING_OFF + 66560);
    const float* lam_re = F.in[I_LAMRE] + g * 64; const float* lam_im = F.in[I_LAMIM] + g * 64;
    const float* b_re = F.in[I_BRE] + g * 1024; const float* b_im = F.in[I_BIM] + g * 1024;
    const float* c_re = F.in[I_CRE] + g * 1024; const float* c_im = F.in[I_CIM] + g * 1024;
    if (F.tid < 64) { const int p = F.tid; const double dl = exp((double)F.in[I_LOGSTEP][g]);
        const double lr = lam_re[p], li = lam_im[p]; const double mag = exp(lr * dl); double sn, cs; sincos(li * dl, &sn, &cs);
        const double ar = mag * cs, ai = mag * sn;
        const double nr = ar - 1.0, ni = ai, den = lr * lr + li * li;
        QQ[p * 2] = (float)((nr * lr + ni * li) / den); QQ[p * 2 + 1] = (float)((ni * lr - nr * li) / den);
        double pr = 1.0, pi = 0.0;
        for (int d = 0; d <= LC; ++d) { PW[(d * 64 + p) * 2] = (float)pr; PW[(d * 64 + p) * 2 + 1] = (float)pi; const double tr = pr * ar - pi * ai, ti = pr * ai + pi * ar; pr = tr; pi = ti; } }
    for (int idx = F.tid; idx < 1024; idx += NWAVES * 64) { CC[idx * 2] = c_re[idx]; CC[idx * 2 + 1] = c_im[idx]; }
    __syncthreads();
    for (int idx = F.tid; idx < 1024; idx += NWAVES * 64) { const int p = idx >> 4; const float qr = QQ[p * 2], qi = QQ[p * 2 + 1], br = b_re[idx], bi = b_im[idx];
        BB[idx * 2] = qr * br - qi * bi; BB[idx * 2 + 1] = qr * bi + qi * br; }
    __syncthreads();
    { const int d = F.tid >> 4, ho0 = ((F.tid >> 2) & 3) * 4, hi0 = (F.tid & 3) * 4; float acc[4][4];
#pragma unroll
      for (int a = 0; a < 4; ++a)
#pragma unroll
          for (int q = 0; q < 4; ++q) acc[a][q] = 0.f;
      for (int p = 0; p < 64; ++p) { const float pr = PW[(d * 64 + p) * 2], pi = PW[(d * 64 + p) * 2 + 1]; float xr[4], xi[4];
#pragma unroll
          for (int a = 0; a < 4; ++a) { const float cr = CC[((ho0 + a) * 64 + p) * 2], ci = CC[((ho0 + a) * 64 + p) * 2 + 1]; xr[a] = cr * pr - ci * pi; xi[a] = cr * pi + ci * pr; }
          const f32x4 b0 = *(const LAS f32x4*)(BB + (p * 16 + hi0) * 2), b1 = *(const LAS f32x4*)(BB + (p * 16 + hi0) * 2 + 4);
          const float br[4] = {b0[0], b0[2], b1[0], b1[2]}, bi[4] = {b0[1], b0[3], b1[1], b1[3]};
#pragma unroll
          for (int a = 0; a < 4; ++a)
#pragma unroll
              for (int q = 0; q < 4; ++q) acc[a][q] += xr[a] * br[q] - xi[a] * bi[q]; }
#pragma unroll
      for (int a = 0; a < 4; ++a)
#pragma unroll
          for (int q = 0; q < 4; ++q) { float v = acc[a][q]; if (d == 0 && ho0 + a == hi0 + q) v += F.in[I_S5D][g * 16 + ho0 + a]; KD[(d * 16 + ho0 + a) * 16 + hi0 + q] = v; } }
    __syncthreads();
    bf16* Tg = (bf16*)(F.ws + WS_S5T) + (size_t)g * 512 * UTP;
    for (int idx = F.tid; idx < 512 * 64; idx += NWAVES * 64) { const int n = idx >> 6, kc = idx & 63, l = n >> 4, ho = n & 15, j = kc >> 1, hi0 = (kc & 1) * 8;
        v4u o = (v4u){0u, 0u, 0u, 0u};
        if (j <= l) { const LAS float* k = KD + ((l - j) * 16 + ho) * 16 + hi0; o.x = pk2(k[0], k[1]); o.y = pk2(k[2], k[3]); o.z = pk2(k[4], k[5]); o.w = pk2(k[6], k[7]); }
        *(GAS v4u*)(Tg + (size_t)n * UTP + kc * 8) = o; }
    for (int idx = F.tid; idx < 512 * 16; idx += NWAVES * 64) { const int n = idx >> 4, pc = idx & 15, l = n >> 4, ho = n & 15, im = pc >> 3, p0 = (pc & 7) * 8; float v[8];
#pragma unroll
        for (int e = 0; e < 8; ++e) { const int p = p0 + e; const float cr = CC[(ho * 64 + p) * 2], ci = CC[(ho * 64 + p) * 2 + 1], pr = PW[((l + 1) * 64 + p) * 2], pi = PW[((l + 1) * 64 + p) * 2 + 1];
            v[e] = im ? -(cr * pi + ci * pr) : (cr * pr - ci * pi); }
        v4u o; o.x = pk2(v[0], v[1]); o.y = pk2(v[2], v[3]); o.z = pk2(v[4], v[5]); o.w = pk2(v[6], v[7]);
        *(GAS v4u*)(Tg + (size_t)n * UTP + 512 + pc * 8) = o; }
    bf16* Fg = (bf16*)(F.ws + WS_S5F) + (size_t)g * 256 * 512;
    for (int idx = F.tid; idx < 256 * 64; idx += NWAVES * 64) { const int r = idx >> 6, kc = idx & 63, j = kc >> 1, hi0 = (kc & 1) * 8;
        v4u o = (v4u){0u, 0u, 0u, 0u};
        if (r < 128) { const int p = r & 63, im = r >> 6; const float pr = PW[((LC - 1 - j) * 64 + p) * 2], pi = PW[((LC - 1 - j) * 64 + p) * 2 + 1]; float v[8];
#pragma unroll
            for (int e = 0; e < 8; ++e) { const float br = BB[(p * 16 + hi0 + e) * 2], bi = BB[(p * 16 + hi0 + e) * 2 + 1]; v[e] = im ? (pr * bi + pi * br) : (pr * br - pi * bi); }
            o.x = pk2(v[0], v[1]); o.y = pk2(v[2], v[3]); o.z = pk2(v[4], v[5]); o.w = pk2(v[6], v[7]); }
        *(GAS v4u*)(Fg + (size_t)r * 512 + kc * 8) = o; }
    if (F.tid < 64) { float* L = (float*)(F.ws + WS_S5LAM) + (g * 64 + F.tid) * 2; L[0] = PW[(LC * 64 + F.tid) * 2]; L[1] = PW[(LC * 64 + F.tid) * 2 + 1]; }
    __syncthreads();
}
template <class WF, class VF> __device__ __forceinline__ void gemv64(Frame& F, WF wf, VF vf, float& o0, float& o1) {
    LAS float* red = (LAS float*)(F.lds + RING_OFF);
    float a0 = 0.f, a1 = 0.f; const int kb = F.wave * 128;
#pragma unroll 16
    for (int k = 0; k < 128; ++k) { const float w = wf(kb + k); a0 += vf(0, kb + k) * w; a1 += vf(1, kb + k) * w; }
    red[(F.wave * 2 + 0) * 64 + F.lane] = a0; red[(F.wave * 2 + 1) * 64 + F.lane] = a1;
    __syncthreads();
    o0 = 0.f; o1 = 0.f;
    if (F.wave == 0) {
#pragma unroll
        for (int w = 0; w < 8; ++w) { o0 += red[(w * 2 + 0) * 64 + F.lane]; o1 += red[(w * 2 + 1) * 64 + F.lane]; } }
    __syncthreads();
}
__device__ __forceinline__ void p0_prologue_a(Frame& F) {
    for (int t = F.vcu * NWAVES * 64 + F.tid; t < 1024 * 128; t += F.G * NWAVES * 64) { const int k = t >> 7, n4 = (t & 127) * 4;
        const f32x4* a1 = (const f32x4*)(F.in[I_ODWA1] + k * 16); const float* a2 = F.in[I_ODWA2] + n4; f32x4 acc = (f32x4){0.f, 0.f, 0.f, 0.f};
#pragma unroll
        for (int r4 = 0; r4 < 4; ++r4) { const f32x4 av = a1[r4];
#pragma unroll
            for (int e = 0; e < 4; ++e) acc += *(const f32x4*)(a2 + (size_t)(r4 * 4 + e) * 512) * av[e]; }
        *(f32x4*)((float*)(F.ws + WS_WA) + (size_t)k * 512 + n4) = acc; }
    if (F.vcu < 32) { s5_constants(F, F.vcu); return; }
    if (F.vcu < 32 + 192) {
        const int task = F.vcu - 32, l = task / 96, n = (task % 96) * 64 + F.lane;
        const float* W = F.in[I_ADAW] + (size_t)l * 1024 * 6144 + n; const float* cc = F.in[I_C];
        LAS float* sc = (LAS float*)(F.lds + RING_OFF + 8192);
        for (int i = F.tid; i < 2048; i += NWAVES * 64) sc[i] = dsilu(cc[i]);
        __syncthreads();
        float o0, o1;
        gemv64(F, [&](int k) { return W[(size_t)k * 6144]; }, [&](int b, int k) { return sc[b * 1024 + k]; }, o0, o1);
        if (F.wave == 0) { const float bb = F.in[I_ADAB][l * 6144 + n]; float* mod = (float*)(F.ws + WS_MOD) + l * 2 * 6144; mod[n] = o0 + bb; mod[6144 + n] = o1 + bb; }
    }
    LAS float* scr = (LAS float*)(F.lds + RING_OFF + 16384 + F.wave * 12288);
    const int gw = (F.vcu - 32) * NWAVES + F.wave, NGW = (F.G - 32) * NWAVES;
    constexpr int I_O = (D / 64) * (D / 32), I_G = (512 / 64) * (512 / 32), I_2 = (FF / 64) * (D / 32);
    constexpr int NITEMS = 2 * I_O + I_G + 2 * I_2;
    for (int it = NGW - 1 - gw; it < NITEMS; it += NGW) {
        int r = it;
        if (r < I_O) { p_transpose_item(F.in[I_EVWOUT], D, D, (bf16*)(F.ws + WS_WOUT0), scr, r, F.lane); continue; } r -= I_O;
        if (r < I_O) { p_transpose_item(F.in[I_ODWOUT], D, D, (bf16*)(F.ws + WS_WOUT1), scr, r, F.lane); continue; } r -= I_O;
        if (r < I_G) { p_transpose_item(F.in[I_WGLU], 512, 512, (bf16*)(F.ws + WS_WGLU), scr, r, F.lane); continue; } r -= I_G;
        if (r < I_2) { p_transpose_item(F.in[I_W2], FF, D, (bf16*)(F.ws + WS_W2_0), scr, r, F.lane); continue; } r -= I_2;
        p_transpose_item(F.in[I_W2] + (size_t)FF * D, FF, D, (bf16*)(F.ws + WS_W2_1), scr, r, F.lane);
    }
    const float* x = F.in[I_X]; bf16* xb = (bf16*)(F.ws + WS_XB); float* rowsq = (float*)(F.ws + WS_ROWSQ);
    for (int m0 = NGW - 1 - gw; m0 < T; m0 += 4 * NGW) {
        f32x4 v[4][4];
#pragma unroll
        for (int q = 0; q < 4; ++q) { const int m = m0 + q * NGW; if (m < T) { const GAS f32x4* xr = (const GAS f32x4*)(x + (size_t)m * D) + F.lane;
#pragma unroll
                for (int j = 0; j < 4; ++j) v[q][j] = xr[64 * j]; } }
#pragma unroll
        for (int q = 0; q < 4; ++q) { const int m = m0 + q * NGW; if (m < T) { float s = 0.f;
#pragma unroll
                for (int j = 0; j < 4; ++j) s += (v[q][j].x * v[q][j].x + v[q][j].y * v[q][j].y) + (v[q][j].z * v[q][j].z + v[q][j].w * v[q][j].w);
                s = wave_sum(s);
                GAS unsigned long long* o8 = (GAS unsigned long long*)(xb + (size_t)m * D) + F.lane;
#pragma unroll
                for (int j = 0; j < 4; ++j) o8[64 * j] = (unsigned long long)pk2(v[q][j].x, v[q][j].y) | ((unsigned long long)pk2(v[q][j].z, v[q][j].w) << 32);
                if (F.lane < 16) rowsq[(size_t)m * 16 + F.lane] = F.lane == 0 ? s : 0.f; } }
    }
}

struct FusedSrc { const float* p; int ld; };
__device__ __forceinline__ FusedSrc fused_src(Frame& F, int mat, int R0) {
    FusedSrc s;
    if (mat == 0) { s.p = F.in[I_EVWIN] + R0; s.ld = N_IN0; }
    else if (mat == 2) { if (R0 < 3072) { s.p = F.in[I_ODWIN] + R0; s.ld = 3072; } else { s.p = (const float*)(F.ws + WS_WA) + (R0 - 3072); s.ld = 512; } }
    else { const int l = mat >> 1, pn = R0 >> 8, half = (R0 >> 7) & 1, i0 = R0 & 127; s.p = (half ? F.in[I_W3] : F.in[I_W1]) + (size_t)l * D * FF + 128 * pn + i0; s.ld = FF; }
    return s;
}
__device__ __forceinline__ void p1_prologue_b(Frame& F) {
    const float* mod = (const float*)(F.ws + WS_MOD);
    for (int task = F.vcu; task < 272; task += F.G) {
        int mat, nb = task; if (nb < 40) mat = 0; else if ((nb -= 40) < 88) mat = 1; else if ((nb -= 88) < 56) mat = 2; else { nb -= 56; mat = 3; }
        const int l = mat >> 1, sh = (mat & 1) ? 3072 : 0, R = nb * 64 + F.lane; const FusedSrc s = fused_src(F, mat, nb * 64);
        LAS float* sc = (LAS float*)(F.lds + RING_OFF + 8192);
        for (int i = F.tid; i < 2048; i += NWAVES * 64) sc[i] = mod[(l * 2 + (i >> 10)) * 6144 + sh + (i & 1023)];
        __syncthreads();
        float o0, o1;
        gemv64(F, [&](int k) { return s.p[(size_t)k * s.ld + F.lane]; }, [&](int b, int k) { return sc[b * 1024 + k]; }, o0, o1);
        if (F.wave == 0) { const int Ns[4] = {N_IN0, N_UP, N_IN1, N_UP}; const int offs[4] = {CV_IN0, CV_UP0, CV_IN1, CV_UP1};
            float* cv = (float*)(F.ws + WS_CV) + offs[mat]; cv[R] = o0; cv[Ns[mat] + R] = o1; }
    }
    LAS float* scr = (LAS float*)(F.lds + RING_OFF + 16384 + F.wave * 12288);
    LAS float* scl = scr + 64 * 33;
    const int gw = F.vcu * NWAVES + F.wave, NGW = F.G * NWAVES;
    constexpr int IT0 = 16 * (N_IN0 / 32), IT1 = 16 * (N_UP / 32), IT2 = 16 * (N_IN1 / 32);
    for (int it = NGW - 1 - gw; it < IT0 + 2 * IT1 + IT2; it += NGW) {
        int mat, r = it; if (r < IT0) mat = 0; else if ((r -= IT0) < IT1) mat = 1; else if ((r -= IT1) < IT2) mat = 2; else { r -= IT2; mat = 3; }
        const int Ns[4] = {N_IN0, N_UP, N_IN1, N_UP}; const size_t wso[4] = {WS_WIN0, WS_W13_0, WS_WIN1, WS_W13_1};
        const int N = Ns[mat], nblk = N / 32, kb = r / nblk, nb = r % nblk, k0 = 64 * kb, R0 = 32 * nb, l = mat >> 1;
        const FusedSrc s = fused_src(F, mat, R0);
        tile_load(s.p + (size_t)k0 * s.ld, s.ld, scr, F.lane);
        { const int k = k0 + F.lane; const float gn = (mat & 1) ? F.in[I_NFG][l * 1024 + k] : F.in[I_NMG][l * 1024 + k]; const int so = (mat & 1) ? 4096 : 1024;
          scl[F.lane] = gn * (1.0f + mod[(l * 2 + 0) * 6144 + so + k]); scl[64 + F.lane] = gn * (1.0f + mod[(l * 2 + 1) * 6144 + so + k]); }
        LDS_WAIT(); asm volatile("" ::: "memory");
        bf16* dst = (bf16*)(F.ws + wso[mat]) + (size_t)R0 * D + k0;
        float sc0[8], sc1[8];
#pragma unroll
        for (int j = 0; j < 8; ++j) { sc0[j] = scl[8 * (F.lane & 7) + j]; sc1[j] = scl[64 + 8 * (F.lane & 7) + j]; }
        const int c = F.lane & 7;
#pragma unroll
        for (int j = 0; j < 4; ++j) { const int n = (F.lane >> 3) + 8 * j; const LAS float* sp = scr + (8 * c) * 33 + n;
            float v[8];
#pragma unroll
            for (int e = 0; e < 8; ++e) v[e] = sp[e * 33];
            v4u o; o.x = pk2(v[0] * sc0[0], v[1] * sc0[1]); o.y = pk2(v[2] * sc0[2], v[3] * sc0[3]); o.z = pk2(v[4] * sc0[4], v[5] * sc0[5]); o.w = pk2(v[6] * sc0[6], v[7] * sc0[7]);
            *(GAS v4u*)(dst + (size_t)n * D + 8 * c) = o;
            o.x = pk2(v[0] * sc1[0], v[1] * sc1[1]); o.y = pk2(v[2] * sc1[2], v[3] * sc1[3]); o.z = pk2(v[4] * sc1[4], v[5] * sc1[5]); o.w = pk2(v[6] * sc1[6], v[7] * sc1[7]);
            *(GAS v4u*)(dst + (size_t)N * D + (size_t)n * D + 8 * c) = o; }
        LDS_WAIT(); asm volatile("" ::: "memory");
    }
}

__device__ __forceinline__ void s5_carry(Frame& F) {
    for (int task = F.vcu; task < 64; task += F.G) {
        const int b = task >> 5, g = task & 31, p = F.tid & 63, seg = F.tid >> 6;
        const float* X = (const float*)(F.ws + WS_XLOC) + ((size_t)g * NCH + b * 512 + seg * 64) * 128 + p;
        const float* L = (const float*)(F.ws + WS_S5LAM) + (g * 64 + p) * 2; const float lr = L[0], li = L[1];
        float ar = 0.f, ai = 0.f;
#pragma unroll 8
        for (int c = 0; c < 64; ++c) { const float xr = X[(size_t)c * 128], xi = X[(size_t)c * 128 + 64]; const float nr = lr * ar - li * ai + xr, ni = lr * ai + li * ar + xi; ar = nr; ai = ni; }
        float sr = lr, si = li;
#pragma unroll
        for (int q = 0; q < 6; ++q) { const float nr = sr * sr - si * si, ni = 2.f * sr * si; sr = nr; si = ni; }
        LAS float* agg = (LAS float*)(F.lds + RING_OFF);
        agg[(seg * 64 + p) * 2] = ar; agg[(seg * 64 + p) * 2 + 1] = ai;
        __syncthreads();
        float cr = 0.f, ci = 0.f;
        for (int s = 0; s < seg; ++s) { const float xr = agg[(s * 64 + p) * 2], xi = agg[(s * 64 + p) * 2 + 1]; const float nr = sr * cr - si * ci + xr, ni = sr * ci + si * cr + xi; cr = nr; ci = ni; }
        bf16* U = (bf16*)(F.ws + WS_UT) + ((size_t)g * NCH + b * 512 + seg * 64) * UTP + 512 + p;
#pragma unroll 8
        for (int c = 0; c < 64; ++c) { U[(size_t)c * UTP] = (bf16)f2bf(cr); U[(size_t)c * UTP + 64] = (bf16)f2bf(ci);
            const float xr = X[(size_t)c * 128], xi = X[(size_t)c * 128 + 64]; const float nr = lr * cr - li * ci + xr, ni = lr * ci + li * cr + xi; cr = nr; ci = ni; }
        __syncthreads();
    }
}

__device__ __forceinline__ void final_norm(Frame& F) {
    const int gw = F.vcu * NWAVES + F.wave, NGW = F.G * NWAVES; const float* gn = F.in[I_FNORM];
    f32x4 gv[4];
#pragma unroll
    for (int j = 0; j < 4; ++j) gv[j] = ((const f32x4*)gn)[F.lane + 64 * j];
    for (int m = gw; m < T; m += NGW) {
        GAS f32x4* xr = (GAS f32x4*)(F.out + (size_t)m * D) + F.lane; f32x4 v[4]; float s = 0.f;
#pragma unroll
        for (int j = 0; j < 4; ++j) { v[j] = xr[64 * j]; s += (v[j].x * v[j].x + v[j].y * v[j].y) + (v[j].z * v[j].z + v[j].w * v[j].w); }
        const float rs = 1.0f / sqrtf(wave_sum(s) * (1.0f / D) + EPS);
#pragma unroll
        for (int j = 0; j < 4; ++j) xr[64 * j] = v[j] * rs * gv[j];
    }
}
namespace gl {
typedef short bf16x8 __attribute__((ext_vector_type(8)));
typedef short bf16x4 __attribute__((ext_vector_type(4)));
typedef float f32x16 __attribute__((ext_vector_type(16)));
constexpr int P136 = 272, P72 = 144;
constexpr int L_QE = 0, L_QI = 17408, L_KI = 34816, L_KLT = 52224, L_VT = 70656, L_P = 107520, L_TOT = 116736, L_DEC = 120832, L_NG = 121344, L_END = 122368;
static_assert(L_END <= RING_BYTES, "mixer LDS map");
__device__ __forceinline__ bf16x8 frag16(LAS unsigned char* lds, int base, int pitch, int row, int col) { return *(const LAS bf16x8*)(lds + base + row * pitch + col * 2); }
__device__ __forceinline__ unsigned pkbf(float lo, float hi) { return pg8::cvt_pk_bf16(lo, hi); }

#define GL_BAR() do { asm volatile("s_waitcnt lgkmcnt(0)" ::: "memory"); __builtin_amdgcn_s_barrier(); asm volatile("" ::: "memory"); } while (0)
template <int DV, bool GLA, bool PASS2> struct MixPF { unsigned qv[8], kv[8], gv[8]; v4u vt[DV * 8 / 512]; };
template <int DV, bool GLA, bool PASS2>
__device__ __forceinline__ void mix_load(MixPF<DV, GLA, PASS2>& P, int t0, int tid, int w, int h, int c0, const unsigned char* wsb, unsigned zr_off, int zp, int qoff, int koff, int goff, unsigned vt_off, int dvt) {
#pragma unroll
    for (int tt = 0; tt < 8; ++tt) { const unsigned o = zr_off + ((unsigned)(t0 + 8 * w + tt) * (unsigned)zp + (unsigned)(h * 128 + c0)) * 2u;
        P.qv[tt] = PASS2 ? *(const unsigned*)(wsb + (size_t)(o + 2u * qoff)) : 0u; P.kv[tt] = *(const unsigned*)(wsb + (size_t)(o + 2u * koff)); P.gv[tt] = GLA ? *(const unsigned*)(wsb + (size_t)(o + 2u * goff)) : 0u; }
#pragma unroll
    for (int i = 0; i < DV * 8 / 512; ++i) { const int idx = tid + 512 * i, v = idx >> 3, jc = idx & 7; P.vt[i] = *(const v4u*)(wsb + (size_t)(vt_off + (((unsigned)(t0 >> 6) * (unsigned)dvt + (unsigned)(h * DV + v)) * 64u + jc * 8u) * 2u)); }
}
template <int DV, bool GLA, bool PASS2>
__device__ __forceinline__ void mix_unit(Frame& F, int bh, int seg, unsigned zr_off, int zp, int qoff, int koff, int goff, int ooff, unsigned vt_off, int dvt,
                                         float* AGG, float* DSEG, unsigned out_off, int ldo, int ocol0, const float* ng, const float* lbl) {
    const unsigned char* wsb = F.ws;
    constexpr int NV = DV / 32, SW0 = (DV == 128) ? 4 : 0, OTP = DV + 4;
    static_assert(64 * OTP * 4 <= L_VT, "O tile overlays QE..KLT");
    LAS unsigned char* lds = F.lds + RING_OFF;
    const int w = F.wave, lane = F.lane, r = lane & 31, hh = lane >> 5, b = bh >> 2, h = bh & 3, tok0 = b * SEQ + seg * 512, c0 = 2 * lane;
    LAS float* TOT = (LAS float*)(lds + L_TOT); LAS float* DEC = (LAS float*)(lds + L_DEC);
    MixPF<DV, GLA, PASS2> nxt;
    mix_load<DV, GLA, PASS2>(nxt, tok0, F.tid, w, h, c0, wsb, zr_off, zp, qoff, koff, goff, vt_off, dvt);
    float lb[2] = {0.f, 0.f};
    if (!GLA) {
#pragma unroll
        for (int e = 0; e < 2; ++e) { const int c = h * 128 + c0 + e; const float l0 = lbl[c], l1 = lbl[512 + c], l2 = lbl[1024 + c], mx = fmaxf(l0, fmaxf(l1, l2)); const float e0 = __expf(l0 - mx), e1 = __expf(l1 - mx), e2 = __expf(l2 - mx); lb[e] = e0 / (e0 + e1 + e2); } }
    f32x16 S[4];
    const size_t aggbase = ((size_t)(bh * 32 + seg) * 128) * DV;
#pragma unroll
    for (int ct = 0; ct < 4; ++ct)
#pragma unroll
        for (int rr = 0; rr < 16; ++rr) S[ct][rr] = 0.f;
    if (PASS2 && w < NV) {
#pragma unroll
        for (int ct = 0; ct < 4; ++ct)
#pragma unroll
            for (int rr = 0; rr < 16; ++rr) S[ct][rr] = AGG[aggbase + (size_t)(32 * ct + (rr & 3) + 8 * (rr >> 2) + 4 * hh) * DV + 32 * w + r];
    }
    float lsum[2] = {0.f, 0.f};
    LAS float* NG = (LAS float*)(lds + L_NG);
    if (PASS2) { if (F.tid < DV) NG[F.tid] = ng[F.tid]; }
#pragma unroll 1
    for (int ch = 0; ch < 8; ++ch) {
        const int t0 = tok0 + ch * 64;
#pragma unroll
        for (int i = 0; i < DV * 8 / 512; ++i) { const int idx = F.tid + 512 * i, v = idx >> 3, jc = idx & 7; *(LAS v4u*)(lds + L_VT + v * P72 + jc * 16) = nxt.vt[i]; }
        float cl[8][2], qq[8][2], kk[8][2]; float run[2] = {0.f, 0.f};
#pragma unroll
        for (int tt = 0; tt < 8; ++tt)
#pragma unroll
            for (int e = 0; e < 2; ++e) {
                const float kf = e ? pg8::bf_hi(nxt.kv[tt]) : pg8::bf_lo(nxt.kv[tt]), qf = e ? pg8::bf_hi(nxt.qv[tt]) : pg8::bf_lo(nxt.qv[tt]); float lg;
                if (GLA) { lg = (e ? pg8::bf_hi(nxt.gv[tt]) : pg8::bf_lo(nxt.gv[tt])) * 0.0625f; kk[tt][e] = kf; qq[tt][e] = qf; }
                else { const float sg = pg8::fsigmoid(kf), fo = lb[e] + (1.f - lb[e]) * sg; lg = __logf(fo); kk[tt][e] = (1.f - lb[e]) * (1.f - sg); qq[tt][e] = pg8::fsilu(qf); }
                run[e] += lg; cl[tt][e] = run[e]; }
        TOT[w * 128 + c0] = run[0]; TOT[w * 128 + c0 + 1] = run[1];
        GL_BAR();
        float off[2] = {0.f, 0.f}, last[2] = {0.f, 0.f}, ref[2] = {0.f, 0.f};
#pragma unroll
        for (int ww = 0; ww < 8; ++ww) { const float t0_ = TOT[ww * 128 + c0], t1_ = TOT[ww * 128 + c0 + 1];
            if (ww < w) { off[0] += t0_; off[1] += t1_; } if (ww < 4) { ref[0] += t0_; ref[1] += t1_; } last[0] += t0_; last[1] += t1_; }
        float klv[2][8];
#pragma unroll
        for (int tt = 0; tt < 8; ++tt) { float qe[2], qi[2], ki[2];
#pragma unroll
            for (int e = 0; e < 2; ++e) { const float cum = off[e] + cl[tt][e]; klv[e][tt] = kk[tt][e] * __expf(last[e] - cum);
                if (PASS2) { qe[e] = qq[tt][e] * __expf(cum); qi[e] = qq[tt][e] * __expf(cum - ref[e]); ki[e] = kk[tt][e] * __expf(ref[e] - cum); } }
            if (PASS2) { const int o = (8 * w + tt) * P136 + c0 * 2;
                *(LAS unsigned*)(lds + L_QE + o) = pkbf(qe[0], qe[1]); *(LAS unsigned*)(lds + L_QI + o) = pkbf(qi[0], qi[1]); *(LAS unsigned*)(lds + L_KI + o) = pkbf(ki[0], ki[1]); } }
#pragma unroll
        for (int e = 0; e < 2; ++e) { v4u o; o.x = pkbf(klv[e][0], klv[e][1]); o.y = pkbf(klv[e][2], klv[e][3]); o.z = pkbf(klv[e][4], klv[e][5]); o.w = pkbf(klv[e][6], klv[e][7]);
            *(LAS v4u*)(lds + L_KLT + (c0 + e) * P72 + 16 * w) = o; }
        if (w == 0) { DEC[c0] = __expf(last[0]); DEC[c0 + 1] = __expf(last[1]); lsum[0] += last[0]; lsum[1] += last[1]; }
        GL_BAR();
        if (ch + 1 < 8) mix_load<DV, GLA, PASS2>(nxt, t0 + 64, F.tid, w, h, c0, wsb, zr_off, zp, qoff, koff, goff, vt_off, dvt);
        v4u og[DV / 64];
        if (PASS2) {
#pragma unroll
            for (int q = 0; q < DV / 64; ++q) og[q] = *(const v4u*)(wsb + (size_t)(zr_off + ((unsigned)(t0 + (F.tid >> 3)) * (unsigned)zp + (unsigned)(ooff + h * DV + (F.tid & 7) * 8 + 64 * q)) * 2u)); }
        f32x16 O[2];
        if (PASS2) {
            if (w >= SW0 && w < SW0 + 3) {
                const int ti = w - SW0, jt = ti >> 1, it = (ti + 1) >> 1;
                f32x16 X;
#pragma unroll
                for (int rr = 0; rr < 16; ++rr) X[rr] = 0.f;
#pragma unroll
                for (int s = 0; s < 8; ++s) X = __builtin_amdgcn_mfma_f32_32x32x16_bf16(frag16(lds, L_KI, P136, 32 * jt + r, 16 * s + 8 * hh), frag16(lds, L_QI, P136, 32 * it + r, 16 * s + 8 * hh), X, 0, 0, 0);
#pragma unroll
                for (int g = 0; g < 4; ++g) { float x[4];
#pragma unroll
                    for (int e = 0; e < 4; ++e) { const int j = 32 * jt + 8 * g + 4 * hh + e, i = 32 * it + r; x[e] = (j <= i) ? X[4 * g + e] : 0.f; }
                    v2u o; o.x = pkbf(x[0], x[1]); o.y = pkbf(x[2], x[3]);
                    *(LAS v2u*)(lds + L_P + (32 * it + r) * P72 + (32 * jt + 8 * g + 4 * hh) * 2) = o; }
            }
            if (w < NV) {
#pragma unroll
                for (int it = 0; it < 2; ++it)
#pragma unroll
                    for (int rr = 0; rr < 16; ++rr) O[it][rr] = 0.f;
#pragma unroll
                for (int ct = 0; ct < 4; ++ct)
#pragma unroll
                    for (int s = 0; s < 2; ++s) {
                        union { bf16x8 v; unsigned u[4]; } Bs;
#pragma unroll
                        for (int p = 0; p < 4; ++p) Bs.u[p] = pkbf(S[ct][8 * s + 2 * p], S[ct][8 * s + 2 * p + 1]);
#pragma unroll
                        for (int it = 0; it < 2; ++it) { union { bf16x8 v; bf16x4 hlf[2]; } A; const int o = L_QE + (32 * it + r) * P136 + (32 * ct + 16 * s + 4 * hh) * 2;
                            A.hlf[0] = *(const LAS bf16x4*)(lds + o); A.hlf[1] = *(const LAS bf16x4*)(lds + o + 16);
                            O[it] = __builtin_amdgcn_mfma_f32_32x32x16_bf16(A.v, Bs.v, O[it], 0, 0, 0); } }
            }
            GL_BAR();
        }
        if (w < NV) {
            if (PASS2) {
#pragma unroll
                for (int it = 0; it < 2; ++it)
#pragma unroll
                    for (int jt = 0; jt <= it; ++jt)
#pragma unroll
                        for (int s = 0; s < 2; ++s)
                            O[it] = __builtin_amdgcn_mfma_f32_32x32x16_bf16(frag16(lds, L_P, P72, 32 * it + r, 32 * jt + 16 * s + 8 * hh), frag16(lds, L_VT, P72, 32 * w + r, 32 * jt + 16 * s + 8 * hh), O[it], 0, 0, 0);
            }
#pragma unroll
            for (int ct = 0; ct < 4; ++ct) {
#pragma unroll
                for (int g = 0; g < 4; ++g) { const f32x4 d4 = *(const LAS f32x4*)(DEC + 32 * ct + 8 * g + 4 * hh);
#pragma unroll
                    for (int e = 0; e < 4; ++e) S[ct][4 * g + e] *= d4[e]; }
#pragma unroll
                for (int sj = 0; sj < 4; ++sj)
                    S[ct] = __builtin_amdgcn_mfma_f32_32x32x16_bf16(frag16(lds, L_KLT, P72, 32 * ct + r, 16 * sj + 8 * hh), frag16(lds, L_VT, P72, 32 * w + r, 16 * sj + 8 * hh), S[ct], 0, 0, 0);
            }
        }
        GL_BAR();
        if (PASS2) {
            LAS float* OT = (LAS float*)lds;
            if (w < NV) {
#pragma unroll
                for (int it = 0; it < 2; ++it)
#pragma unroll
                    for (int rr = 0; rr < 16; ++rr) OT[(32 * it + (rr & 3) + 8 * (rr >> 2) + 4 * hh) * OTP + 32 * w + r] = O[it][rr];
            }
            GL_BAR();
            const int i = F.tid >> 3, sub = F.tid & 7; float ov[DV / 64][8]; float ss = 0.f;
#pragma unroll
            for (int q = 0; q < DV / 64; ++q) { const f32x4 a = *(const LAS f32x4*)(OT + i * OTP + sub * 8 + 64 * q), bq = *(const LAS f32x4*)(OT + i * OTP + sub * 8 + 64 * q + 4);
#pragma unroll
                for (int e = 0; e < 4; ++e) { ov[q][e] = a[e]; ov[q][4 + e] = bq[e]; ss += a[e] * a[e] + bq[e] * bq[e]; } }
            ss = pg8::sum8(ss);
            const float rs = 1.0f / sqrtf(ss * (1.0f / DV) + EPS);
#pragma unroll
            for (int q = 0; q < DV / 64; ++q) { const int col = sub * 8 + 64 * q; const v4u gw = og[q];
                const float g8[8] = {pg8::bf_lo(gw.x), pg8::bf_hi(gw.x), pg8::bf_lo(gw.y), pg8::bf_hi(gw.y), pg8::bf_lo(gw.z), pg8::bf_hi(gw.z), pg8::bf_lo(gw.w), pg8::bf_hi(gw.w)};
                const f32x4 n0 = *(const LAS f32x4*)(NG + col), n1 = *(const LAS f32x4*)(NG + col + 4);
                float y[8];
#pragma unroll
                for (int e = 0; e < 8; ++e) y[e] = ov[q][e] * rs * (e < 4 ? n0[e] : n1[e - 4]) * pg8::fsilu(g8[e]);
                v4u o; o.x = pkbf(y[0], y[1]); o.y = pkbf(y[2], y[3]); o.z = pkbf(y[4], y[5]); o.w = pkbf(y[6], y[7]);
                *(v4u*)(F.ws + (size_t)(out_off + ((unsigned)(t0 + i) * (unsigned)ldo + (unsigned)(ocol0 + h * DV + col)) * 2u)) = o; }
        }
    }
    if (!PASS2) {
        if (w < NV) {
#pragma unroll
            for (int ct = 0; ct < 4; ++ct)
#pragma unroll
                for (int rr = 0; rr < 16; ++rr) AGG[aggbase + (size_t)(32 * ct + (rr & 3) + 8 * (rr >> 2) + 4 * hh) * DV + 32 * w + r] = S[ct][rr];
        }
        if (w == 0) { DSEG[(bh * 32 + seg) * 128 + c0] = __expf(lsum[0]); DSEG[(bh * 32 + seg) * 128 + c0 + 1] = __expf(lsum[1]); }
    }
}
template <int DV> __device__ __forceinline__ void mix_carry(Frame& F, float* AGG, const float* DSEG) {
    constexpr int PER = 128 * DV;
    for (int idx = F.vcu * (NWAVES * 64) + F.tid; idx < 8 * PER; idx += F.G * NWAVES * 64) {
        const int bh = idx / PER, rem = idx % PER, c = rem / DV; float a[32], d[32];
#pragma unroll
        for (int s = 0; s < 32; ++s) { a[s] = AGG[(size_t)(bh * 32 + s) * PER + rem]; d[s] = DSEG[(bh * 32 + s) * 128 + c]; }
        float cur = 0.f;
#pragma unroll
        for (int s = 0; s < 32; ++s) { AGG[(size_t)(bh * 32 + s) * PER + rem] = cur; cur = d[s] * cur + a[s]; }
    }
}
}
constexpr int N_PHASES = 18;
__global__ void __launch_bounds__(NWAVES * 64, 2) mk_fwd(Args args) {
    extern __shared__ __attribute__((aligned(16))) unsigned char lds[];
    Frame F;
    F.lds = (LAS unsigned char*)lds;
    F.MISC = (volatile LAS unsigned*)(F.lds + MISC_OFF);
    F.tid = threadIdx.x; F.lane = F.tid & 63; F.wave = __builtin_amdgcn_readfirstlane(F.tid >> 6);
    F.G = gridDim.x; { const int bx = blockIdx.x; F.vcu = (F.G % 8 == 0) ? (bx % 8) * (F.G / 8) + bx / 8 : bx; }
    F.in = args.in; F.out = args.out; F.ws = args.ws;
    F.ctl = (gu32*)(args.ws + WS_CTL);
    for (int u = F.tid; u < (LDS_BYTES - LDSCTL_OFF) / 4; u += NWAVES * 64) ((LAS unsigned*)(F.lds + LDSCTL_OFF))[u] = 0u;
    __syncthreads();
    const int lo = args.ph_lo, hi = args.ph_hi;
    XcdBarrier bar; bar.bar = (unsigned*)(F.ctl + CW_BAR); bar.x = 0; bar.st = nullptr;
    if (hi - lo > 1) bar = xcd_barrier_post((unsigned*)(F.ctl + CW_BAR), F.MISC + 8);
#define IN(k) (lo <= (k) && (k) < hi)
#ifdef PROBE_BAR2
#define SEAM(k) do { if (IN(k) && IN((k) + 1)) { xcd_barrier(bar); xcd_barrier(bar); } } while (0)
#else
#define SEAM(k) do { if (IN(k) && IN((k) + 1)) xcd_barrier(bar); } while (0)
#endif
    unsigned char* ws = args.ws;
    float* rowsq = (float*)(ws + WS_ROWSQ); bf16* xb = (bf16*)(ws + WS_XB); const float* mod = (const float*)(ws + WS_MOD); const float* cv = (const float*)(ws + WS_CV);
    const int bid = (int)blockIdx.x;

    if (IN(0)) { p0_prologue_a(F); } SEAM(0);
    if (IN(1)) { p1_prologue_b(F); } SEAM(1);
    if (IN(2)) {
        pg8::Gemm g{xb, (const bf16*)(ws + WS_WIN0), D, D, D}; pg8::StaticOrder S; S.init(T, N_IN0, F.G, bid, 64, (size_t)N_IN0 * D * 2);
        pg8::EpiIn0 E{rowsq, cv + CV_IN0, (bf16*)(ws + WS_UT), (bf16*)(ws + WS_QFG), (bf16*)(ws + WS_VT0)};
        pg8::gemm_phase<pg8::EpiIn0, pg8::StaticOrder, true>(F.lds + RING_OFF, g, S, E);
    } SEAM(2);
    if (IN(3)) {
        { const int un = F.vcu; if (un < 256)
            gl::mix_unit<128, false, false>(F, un >> 5, un & 31, (unsigned)WS_QFG, 1536, 0, 512, 0, 1024, (unsigned)WS_VT0, 512, (float*)(ws + WS_HGA), (float*)(ws + WS_HGD), 0u, 0, 0, nullptr, F.in[I_LBLOG]); }
        __syncthreads();
        pg8::Gemm g{(const bf16*)(ws + WS_UT), (const bf16*)(ws + WS_S5F), UTP, 512, 512}; pg8::GroupOrder S; S.init(4, 1, S5G, F.G, F.vcu, (size_t)NCH * UTP * 2, (size_t)256 * 512 * 2);
        pg8::EpiS5X E{(float*)(ws + WS_XLOC)};
        pg8::gemm_phase<pg8::EpiS5X, pg8::GroupOrder, true>(F.lds + RING_OFF, g, S, E);
    } SEAM(3);
    if (IN(4)) { s5_carry(F); gl::mix_carry<128>(F, (float*)(ws + WS_HGA), (const float*)(ws + WS_HGD)); } SEAM(4);
    if (IN(5)) {
        { const int un = F.vcu; if (un < 256)
            gl::mix_unit<128, false, true>(F, un >> 5, un & 31, (unsigned)WS_QFG, 1536, 0, 512, 0, 1024, (unsigned)WS_VT0, 512, (float*)(ws + WS_HGA), (float*)(ws + WS_HGD), (unsigned)WS_MIXED, D, 512, F.in[I_HGNORM], F.in[I_LBLOG]); }
        __syncthreads();
        pg8::Gemm g{(const bf16*)(ws + WS_UT), (const bf16*)(ws + WS_S5T), UTP, UTP, UTP}; pg8::GroupOrder S; S.init(4, 2, S5G, F.G, F.vcu, (size_t)NCH * UTP * 2, (size_t)512 * UTP * 2);
        pg8::EpiS5Y E{(bf16*)(ws + WS_YGELU)};
        pg8::gemm_phase<pg8::EpiS5Y, pg8::GroupOrder, true>(F.lds + RING_OFF, g, S, E);
    } SEAM(5);
    if (IN(6)) {
        pg8::Gemm g{(const bf16*)(ws + WS_YGELU), (const bf16*)(ws + WS_WGLU), 512, 512, 512}; pg8::StaticOrder S; S.init(T, 512, F.G, bid, 64, 0);
        pg8::EpiGlu E{(const bf16*)(ws + WS_YGELU), F.in[I_BGLU], (bf16*)(ws + WS_MIXED), D};
        pg8::gemm_phase<pg8::EpiGlu, pg8::StaticOrder, true>(F.lds + RING_OFF, g, S, E);
    } SEAM(6);
    if (IN(7)) {
        pg8::Gemm g{(const bf16*)(ws + WS_MIXED), (const bf16*)(ws + WS_WOUT0), D, D, D}; pg8::StaticOrder S; S.init(T, D, F.G, bid, 64, 0);
        pg8::EpiResid E{F.in[I_X], F.out, xb, rowsq, mod + 2048, 6144};
        pg8::gemm_phase<pg8::EpiResid, pg8::StaticOrder, true>(F.lds + RING_OFF, g, S, E);
    } SEAM(7);
    if (IN(8)) {
        pg8::Gemm g{xb, (const bf16*)(ws + WS_W13_0), D, D, D}; pg8::StaticOrder S; S.init(T, N_UP, F.G, bid, 64, (size_t)N_UP * D * 2);
        pg8::EpiFfnUp E{rowsq, cv + CV_UP0, (bf16*)(ws + WS_HID)};
        pg8::gemm_phase<pg8::EpiFfnUp, pg8::StaticOrder, true>(F.lds + RING_OFF, g, S, E);
    } SEAM(8);
    if (IN(9)) {
        pg8::Gemm g{(const bf16*)(ws + WS_HID), (const bf16*)(ws + WS_W2_0), FF, FF, FF}; pg8::StaticOrder S; S.init(T, D, F.G, bid, 64, 0);
        pg8::EpiResid E{F.out, F.out, xb, rowsq, mod + 5120, 6144};
        pg8::gemm_phase<pg8::EpiResid, pg8::StaticOrder, true>(F.lds + RING_OFF, g, S, E);
    } SEAM(9);
    if (IN(10)) {
        pg8::Gemm g{xb, (const bf16*)(ws + WS_WIN1), D, D, D}; pg8::StaticOrder S; S.init(T, N_IN1, F.G, bid, 64, (size_t)N_IN1 * D * 2);
        pg8::EpiIn1 E{rowsq, cv + CV_IN1, F.in[I_ODBA], (bf16*)(ws + WS_Z1), (bf16*)(ws + WS_VT1)};
        pg8::gemm_phase<pg8::EpiIn1, pg8::StaticOrder, true>(F.lds + RING_OFF, g, S, E);
    } SEAM(10);
    if (IN(11)) {
        { const int un = F.vcu; if (un < 256)
            gl::mix_unit<256, true, false>(F, un >> 5, un & 31, (unsigned)WS_Z1, 2560, 0, 512, 2048, 1024, (unsigned)WS_VT1, 1024, (float*)(ws + WS_GLA_A), (float*)(ws + WS_GLA_D), 0u, 0, 0, nullptr, nullptr); }
    } SEAM(11);
    if (IN(12)) { gl::mix_carry<256>(F, (float*)(ws + WS_GLA_A), (const float*)(ws + WS_GLA_D)); } SEAM(12);
    if (IN(13)) {
        { const int un = F.vcu; if (un < 256)
            gl::mix_unit<256, true, true>(F, un >> 5, un & 31, (unsigned)WS_Z1, 2560, 0, 512, 2048, 1024, (unsigned)WS_VT1, 1024, (float*)(ws + WS_GLA_A), (float*)(ws + WS_GLA_D), (unsigned)WS_MIXED2, D, 0, F.in[I_GLANORM], nullptr); }
    } SEAM(13);
    if (IN(14)) {
        pg8::Gemm g{(const bf16*)(ws + WS_MIXED2), (const bf16*)(ws + WS_WOUT1), D, D, D}; pg8::StaticOrder S; S.init(T, D, F.G, bid, 64, 0);
        pg8::EpiResid E{F.out, F.out, xb, rowsq, mod + 2 * 6144 + 2048, 6144};
        pg8::gemm_phase<pg8::EpiResid, pg8::StaticOrder, true>(F.lds + RING_OFF, g, S, E);
    } SEAM(14);
    if (IN(15)) {
        pg8::Gemm g{xb, (const bf16*)(ws + WS_W13_1), D, D, D}; pg8::StaticOrder S; S.init(T, N_UP, F.G, bid, 64, (size_t)N_UP * D * 2);
        pg8::EpiFfnUp E{rowsq, cv + CV_UP1, (bf16*)(ws + WS_HID)};
        pg8::gemm_phase<pg8::EpiFfnUp, pg8::StaticOrder, true>(F.lds + RING_OFF, g, S, E);
    } SEAM(15);
    if (IN(16)) {
        pg8::Gemm g{(const bf16*)(ws + WS_HID), (const bf16*)(ws + WS_W2_1), FF, FF, FF}; pg8::StaticOrder S; S.init(T, D, F.G, bid, 64, 0);
        pg8::EpiResid E{F.out, F.out, xb, rowsq, mod + 2 * 6144 + 5120, 6144};
        pg8::gemm_phase<pg8::EpiResid, pg8::StaticOrder, true>(F.lds + RING_OFF, g, S, E);
    } SEAM(16);
    if (IN(17)) { final_norm(F); }
#undef IN
#undef SEAM
}


extern "C" void kernel_launch(void* const* d_in, const int* in_sizes, int n_in, void* d_out, int out_size, void* d_ws, size_t ws_size, hipStream_t stream) {
    static int grid = 0;
    if (grid == 0) {
        if (n_in != 30 || in_sizes[0] != T * D || out_size != T * D || ws_size < WS_END) { fprintf(stderr, "kernel_launch: unexpected shapes: n_in %d in0 %d out %d ws %zu (need %zu)\n", n_in, n_in > 0 ? in_sizes[0] : -1, out_size, ws_size, (size_t)WS_END); grid = -1; return; }
        int dev = 0, cus = 0, per_cu = 0;
        if (hipGetDevice(&dev) != hipSuccess || hipDeviceGetAttribute(&cus, hipDeviceAttributeMultiprocessorCount, dev) != hipSuccess) { fprintf(stderr, "kernel_launch: device query failed\n"); grid = -1; return; }
        if (hipFuncSetAttribute((const void*)mk_fwd, hipFuncAttributeMaxDynamicSharedMemorySize, LDS_BYTES) != hipSuccess) { fprintf(stderr, "kernel_launch: hipFuncSetAttribute failed\n"); grid = -1; return; }
        if (hipOccupancyMaxActiveBlocksPerMultiprocessor(&per_cu, (const void*)mk_fwd, NWAVES * 64, LDS_BYTES) != hipSuccess || per_cu < 1) { fprintf(stderr, "kernel_launch: occupancy query reports %d workgroups per CU; nothing launched\n", per_cu); (void)hipGetLastError(); grid = -1; return; }
        if (cus < 256) { fprintf(stderr, "kernel_launch: this kernel needs 256 CUs (found %d); nothing launched\n", cus); grid = -1; return; }
        grid = 256;
    }
    if (grid < 0) return;
    (void)hipMemsetAsync((char*)d_ws + WS_CTL, 0, CTL_ZERO_BYTES, stream);
    Args a{};
    for (int i = 0; i < 30; ++i) a.in[i] = (const float*)d_in[i];
    a.out = (float*)d_out; a.ws = (unsigned char*)d_ws;
#ifdef PROBE_RANGES
    static const int ranges[][2] = PROBE_RANGES;
    for (unsigned i = 0; i < sizeof(ranges) / sizeof(ranges[0]); ++i) { if (i) (void)hipMemsetAsync((char*)d_ws + WS_CTL, 0, CTL_ZERO_BYTES, stream);
        a.ph_lo = ranges[i][0]; a.ph_hi = ranges[i][1]; hipLaunchKernelGGL(mk_fwd, dim3(grid), dim3(NWAVES * 64), LDS_BYTES, stream, a); }
#else
    a.ph_lo = 0; a.ph_hi = N_PHASES;
    hipLaunchKernelGGL(mk_fwd, dim3(grid), dim3(NWAVES * 64), LDS_BYTES, stream, a);
#endif
}
```

```cpp
#ifndef PROBE_EPI2_FFNUP
#define PROBE_EPI2_FFNUP false
#endif
#include <hip/hip_runtime.h>
#include <cstdio>
#include <cstdint>
#include <cmath>
namespace pg8 {
#define PG8_LAS __attribute__((address_space(3)))
typedef unsigned short bf16_t;
typedef short bf16x8 __attribute__((ext_vector_type(8)));
typedef float f32x4 __attribute__((ext_vector_type(4)));
typedef unsigned u32x4 __attribute__((ext_vector_type(4)));
typedef unsigned u32x2 __attribute__((ext_vector_type(2)));
constexpr int BM = 256, BK = 64, HALF = 128, HTB = HALF * BK * 2  , STAGE_BYTES = 8 * HTB, NXCD = 8, WGM = 8;

__host__ __device__ __forceinline__ int lds_byte(int r, int c) { const int st = (r >> 4) * 2 + (c >> 5), rr = r & 15, cc = c & 31, ob = rr * 64 + cc * 2; return st * 1024 + (ob ^ (((ob >> 9) & 1) << 5)); }
__host__ __device__ __forceinline__ void stage_rc(int b, int& R, int& C) { const int st = b / 1024, sb = b % 1024, swz = sb ^ (((sb >> 9) & 1) << 5); R = (st >> 1) * 16 + swz / 64; C = (st & 1) * 32 + (swz % 64) / 2; }
__host__ __device__ __forceinline__ int perm32(int rho) { const int n = rho >> 4, i = rho & 15; return 8 * (i >> 2) + 4 * n + (i & 3); }

struct Unit { int pm, pn, g; size_t aoff, boff; };
struct Gemm { const bf16_t* A; const bf16_t* Bt; int lda, ldb, K; };

struct StaticOrder {
    int nM, nN, nwg, G, c, pm_per_batch; size_t bstride;
    __device__ void init(int M, int N, int G_, int c_, int pmpb, size_t bs) { nM = M / BM; nN = N / BM; nwg = nM * nN; G = G_; c = c_; pm_per_batch = pmpb; bstride = bs; }
    __device__ bool next(int i, Unit& u) const {
        const long L = (long)i * G + c; if (L >= nwg) return false;
        int wgid = (int)L; { const int q = nwg / NXCD, r = nwg % NXCD, xcd = wgid % NXCD, off = wgid / NXCD; wgid = (xcd < r ? xcd * (q + 1) : r * (q + 1) + (xcd - r) * q) + off; }
        const int nig = WGM * nN, gid = wgid / nig, fm = gid * WGM, gsz = (nM - fm) < WGM ? (nM - fm) : WGM;
        u.pm = fm + ((wgid % nig) % gsz); u.pn = (wgid % nig) / gsz; u.g = u.pm / pm_per_batch; u.aoff = 0; u.boff = (size_t)u.g * bstride; return true;
    }
};
struct GroupOrder {
    int nM, nN, ngroups, G, c; size_t astride, bstride;
    __device__ void init(int nM_, int nN_, int ng, int G_, int c_, size_t as, size_t bs) { nM = nM_; nN = nN_; ngroups = ng; G = G_; c = c_; astride = as; bstride = bs; }
    __device__ bool next(int i, Unit& u) const {
        const long L = (long)i * G + c; if (L >= (long)ngroups * nM * nN) return false;
        const int g = (int)(L / (nM * nN)), r = (int)(L % (nM * nN)); u.g = g; u.pm = r / nN; u.pn = r % nN; u.aoff = (size_t)g * astride; u.boff = (size_t)g * bstride; return true;
    }
};

__device__ __forceinline__ unsigned cvt_pk_bf16(float lo, float hi) { unsigned r; asm volatile("v_cvt_pk_bf16_f32 %0, %1, %2" : "=v"(r) : "v"(lo), "v"(hi)); return r; }
__device__ __forceinline__ float xsum16(float s) { const unsigned u = __builtin_bit_cast(unsigned, s); const auto r = __builtin_amdgcn_permlane16_swap(u, u, false, false); return __builtin_bit_cast(float, (unsigned)r[0]) + __builtin_bit_cast(float, (unsigned)r[1]); }
__device__ __forceinline__ float xsum32(float s) { const unsigned u = __builtin_bit_cast(unsigned, s); const auto r = __builtin_amdgcn_permlane32_swap(u, u, false, false); return __builtin_bit_cast(float, (unsigned)r[0]) + __builtin_bit_cast(float, (unsigned)r[1]); }
template <int CTRL> __device__ __forceinline__ float dppf(float v) { return __builtin_bit_cast(float, __builtin_amdgcn_update_dpp(0, __builtin_bit_cast(int, v), CTRL, 0xf, 0xf, true)); }
__device__ __forceinline__ float sum8(float s) { s += dppf<0xB1>(s); s += dppf<0x4E>(s); s += dppf<0x141>(s); return s; }
__device__ __forceinline__ float sum64(float s) { s = sum8(s); s += dppf<0x140>(s); s = xsum16(s); return xsum32(s); }
__device__ __forceinline__ float bf_lo(unsigned w) { return __uint_as_float(w << 16); }
__device__ __forceinline__ float bf_hi(unsigned w) { return __uint_as_float(w & 0xffff0000u); }
__device__ __forceinline__ float fsigmoid(float x) { return __builtin_amdgcn_rcpf(1.0f + __expf(-x)); }
__device__ __forceinline__ float fsilu(float x) { return x * fsigmoid(x); }
__device__ __forceinline__ float fgelu_tanh(float y) { return y * fsigmoid(1.5957691216f * (y + 0.044715f * y * y * y)); }
__device__ __forceinline__ float flogsigmoid(float x) { return fminf(x, 0.f) - __logf(1.0f + __expf(-fabsf(x))); }
__device__ __forceinline__ float row_rstd(const float* rowsq, int row) {
    const f32x4* p = (const f32x4*)(rowsq + (size_t)row * 16); const f32x4 a = p[0], b = p[1], c = p[2], d = p[3];
    const float s = ((a[0] + a[1]) + (a[2] + a[3])) + ((b[0] + b[1]) + (b[2] + b[3])) + ((c[0] + c[1]) + (c[2] + c[3])) + ((d[0] + d[1]) + (d[2] + d[3]));
    return 1.0f / sqrtf(s * (1.0f / 1024.0f) + 1e-6f);
}

__device__ __forceinline__ void rowstats8(const float* rowsq, int row0  , int fq, float (&rs)[2][4]) {
    f32x4 p[2][4];
#pragma unroll
    for (int ai = 0; ai < 2; ++ai)
#pragma unroll
        for (int m = 0; m < 4; ++m) p[ai][m] = *(const f32x4*)(rowsq + (size_t)(row0 + ai * HALF + m * 16) * 16 + 4 * fq);
#pragma unroll
    for (int ai = 0; ai < 2; ++ai)
#pragma unroll
        for (int m = 0; m < 4; ++m) { float s = (p[ai][m][0] + p[ai][m][1]) + (p[ai][m][2] + p[ai][m][3]); s = xsum32(xsum16(s)); rs[ai][m] = 1.0f / sqrtf(s * (1.0f / 1024.0f) + 1e-6f); }
}


struct EpiIn0 {
    static constexpr bool PERM = true, AFTER_DRAIN = false, PROBE2 = false;
    const float* rowsq; const float* cvec; bf16_t* Ut; bf16_t* QFG; bf16_t* VT;
    __device__ __forceinline__ void operator()(const f32x4 (&acc)[2][2][4][2], const Unit& u, int wr, int wc, int fr, int fq) const {
        f32x4 cv[2][2];
#pragma unroll
        for (int bj = 0; bj < 2; ++bj)
#pragma unroll
            for (int n = 0; n < 2; ++n) cv[bj][n] = *(const f32x4*)(cvec + u.g * 2560 + u.pn * BM + bj * HALF + wc * 32 + 8 * fq + 4 * n);
float rs8[2][4]; rowstats8(rowsq, u.pm * BM + wr * 64 + fr, fq, rs8);
#pragma unroll
        for (int ai = 0; ai < 2; ++ai)
#pragma unroll
        for (int m = 0; m < 4; ++m) { const int row = u.pm * BM + ai * HALF + wr * 64 + m * 16 + fr;
            const float rs = rs8[ai][m];
#pragma unroll
            for (int bj = 0; bj < 2; ++bj) { const int c0 = u.pn * BM + bj * HALF + wc * 32 + 8 * fq;
                const f32x4 v0 = acc[ai][bj][m][0] * rs + cv[bj][0], v1 = acc[ai][bj][m][1] * rs + cv[bj][1];
                u32x4 w; w.x = cvt_pk_bf16(v0[0], v0[1]); w.y = cvt_pk_bf16(v0[2], v0[3]); w.z = cvt_pk_bf16(v1[0], v1[1]); w.w = cvt_pk_bf16(v1[2], v1[3]);
                if (u.pn == 6 || u.pn == 7) { bf16_t* d = VT + ((size_t)(row >> 6) * 512 + (c0 - 1536)) * 64 + (row & 63);
                    d[0] = (bf16_t)w.x; d[64] = (bf16_t)(w.x >> 16); d[128] = (bf16_t)w.y; d[192] = (bf16_t)(w.y >> 16); d[256] = (bf16_t)w.z; d[320] = (bf16_t)(w.z >> 16); d[384] = (bf16_t)w.w; d[448] = (bf16_t)(w.w >> 16); }
                else { bf16_t* dst = (u.pn < 2) ? Ut + ((size_t)((c0 >> 4) * 1024 + (row >> 5)) * 640 + (row & 31) * 16 + (c0 & 15)) : QFG + (size_t)row * 1536 + (u.pn < 6 ? c0 - 512 : c0 - 1024);
                    *(u32x4*)dst = w; } }
        }
    }
};
struct EpiS5X {
    static constexpr bool PERM = false, AFTER_DRAIN = false, PROBE2 = false;
    float* Xloc;
    __device__ __forceinline__ void operator()(const f32x4 (&acc)[2][2][4][2], const Unit& u, int wr, int wc, int fr, int fq) const {
#pragma unroll
        for (int ai = 0; ai < 2; ++ai)
#pragma unroll
        for (int m = 0; m < 4; ++m) { const int row = u.pm * BM + ai * HALF + wr * 64 + m * 16 + fr;
#pragma unroll
            for (int n = 0; n < 2; ++n) *(f32x4*)(Xloc + ((size_t)u.g * 1024 + row) * 128 + wc * 32 + 16 * n + 4 * fq) = acc[ai][0][m][n];
        }
    }
};
struct EpiS5Y {
    static constexpr bool PERM = true, AFTER_DRAIN = false, PROBE2 = false;
    bf16_t* Y;
    __device__ __forceinline__ void operator()(const f32x4 (&acc)[2][2][4][2], const Unit& u, int wr, int wc, int fr, int fq) const {
#pragma unroll
        for (int ai = 0; ai < 2; ++ai)
#pragma unroll
        for (int m = 0; m < 4; ++m) { const int row = u.pm * BM + ai * HALF + wr * 64 + m * 16 + fr;
#pragma unroll
            for (int bj = 0; bj < 2; ++bj) { const int c0 = u.pn * BM + bj * HALF + wc * 32 + 8 * fq;
                const f32x4 a0 = acc[ai][bj][m][0], a1 = acc[ai][bj][m][1];
                u32x4 w; w.x = cvt_pk_bf16(fgelu_tanh(a0[0]), fgelu_tanh(a0[1])); w.y = cvt_pk_bf16(fgelu_tanh(a0[2]), fgelu_tanh(a0[3]));
                w.z = cvt_pk_bf16(fgelu_tanh(a1[0]), fgelu_tanh(a1[1])); w.w = cvt_pk_bf16(fgelu_tanh(a1[2]), fgelu_tanh(a1[3]));
                *(u32x4*)(Y + ((size_t)row * 32 + (c0 >> 4)) * 512 + u.g * 16 + (c0 & 15)) = w; }
        }
    }
};
struct EpiGlu {
    static constexpr bool PERM = true, AFTER_DRAIN = false, PROBE2 = false;
    const bf16_t* Y; const float* bias; bf16_t* O; int ldo;
    __device__ __forceinline__ void operator()(const f32x4 (&acc)[2][2][4][2], const Unit& u, int wr, int wc, int fr, int fq) const {
        f32x4 bv[2][2];
#pragma unroll
        for (int bj = 0; bj < 2; ++bj)
#pragma unroll
            for (int n = 0; n < 2; ++n) bv[bj][n] = *(const f32x4*)(bias + u.pn * BM + bj * HALF + wc * 32 + 8 * fq + 4 * n);
#pragma unroll
        for (int ai = 0; ai < 2; ++ai)
#pragma unroll
        for (int m = 0; m < 4; ++m) { const int row = u.pm * BM + ai * HALF + wr * 64 + m * 16 + fr;
#pragma unroll
            for (int bj = 0; bj < 2; ++bj) { const int c0 = u.pn * BM + bj * HALF + wc * 32 + 8 * fq;
                const u32x4 yw = *(const u32x4*)(Y + (size_t)row * 512 + c0);
                const f32x4 a0 = acc[ai][bj][m][0] + bv[bj][0], a1 = acc[ai][bj][m][1] + bv[bj][1];
                u32x4 w; w.x = cvt_pk_bf16(bf_lo(yw.x) * fsigmoid(a0[0]), bf_hi(yw.x) * fsigmoid(a0[1])); w.y = cvt_pk_bf16(bf_lo(yw.y) * fsigmoid(a0[2]), bf_hi(yw.y) * fsigmoid(a0[3]));
                w.z = cvt_pk_bf16(bf_lo(yw.z) * fsigmoid(a1[0]), bf_hi(yw.z) * fsigmoid(a1[1])); w.w = cvt_pk_bf16(bf_lo(yw.w) * fsigmoid(a1[2]), bf_hi(yw.w) * fsigmoid(a1[3]));
                *(u32x4*)(O + (size_t)row * ldo + c0) = w; }
        }
    }
};
template <bool LAST> struct EpiResidB {
    static constexpr bool PERM = true, AFTER_DRAIN = false, PROBE2 = false;
    bf16_t* xb; float* xf; float* rowsq; const float* gate; int gstride;
    __device__ __forceinline__ void operator()(const f32x4 (&acc)[2][2][4][2], const Unit& u, int wr, int wc, int fr, int fq) const {
        f32x4 gv[2][2];
#pragma unroll
        for (int bj = 0; bj < 2; ++bj)
#pragma unroll
            for (int n = 0; n < 2; ++n) gv[bj][n] = *(const f32x4*)(gate + u.g * gstride + u.pn * BM + bj * HALF + wc * 32 + 8 * fq + 4 * n);
#pragma unroll
        for (int ai = 0; ai < 2; ++ai) {
        u32x4 xo[4][2];
#pragma unroll
        for (int m = 0; m < 4; ++m)
#pragma unroll
            for (int bj = 0; bj < 2; ++bj) xo[m][bj] = *(const u32x4*)(xb + (size_t)(u.pm * BM + ai * HALF + wr * 64 + m * 16 + fr) * 1024 + u.pn * BM + bj * HALF + wc * 32 + 8 * fq);
#pragma unroll
        for (int m = 0; m < 4; ++m) { const int row = u.pm * BM + ai * HALF + wr * 64 + m * 16 + fr;
            float sq = 0.f;
#pragma unroll
            for (int bj = 0; bj < 2; ++bj) { const size_t off = (size_t)row * 1024 + u.pn * BM + bj * HALF + wc * 32 + 8 * fq; const u32x4 xw = xo[m][bj];
                const f32x4 x0 = (f32x4){bf_lo(xw.x), bf_hi(xw.x), bf_lo(xw.y), bf_hi(xw.y)}, x1 = (f32x4){bf_lo(xw.z), bf_hi(xw.z), bf_lo(xw.w), bf_hi(xw.w)};
                const f32x4 v0 = x0 + gv[bj][0] * acc[ai][bj][m][0], v1 = x1 + gv[bj][1] * acc[ai][bj][m][1];
                sq += (v0[0] * v0[0] + v0[1] * v0[1]) + (v0[2] * v0[2] + v0[3] * v0[3]) + (v1[0] * v1[0] + v1[1] * v1[1]) + (v1[2] * v1[2] + v1[3] * v1[3]);
                if (LAST) { *(f32x4*)(xf + off) = v0; *(f32x4*)(xf + off + 4) = v1; }
                else { u32x4 w; w.x = cvt_pk_bf16(v0[0], v0[1]); w.y = cvt_pk_bf16(v0[2], v0[3]); w.z = cvt_pk_bf16(v1[0], v1[1]); w.w = cvt_pk_bf16(v1[2], v1[3]); *(u32x4*)(xb + off) = w; } }
            sq = xsum32(xsum16(sq));
            if (!LAST && fq == 0) rowsq[(size_t)row * 16 + u.pn * 4 + wc] = sq;
        }
        }
    }
};
struct EpiFfnUp {
    static constexpr bool PERM = true, AFTER_DRAIN = false, PROBE2 = PROBE_EPI2_FFNUP;
    const float* rowsq; const float* cvec; bf16_t* H;
    __device__ __forceinline__ void operator()(const f32x4 (&acc)[2][2][4][2], const Unit& u, int wr, int wc, int fr, int fq) const {
        f32x4 cv[2][2];
#pragma unroll
        for (int bj = 0; bj < 2; ++bj)
#pragma unroll
            for (int n = 0; n < 2; ++n) cv[bj][n] = *(const f32x4*)(cvec + u.g * 5632 + u.pn * BM + bj * HALF + wc * 32 + 8 * fq + 4 * n);
float rs8[2][4]; rowstats8(rowsq, u.pm * BM + wr * 64 + fr, fq, rs8);
#pragma unroll
        for (int ai = 0; ai < 2; ++ai)
#pragma unroll
        for (int m = 0; m < 4; ++m) { const int row = u.pm * BM + ai * HALF + wr * 64 + m * 16 + fr;
            const float rs = rs8[ai][m];
            const f32x4 a0 = acc[ai][0][m][0] * rs + cv[0][0], a1 = acc[ai][0][m][1] * rs + cv[0][1], b0 = acc[ai][1][m][0] * rs + cv[1][0], b1 = acc[ai][1][m][1] * rs + cv[1][1];
            u32x4 w; w.x = cvt_pk_bf16(fsilu(a0[0]) * b0[0], fsilu(a0[1]) * b0[1]); w.y = cvt_pk_bf16(fsilu(a0[2]) * b0[2], fsilu(a0[3]) * b0[3]);
            w.z = cvt_pk_bf16(fsilu(a1[0]) * b1[0], fsilu(a1[1]) * b1[1]); w.w = cvt_pk_bf16(fsilu(a1[2]) * b1[2], fsilu(a1[3]) * b1[3]);
            *(u32x4*)(H + (size_t)row * 2816 + u.pn * HALF + wc * 32 + 8 * fq) = w;
        }
    }
};
struct EpiIn1 {
    static constexpr bool PERM = true, AFTER_DRAIN = false, PROBE2 = false;
    const float* rowsq; const float* cvec; const float* ba; bf16_t* Z; bf16_t* VT;
    __device__ __forceinline__ void operator()(const f32x4 (&acc)[2][2][4][2], const Unit& u, int wr, int wc, int fr, int fq) const {
        f32x4 cv[2][2];
#pragma unroll
        for (int bj = 0; bj < 2; ++bj)
#pragma unroll
            for (int n = 0; n < 2; ++n) { const int c = u.pn * BM + bj * HALF + wc * 32 + 8 * fq + 4 * n; cv[bj][n] = *(const f32x4*)(cvec + u.g * 3584 + c); if (u.pn >= 12) cv[bj][n] += *(const f32x4*)(ba + c - 3072); }
float rs8[2][4]; rowstats8(rowsq, u.pm * BM + wr * 64 + fr, fq, rs8);
#pragma unroll
        for (int ai = 0; ai < 2; ++ai)
#pragma unroll
        for (int m = 0; m < 4; ++m) { const int row = u.pm * BM + ai * HALF + wr * 64 + m * 16 + fr;
            const float rs = rs8[ai][m];
#pragma unroll
            for (int bj = 0; bj < 2; ++bj) { const int c0 = u.pn * BM + bj * HALF + wc * 32 + 8 * fq;
                f32x4 v0 = acc[ai][bj][m][0] * rs + cv[bj][0], v1 = acc[ai][bj][m][1] * rs + cv[bj][1];
                if (u.pn < 2) { v0 = v0 * 0.08838834764831845f; v1 = v1 * 0.08838834764831845f; }
                if (u.pn >= 12) {
#pragma unroll
                    for (int e = 0; e < 4; ++e) { v0[e] = flogsigmoid(v0[e]); v1[e] = flogsigmoid(v1[e]); } }
                u32x4 w; w.x = cvt_pk_bf16(v0[0], v0[1]); w.y = cvt_pk_bf16(v0[2], v0[3]); w.z = cvt_pk_bf16(v1[0], v1[1]); w.w = cvt_pk_bf16(v1[2], v1[3]);
                if (u.pn >= 4 && u.pn < 8) { bf16_t* d = VT + ((size_t)(row >> 6) * 1024 + (c0 - 1024)) * 64 + (row & 63);
                    d[0] = (bf16_t)w.x; d[64] = (bf16_t)(w.x >> 16); d[128] = (bf16_t)w.y; d[192] = (bf16_t)(w.y >> 16); d[256] = (bf16_t)w.z; d[320] = (bf16_t)(w.z >> 16); d[384] = (bf16_t)w.w; d[448] = (bf16_t)(w.w >> 16); }
                else *(u32x4*)(Z + (size_t)row * 2560 + (u.pn < 4 ? c0 : c0 - 1024)) = w; }
        }
    }
};

template <class Epi, class Sched, bool ALIGN_EPI>
__device__ __forceinline__ void gemm_phase(PG8_LAS unsigned char* lds, const Gemm g, const Sched& S, const Epi& E) {
    const int tid = threadIdx.x, wid = __builtin_amdgcn_readfirstlane(tid >> 6), lane = tid & 63, wr = wid >> 2, wc = wid & 3, fr = lane & 15, fq = lane >> 4;
    const int K = g.K, nt = K / BK;
    unsigned voffA[2], voffB[2];
#pragma unroll
    for (int i = 0; i < 2; ++i) { int R, C; stage_rc(tid * 16 + i * 8192, R, C); const int Rb = Epi::PERM ? ((R & ~31) + perm32(R & 31)) : R;
        voffA[i] = (unsigned)(R * g.lda + C) * 2u; voffB[i] = (unsigned)(Rb * g.ldb + C) * 2u; }
    const size_t kstep = (size_t)(BK * 2);
    const size_t hstepA = (size_t)HALF * g.lda * 2, hstepB = (size_t)HALF * g.ldb * 2;
    const unsigned ldsw = (unsigned)wid * 1024u;
    const int aoff = lds_byte(wr * 64 + fr, fq * 8), boff = lds_byte(wc * 32 + fr, fq * 8);
#define PG8_SA(b, h) (((b) * 2 + (h)) * HTB)
#define PG8_SB(b, h) ((4 + (b) * 2 + (h)) * HTB)
#define PG8_STAGE(bufoff, gbase, voff) do { _Pragma("unroll") for (int _i = 0; _i < 2; ++_i) \
        __builtin_amdgcn_global_load_lds((const unsigned*)((const char*)(gbase) + (voff)[_i]), (PG8_LAS unsigned*)(lds + (bufoff) + ldsw + _i * 8192), 16, 0, 0); } while (0)
#define PG8_LDA(dst, b, h) do { _Pragma("unroll") for (int m = 0; m < 4; ++m) _Pragma("unroll") for (int k = 0; k < 2; ++k) dst[m][k] = *(const PG8_LAS bf16x8*)(lds + PG8_SA(b, h) + aoff + m * 2048 + k * 1024); } while (0)
#define PG8_LDB(dst, b, h) do { _Pragma("unroll") for (int n = 0; n < 2; ++n) _Pragma("unroll") for (int k = 0; k < 2; ++k) dst[n][k] = *(const PG8_LAS bf16x8*)(lds + PG8_SB(b, h) + boff + n * 2048 + k * 1024); } while (0)
#define PG8_MMA(ai, bj, At, Bt) do { __builtin_amdgcn_s_setprio(1); _Pragma("unroll") for (int m = 0; m < 4; ++m) _Pragma("unroll") for (int n = 0; n < 2; ++n) _Pragma("unroll") for (int k = 0; k < 2; ++k) \
        acc[ai][bj][m][n] = __builtin_amdgcn_mfma_f32_16x16x32_bf16(Bt[n][k], At[m][k], acc[ai][bj][m][n], 0, 0, 0); __builtin_amdgcn_s_setprio(0); } while (0)
#define PG8_WAIT_V(n) asm volatile("s_waitcnt vmcnt(" #n ")" ::: "memory")
#define PG8_WAIT_L(n) asm volatile("s_waitcnt lgkmcnt(" #n ")" ::: "memory")
#define PG8_BAR __builtin_amdgcn_s_barrier()
#define PG8_SCHED __builtin_amdgcn_sched_barrier(0)
    Unit cur, nxt; int ui = 0;
    if (!S.next(0, cur)) return;
    f32x4 acc[2][2][4][2];
#pragma unroll
    for (int a = 0; a < 2; ++a)
#pragma unroll
        for (int b = 0; b < 2; ++b)
#pragma unroll
            for (int m = 0; m < 4; ++m)
#pragma unroll
                for (int n = 0; n < 2; ++n) acc[a][b][m][n] = (f32x4){0.f, 0.f, 0.f, 0.f};
    bf16x8 At[4][2], B0[2][2], B1[2][2];
    const char* cA = (const char*)g.A + cur.aoff + (size_t)cur.pm * 2 * hstepA; const char* cB = (const char*)g.Bt + cur.boff + (size_t)cur.pn * 2 * hstepB;
    PG8_STAGE(PG8_SB(0, 0), cB, voffB); PG8_STAGE(PG8_SB(0, 1), cB + hstepB, voffB); PG8_STAGE(PG8_SA(0, 0), cA, voffA); PG8_STAGE(PG8_SA(0, 1), cA + hstepA, voffA);
    if (wr == 1) PG8_BAR;
    PG8_WAIT_V(2); PG8_BAR;
    PG8_STAGE(PG8_SB(1, 0), cB + kstep, voffB); PG8_STAGE(PG8_SA(1, 0), cA + kstep, voffA); PG8_STAGE(PG8_SB(1, 1), cB + hstepB + kstep, voffB);
    PG8_WAIT_V(6); PG8_BAR;
    for (;;) {
        const bool has_next = S.next(ui + 1, nxt);
        const char* nA = has_next ? (const char*)g.A + nxt.aoff + (size_t)nxt.pm * 2 * hstepA : cA; const char* nB = has_next ? (const char*)g.Bt + nxt.boff + (size_t)nxt.pn * 2 * hstepB : cB;
        for (int t = 0; t < nt; t += 2) {
            const bool last = (t == nt - 2);
            const char* a1 = cA + (size_t)(t + 1) * kstep;
            const char* a2 = last ? nA : cA + (size_t)(t + 2) * kstep; const char* b2 = last ? nB : cB + (size_t)(t + 2) * kstep;
            const char* a3 = a2 + kstep; const char* b3 = b2 + kstep;
            PG8_LDB(B0, 0, 0); PG8_LDB(B1, 0, 1); PG8_SCHED; PG8_LDA(At, 0, 0); PG8_STAGE(PG8_SA(1, 1), a1 + hstepA, voffA);
            PG8_WAIT_V(8); PG8_WAIT_L(0); PG8_BAR; PG8_MMA(0, 0, At, B0); PG8_MMA(0, 1, At, B1); PG8_BAR; PG8_SCHED;
            PG8_LDA(At, 0, 1); PG8_STAGE(PG8_SB(0, 0), b2, voffB); PG8_STAGE(PG8_SB(0, 1), b2 + hstepB, voffB); PG8_STAGE(PG8_SA(0, 0), a2, voffA);
            PG8_WAIT_V(8); PG8_WAIT_L(0); PG8_BAR; PG8_MMA(1, 0, At, B0); PG8_MMA(1, 1, At, B1); PG8_BAR; PG8_SCHED;
            PG8_LDB(B0, 1, 0); PG8_LDB(B1, 1, 1); PG8_SCHED; PG8_LDA(At, 1, 0); PG8_STAGE(PG8_SA(0, 1), a2 + hstepA, voffA);
            PG8_WAIT_V(8); PG8_WAIT_L(0); PG8_BAR; PG8_MMA(0, 0, At, B0); PG8_MMA(0, 1, At, B1); PG8_BAR; PG8_SCHED;
            PG8_LDA(At, 1, 1); PG8_STAGE(PG8_SB(1, 0), b3, voffB); PG8_STAGE(PG8_SB(1, 1), b3 + hstepB, voffB); PG8_STAGE(PG8_SA(1, 0), a3, voffA);
            PG8_WAIT_V(8); PG8_WAIT_L(0); PG8_BAR; PG8_MMA(1, 0, At, B0); PG8_MMA(1, 1, At, B1); PG8_BAR; PG8_SCHED;
        }
        if constexpr (ALIGN_EPI) { if (wr == 0) PG8_BAR; }
        E(acc, cur, wr, wc, fr, fq);
        if constexpr (Epi::PROBE2) { asm volatile("" ::: "memory"); E(acc, cur, wr, wc, fr, fq); }
        if (!has_next) break;
#pragma unroll
        for (int a = 0; a < 2; ++a)
#pragma unroll
            for (int b = 0; b < 2; ++b)
#pragma unroll
                for (int m = 0; m < 4; ++m)
#pragma unroll
                    for (int n = 0; n < 2; ++n) acc[a][b][m][n] = (f32x4){0.f, 0.f, 0.f, 0.f};
        cur = nxt; cA = nA; cB = nB; ++ui;
        if constexpr (ALIGN_EPI) { if (wr == 1) PG8_BAR; }
    }
    PG8_WAIT_V(0);
    if constexpr (!ALIGN_EPI) { if (wr == 0) PG8_BAR; }
    PG8_BAR;
#undef PG8_SA
#undef PG8_SB
#undef PG8_STAGE
#undef PG8_LDA
#undef PG8_LDB
#undef PG8_MMA
#undef PG8_WAIT_V
#undef PG8_WAIT_L
#undef PG8_BAR
#undef PG8_SCHED
}
}
constexpr int NWAVES = 8;
constexpr int BATCH = 2, SEQ = 16384, D = 1024, T = BATCH * SEQ;
constexpr int FF = 2816, S5W = 512, S5G = 32, S5P = 64, LC = 32, NCH = T / LC  , UTP = LC * 16 + 128  ;
constexpr int N_IN0 = 2560, N_IN1 = 3584, N_UP = 5632;
constexpr float EPS = 1e-6f;
constexpr size_t MiB = 1u << 20;
constexpr size_t WS_CTL = 0, CTL_ZERO_BYTES = 1 * MiB;
constexpr size_t WS_MOD = 1 * MiB;
constexpr size_t WS_CV = 1 * MiB + 128 * 1024;
constexpr int CV_IN0 = 0, CV_UP0 = 2 * N_IN0, CV_IN1 = CV_UP0 + 2 * N_UP, CV_UP1 = CV_IN1 + 2 * N_IN1;
constexpr size_t WS_S5LAM = 1 * MiB + 512 * 1024;
constexpr size_t WS_WIN0 = 2 * MiB, WS_WOUT0 = 12 * MiB, WS_WGLU = 14 * MiB, WS_S5F = 15 * MiB, WS_S5T = 23 * MiB, WS_W13_0 = 43 * MiB, WS_W2_0 = 65 * MiB,
                 WS_WIN1 = 71 * MiB, WS_WOUT1 = 85 * MiB, WS_W13_1 = 87 * MiB, WS_W2_1 = 109 * MiB;
constexpr size_t WS_ROWSQ = 115 * MiB, WS_XB = 117 * MiB, WS_POOL = 181 * MiB, WS_END = 512 * MiB;
constexpr size_t WS_UT = WS_POOL, WS_QFG = 221 * MiB, WS_VT0 = 317 * MiB, WS_XLOC = 349 * MiB, WS_YGELU = 365 * MiB, WS_MIXED = 397 * MiB, WS_HGA = 461 * MiB, WS_HGD = 477 * MiB;
constexpr size_t WS_WA = 349 * MiB;
constexpr size_t WS_HID = WS_POOL;
constexpr size_t WS_Z1 = WS_POOL, WS_VT1 = 341 * MiB, WS_MIXED2 = 405 * MiB, WS_GLA_A = 469 * MiB, WS_GLA_D = 501 * MiB;
static_assert(WS_WIN0 + (size_t)2 * N_IN0 * D * 2 <= WS_WOUT0 && WS_S5F + (size_t)S5G * 256 * 512 * 2 <= WS_S5T && WS_S5T + (size_t)S5G * 512 * UTP * 2 <= WS_W13_0 && WS_W13_0 + (size_t)2 * N_UP * D * 2 <= WS_W2_0 &&
              WS_W2_0 + (size_t)D * FF * 2 <= WS_WIN1 && WS_WIN1 + (size_t)2 * N_IN1 * D * 2 <= WS_WOUT1 && WS_W13_1 + (size_t)2 * N_UP * D * 2 <= WS_W2_1 && WS_W2_1 + (size_t)D * FF * 2 <= WS_ROWSQ, "weights map");
static_assert(WS_UT + (size_t)S5G * NCH * UTP * 2 <= WS_QFG && WS_QFG + (size_t)T * 1536 * 2 <= WS_VT0 && WS_VT0 + (size_t)T * 512 * 2 <= WS_XLOC && WS_XLOC + (size_t)S5G * NCH * 128 * 4 <= WS_YGELU && WS_YGELU + (size_t)T * 512 * 2 <= WS_MIXED &&
              WS_MIXED + (size_t)T * D * 2 <= WS_HGA && WS_HGA + (size_t)8 * 32 * 128 * 128 * 4 <= WS_HGD && WS_HID + (size_t)T * FF * 2 <= WS_END && WS_Z1 + (size_t)T * 2560 * 2 <= WS_VT1 && WS_VT1 + (size_t)T * D * 2 <= WS_MIXED2 &&
              WS_MIXED2 + (size_t)T * D * 2 <= WS_GLA_A && WS_GLA_A + (size_t)8 * 32 * 128 * 256 * 4 <= WS_GLA_D && WS_GLA_D + 8 * 32 * 128 * 4 <= WS_END, "pool map");
constexpr int CW_BAR = 4096;

constexpr int RING_OFF = 0, RING_BYTES = 131072;
constexpr int LDSCTL_OFF = RING_BYTES, MISC_OFF = LDSCTL_OFF + 320;
constexpr int LDS_BYTES = 147456;
static_assert(MISC_OFF + 128 <= LDS_BYTES, "LDS map");

#define GAS __attribute__((address_space(1)))
#define LAS __attribute__((address_space(3)))
typedef unsigned short bf16;
typedef unsigned v4u __attribute__((ext_vector_type(4)));
typedef unsigned v2u __attribute__((ext_vector_type(2)));
typedef float f32x4 __attribute__((ext_vector_type(4)));
typedef GAS unsigned gu32;
#define RLX_AGENT __ATOMIC_RELAXED, __HIP_MEMORY_SCOPE_AGENT
#define LDS_WAIT() asm volatile("s_waitcnt lgkmcnt(0)" ::: "memory")
#define VM_WAIT() asm volatile("s_waitcnt vmcnt(0)" ::: "memory")
__device__ __forceinline__ unsigned f2bf(float f) { unsigned u = __builtin_bit_cast(unsigned, f); return (u + 0x7fffu + ((u >> 16) & 1u)) >> 16; }
__device__ __forceinline__ unsigned pk2(float lo, float hi) { return f2bf(lo) | (f2bf(hi) << 16); }
__device__ __forceinline__ float bf2f(bf16 v) { return __uint_as_float((unsigned)v << 16); }

#define XB_TMO      128
#define XB_XCNT(j)  (256  + 64 * (j))
#define XB_XSUB(j)  (1280 + 64 * (j))
#define XB_XGEN(j)  (2304 + 64 * (j))
#define XB_TOP      3328
#define XB_TOPGEN   3392
#define XCD_BAR_WORDS 3456
#define XB_SPIN_CAP (1u << 18)
__device__ __forceinline__ unsigned xb_ld(unsigned* p)              { return __hip_atomic_load(p, __ATOMIC_RELAXED, __HIP_MEMORY_SCOPE_AGENT); }
__device__ __forceinline__ unsigned xb_add(unsigned* p, unsigned v) { return __hip_atomic_fetch_add(p, v, __ATOMIC_RELAXED, __HIP_MEMORY_SCOPE_AGENT); }
__device__ __forceinline__ unsigned xb_xcc_id() { return (unsigned)__builtin_amdgcn_s_getreg((3 << 11) | 20) & 0xFu; }
#define XB_SPIN(cond, bar) do { unsigned _sp = 0; while (cond) { __builtin_amdgcn_s_sleep(1); \
    if ((++_sp & 255u) == 0u) { if (xb_ld(&(bar)[XB_TMO])) break; if (_sp > XB_SPIN_CAP) { atomicAdd(&(bar)[XB_TMO], 1u); break; } } } } while (0)
struct XcdBarrier { unsigned* bar; unsigned x; volatile LAS unsigned* st; };
__device__ __forceinline__ XcdBarrier xcd_barrier_post(unsigned* bar, volatile LAS unsigned* st) {
    XcdBarrier b; b.bar = bar; b.x = xb_xcc_id(); b.st = st;
    if (threadIdx.x == 0) (void)xb_add(&bar[XB_XCNT(b.x)], 1u);
    return b;
}
__device__ __forceinline__ void xcd_barrier_complete(unsigned* bar, unsigned x, unsigned& nloc, unsigned& nx) {
    const unsigned G = gridDim.x * gridDim.y * gridDim.z;
    unsigned sum, cnt, mine, sp = 0u;
    for (;;) {
        sum = 0u; cnt = 0u; mine = 0u;
#pragma unroll
        for (unsigned j = 0; j < 16; ++j) { const unsigned c = xb_ld(&bar[XB_XCNT(j)]); sum += c; cnt += (c > 0u) ? 1u : 0u; mine = (j == x) ? c : mine; }
        if (sum == G) break;
        __builtin_amdgcn_s_sleep(1);
        if ((++sp & 255u) == 0u) { if (xb_ld(&bar[XB_TMO])) break; if (sp > XB_SPIN_CAP) { atomicAdd(&bar[XB_TMO], 1u); break; } }
    }
    nloc = mine > 0u ? mine : 1u; nx = cnt > 0u ? cnt : 1u;
}
__device__ __forceinline__ void xcd_barrier(const XcdBarrier& b) {
    asm volatile("s_waitcnt vmcnt(0)" ::: "memory");
    __syncthreads();
    if (threadIdx.x == 0) {
        unsigned* bar = b.bar;
        __builtin_amdgcn_s_waitcnt(0);
        unsigned nloc = b.st[0], nx = b.st[1];
        if (nloc == 0u) { xcd_barrier_complete(bar, b.x, nloc, nx); b.st[0] = nloc; b.st[1] = nx; }
        const unsigned old = xb_add(&bar[XB_XSUB(b.x)], 1u);
        const unsigned gen = old / nloc;
        if (old + 1u == (gen + 1u) * nloc) {
            __builtin_amdgcn_fence(__ATOMIC_RELEASE, "agent");
            asm volatile("s_waitcnt vmcnt(0)" ::: "memory");
            const unsigned og = xb_add(&bar[XB_TOP], 1u);
            const unsigned tg = og / nx;
            if (og + 1u == (tg + 1u) * nx) xb_add(&bar[XB_TOPGEN], 1u);
            else XB_SPIN(xb_ld(&bar[XB_TOPGEN]) == tg, bar);
            __builtin_amdgcn_fence(__ATOMIC_ACQUIRE, "agent");
            xb_add(&bar[XB_XGEN(b.x)], 1u);
            asm volatile("s_waitcnt vmcnt(0)" ::: "memory");
        } else {
            XB_SPIN(xb_ld(&bar[XB_XGEN(b.x)]) == gen, bar);
            __builtin_amdgcn_fence(__ATOMIC_ACQUIRE, "agent");
            asm volatile("s_waitcnt vmcnt(0)" ::: "memory");
        }
    }
    __syncthreads();
}

struct Args { const float* in[30]; float* out; unsigned char* ws; int ph_lo, ph_hi; };
enum InIdx { I_X = 0, I_C, I_ADAW, I_ADAB, I_NMG, I_NFG, I_EVWIN, I_EVWOUT, I_LAMRE, I_LAMIM, I_BRE, I_BIM, I_CRE, I_CIM, I_S5D, I_LOGSTEP, I_WGLU, I_BGLU, I_LBLOG, I_HGNORM,
             I_ODWIN, I_ODWA1, I_ODWA2, I_ODBA, I_GLANORM, I_ODWOUT, I_W1, I_W3, I_W2, I_FNORM };
struct Frame {
    LAS unsigned char* lds;
    volatile LAS unsigned* MISC;
    gu32* ctl;
    int tid, lane, wave, vcu, G;
    const float* const* in; float* out; unsigned char* ws;
};
__device__ __forceinline__ float wave_sum(float v) { return pg8::sum64(v); }
__device__ __forceinline__ float dsilu(float x) { return x / (1.0f + expf(-x)); }

__device__ __forceinline__ void tile_store(const LAS float* scr, bf16* dst  , int ldk, const float* sc  , int lane) {
    const int c = lane & 7;
    float s8[8];
#pragma unroll
    for (int j = 0; j < 8; ++j) s8[j] = sc ? sc[8 * c + j] : 1.0f;
#pragma unroll
    for (int j = 0; j < 4; ++j) { const int n = (lane >> 3) + 8 * j; const LAS float* s = scr + (8 * c) * 33 + n;
        v4u o; o.x = pk2(s[0 * 33] * s8[0], s[1 * 33] * s8[1]); o.y = pk2(s[2 * 33] * s8[2], s[3 * 33] * s8[3]); o.z = pk2(s[4 * 33] * s8[4], s[5 * 33] * s8[5]); o.w = pk2(s[6 * 33] * s8[6], s[7 * 33] * s8[7]);
        *(GAS v4u*)(dst + (size_t)n * ldk + 8 * c) = o; }
}
__device__ __forceinline__ void tile_load(const float* W  , int ldw, LAS float* scr, int lane) {
    const int nn = (lane & 7) * 4, kr = lane >> 3; f32x4 v[8];
#pragma unroll
    for (int i = 0; i < 8; ++i) v[i] = *(const GAS f32x4*)(W + (size_t)(kr + 8 * i) * ldw + nn);
#pragma unroll
    for (int i = 0; i < 8; ++i) { LAS float* d = scr + (kr + 8 * i) * 33 + nn; d[0] = v[i].x; d[1] = v[i].y; d[2] = v[i].z; d[3] = v[i].w; }
}
__device__ __forceinline__ void p_transpose_item(const float* W, int K, int N, bf16* WT, LAS float* scr, int item, int lane) {
    const int nblk = N / 32, kb = item / nblk, nb = item % nblk, k0 = 64 * kb, n0 = 32 * nb;
    tile_load(W + (size_t)k0 * N + n0, N, scr, lane);
    LDS_WAIT(); asm volatile("" ::: "memory");
    tile_store(scr, WT + (size_t)n0 * K + k0, K, nullptr, lane);
    LDS_WAIT(); asm volatile("" ::: "memory");
}

__device__ __forceinline__ void s5_constants(Frame& F, int g) {
    LAS float* PW = (LAS float*)(F.lds + RING_OFF);
    LAS float* BB = (LAS float*)(F.lds + RING_OFF + 17408);
    LAS float* CC = (LAS float*)(F.lds + RING_OFF + 25600);
    LAS float* KD = (LAS float*)(F.lds + RING_OFF + 33792);
    LAS float* QQ = (LAS float*)(F.lds + RING_OFF + 66560);
    const float* lam_re = F.in[I_LAMRE] + g * 64; const float* lam_im = F.in[I_LAMIM] + g * 64;
    const float* b_re = F.in[I_BRE] + g * 1024; const float* b_im = F.in[I_BIM] + g * 1024;
    const float* c_re = F.in[I_CRE] + g * 1024; const float* c_im = F.in[I_CIM] + g * 1024;
    if (F.tid < 64) { const int p = F.tid; const double dl = exp((double)F.in[I_LOGSTEP][g]);
        const double lr = lam_re[p], li = lam_im[p]; const double mag = exp(lr * dl); double sn, cs; sincos(li * dl, &sn, &cs);
        const double ar = mag * cs, ai = mag * sn;
        const double nr = ar - 1.0, ni = ai, den = lr * lr + li * li;
        QQ[p * 2] = (float)((nr * lr + ni * li) / den); QQ[p * 2 + 1] = (float)((ni * lr - nr * li) / den);
        double pr = 1.0, pi = 0.0;
        for (int d = 0; d <= LC; ++d) { PW[(d * 64 + p) * 2] = (float)pr; PW[(d * 64 + p) * 2 + 1] = (float)pi; const double tr = pr * ar - pi * ai, ti = pr * ai + pi * ar; pr = tr; pi = ti; } }
    for (int idx = F.tid; idx < 1024; idx += NWAVES * 64) { CC[idx * 2] = c_re[idx]; CC[idx * 2 + 1] = c_im[idx]; }
    __syncthreads();
    for (int idx = F.tid; idx < 1024; idx += NWAVES * 64) { const int p = idx >> 4; const float qr = QQ[p * 2], qi = QQ[p * 2 + 1], br = b_re[idx], bi = b_im[idx];
        BB[idx * 2] = qr * br - qi * bi; BB[idx * 2 + 1] = qr * bi + qi * br; }
    __syncthreads();
    { const int d = F.tid >> 4, ho0 = ((F.tid >> 2) & 3) * 4, hi0 = (F.tid & 3) * 4; float acc[4][4];
#pragma unroll
      for (int a = 0; a < 4; ++a)
#pragma unroll
          for (int q = 0; q < 4; ++q) acc[a][q] = 0.f;
      for (int p = 0; p < 64; ++p) { const float pr = PW[(d * 64 + p) * 2], pi = PW[(d * 64 + p) * 2 + 1]; float xr[4], xi[4];
#pragma unroll
          for (int a = 0; a < 4; ++a) { const float cr = CC[((ho0 + a) * 64 + p) * 2], ci = CC[((ho0 + a) * 64 + p) * 2 + 1]; xr[a] = cr * pr - ci * pi; xi[a] = cr * pi + ci * pr; }
          const f32x4 b0 = *(const LAS f32x4*)(BB + (p * 16 + hi0) * 2), b1 = *(const LAS f32x4*)(BB + (p * 16 + hi0) * 2 + 4);
          const float br[4] = {b0[0], b0[2], b1[0], b1[2]}, bi[4] = {b0[1], b0[3], b1[1], b1[3]};
#pragma unroll
          for (int a = 0; a < 4; ++a)
#pragma unroll
              for (int q = 0; q < 4; ++q) acc[a][q] += xr[a] * br[q] - xi[a] * bi[q]; }
#pragma unroll
      for (int a = 0; a < 4; ++a)
#pragma unroll
          for (int q = 0; q < 4; ++q) { float v = acc[a][q]; if (d == 0 && ho0 + a == hi0 + q) v += F.in[I_S5D][g * 16 + ho0 + a]; KD[(d * 16 + ho0 + a) * 16 + hi0 + q] = v; } }
    __syncthreads();
    bf16* Tg = (bf16*)(F.ws + WS_S5T) + (size_t)g * 512 * UTP;
    for (int idx = F.tid; idx < 512 * 64; idx += NWAVES * 64) { const int n = idx >> 6, kc = idx & 63, l = n >> 4, ho = n & 15, j = kc >> 1, hi0 = (kc & 1) * 8;
        v4u o = (v4u){0u, 0u, 0u, 0u};
        if (j <= l) { const LAS float* k = KD + ((l - j) * 16 + ho) * 16 + hi0; o.x = pk2(k[0], k[1]); o.y = pk2(k[2], k[3]); o.z = pk2(k[4], k[5]); o.w = pk2(k[6], k[7]); }
        *(GAS v4u*)(Tg + (size_t)n * UTP + kc * 8) = o; }
    for (int idx = F.tid; idx < 512 * 16; idx += NWAVES * 64) { const int n = idx >> 4, pc = idx & 15, l = n >> 4, ho = n & 15, im = pc >> 3, p0 = (pc & 7) * 8; float v[8];
#pragma unroll
        for (int e = 0; e < 8; ++e) { const int p = p0 + e; const float cr = CC[(ho * 64 + p) * 2], ci = CC[(ho * 64 + p) * 2 + 1], pr = PW[((l + 1) * 64 + p) * 2], pi = PW[((l + 1) * 64 + p) * 2 + 1];
            v[e] = im ? -(cr * pi + ci * pr) : (cr * pr - ci * pi); }
        v4u o; o.x = pk2(v[0], v[1]); o.y = pk2(v[2], v[3]); o.z = pk2(v[4], v[5]); o.w = pk2(v[6], v[7]);
        *(GAS v4u*)(Tg + (size_t)n * UTP + 512 + pc * 8) = o; }
    bf16* Fg = (bf16*)(F.ws + WS_S5F) + (size_t)g * 256 * 512;
    for (int idx = F.tid; idx < 256 * 64; idx += NWAVES * 64) { const int r = idx >> 6, kc = idx & 63, j = kc >> 1, hi0 = (kc & 1) * 8;
        v4u o = (v4u){0u, 0u, 0u, 0u};
        if (r < 128) { const int p = r & 63, im = r >> 6; const float pr = PW[((LC - 1 - j) * 64 + p) * 2], pi = PW[((LC - 1 - j) * 64 + p) * 2 + 1]; float v[8];
#pragma unroll
            for (int e = 0; e < 8; ++e) { const float br = BB[(p * 16 + hi0 + e) * 2], bi = BB[(p * 16 + hi0 + e) * 2 + 1]; v[e] = im ? (pr * bi + pi * br) : (pr * br - pi * bi); }
            o.x = pk2(v[0], v[1]); o.y = pk2(v[2], v[3]); o.z = pk2(v[4], v[5]); o.w = pk2(v[6], v[7]); }
        *(GAS v4u*)(Fg + (size_t)r * 512 + kc * 8) = o; }
    if (F.tid < 64) { float* L = (float*)(F.ws + WS_S5LAM) + (g * 64 + F.tid) * 2; L[0] = PW[(LC * 64 + F.tid) * 2]; L[1] = PW[(LC * 64 + F.tid) * 2 + 1]; }
    __syncthreads();
}
template <class WF, class VF> __device__ __forceinline__ void gemv64(Frame& F, WF wf, VF vf, float& o0, float& o1) {
    LAS float* red = (LAS float*)(F.lds + RING_OFF);
    float a0 = 0.f, a1 = 0.f; const int kb = F.wave * 128;
#pragma unroll 16
    for (int k = 0; k < 128; ++k) { const float w = wf(kb + k); a0 += vf(0, kb + k) * w; a1 += vf(1, kb + k) * w; }
    red[(F.wave * 2 + 0) * 64 + F.lane] = a0; red[(F.wave * 2 + 1) * 64 + F.lane] = a1;
    __syncthreads();
    o0 = 0.f; o1 = 0.f;
    if (F.wave == 0) {
#pragma unroll
        for (int w = 0; w < 8; ++w) { o0 += red[(w * 2 + 0) * 64 + F.lane]; o1 += red[(w * 2 + 1) * 64 + F.lane]; } }
    __syncthreads();
}
__device__ __forceinline__ void p0_prologue_a(Frame& F) {
    for (int t = F.vcu * NWAVES * 64 + F.tid; t < 1024 * 128; t += F.G * NWAVES * 64) { const int k = t >> 7, n4 = (t & 127) * 4;
        const f32x4* a1 = (const f32x4*)(F.in[I_ODWA1] + k * 16); const float* a2 = F.in[I_ODWA2] + n4; f32x4 acc = (f32x4){0.f, 0.f, 0.f, 0.f};
#pragma unroll
        for (int r4 = 0; r4 < 4; ++r4) { const f32x4 av = a1[r4];
#pragma unroll
            for (int e = 0; e < 4; ++e) acc += *(const f32x4*)(a2 + (size_t)(r4 * 4 + e) * 512) * av[e]; }
        *(f32x4*)((float*)(F.ws + WS_WA) + (size_t)k * 512 + n4) = acc; }
    if (F.vcu < 32) { s5_constants(F, F.vcu); return; }
    if (F.vcu < 32 + 192) {
        const int task = F.vcu - 32, l = task / 96, n = (task % 96) * 64 + F.lane;
        const float* W = F.in[I_ADAW] + (size_t)l * 1024 * 6144 + n; const float* cc = F.in[I_C];
        LAS float* sc = (LAS float*)(F.lds + RING_OFF + 8192);
        for (int i = F.tid; i < 2048; i += NWAVES * 64) sc[i] = dsilu(cc[i]);
        __syncthreads();
        float o0, o1;
        gemv64(F, [&](int k) { return W[(size_t)k * 6144]; }, [&](int b, int k) { return sc[b * 1024 + k]; }, o0, o1);
        if (F.wave == 0) { const float bb = F.in[I_ADAB][l * 6144 + n]; float* mod = (float*)(F.ws + WS_MOD) + l * 2 * 6144; mod[n] = o0 + bb; mod[6144 + n] = o1 + bb; }
    }
    LAS float* scr = (LAS float*)(F.lds + RING_OFF + 16384 + F.wave * 12288);
    const int gw = (F.vcu - 32) * NWAVES + F.wave, NGW = (F.G - 32) * NWAVES;
    constexpr int I_O = (D / 64) * (D / 32), I_G = (512 / 64) * (512 / 32), I_2 = (FF / 64) * (D / 32);
    constexpr int NITEMS = 2 * I_O + I_G + 2 * I_2;
    for (int it = NGW - 1 - gw; it < NITEMS; it += NGW) {
        int r = it;
        if (r < I_O) { p_transpose_item(F.in[I_EVWOUT], D, D, (bf16*)(F.ws + WS_WOUT0), scr, r, F.lane); continue; } r -= I_O;
        if (r < I_O) { p_transpose_item(F.in[I_ODWOUT], D, D, (bf16*)(F.ws + WS_WOUT1), scr, r, F.lane); continue; } r -= I_O;
        if (r < I_G) { p_transpose_item(F.in[I_WGLU], 512, 512, (bf16*)(F.ws + WS_WGLU), scr, r, F.lane); continue; } r -= I_G;
        if (r < I_2) { p_transpose_item(F.in[I_W2], FF, D, (bf16*)(F.ws + WS_W2_0), scr, r, F.lane); continue; } r -= I_2;
        p_transpose_item(F.in[I_W2] + (size_t)FF * D, FF, D, (bf16*)(F.ws + WS_W2_1), scr, r, F.lane);
    }
    const float* x = F.in[I_X]; bf16* xb = (bf16*)(F.ws + WS_XB); float* rowsq = (float*)(F.ws + WS_ROWSQ);
    for (int m0 = NGW - 1 - gw; m0 < T; m0 += 4 * NGW) {
        f32x4 v[4][4];
#pragma unroll
        for (int q = 0; q < 4; ++q) { const int m = m0 + q * NGW; if (m < T) { const GAS f32x4* xr = (const GAS f32x4*)(x + (size_t)m * D) + F.lane;
#pragma unroll
                for (int j = 0; j < 4; ++j) v[q][j] = xr[64 * j]; } }
#pragma unroll
        for (int q = 0; q < 4; ++q) { const int m = m0 + q * NGW; if (m < T) { float s = 0.f;
#pragma unroll
                for (int j = 0; j < 4; ++j) s += (v[q][j].x * v[q][j].x + v[q][j].y * v[q][j].y) + (v[q][j].z * v[q][j].z + v[q][j].w * v[q][j].w);
                s = wave_sum(s);
                GAS unsigned long long* o8 = (GAS unsigned long long*)(xb + (size_t)m * D) + F.lane;
#pragma unroll
                for (int j = 0; j < 4; ++j) o8[64 * j] = (unsigned long long)pk2(v[q][j].x, v[q][j].y) | ((unsigned long long)pk2(v[q][j].z, v[q][j].w) << 32);
                if (F.lane < 16) rowsq[(size_t)m * 16 + F.lane] = F.lane == 0 ? s : 0.f; } }
    }
}

struct FusedSrc { const float* p; int ld; };
__device__ __forceinline__ FusedSrc fused_src(Frame& F, int mat, int R0) {
    FusedSrc s;
    if (mat == 0) { s.p = F.in[I_EVWIN] + R0; s.ld = N_IN0; }
    else if (mat == 2) { if (R0 < 3072) { s.p = F.in[I_ODWIN] + R0; s.ld = 3072; } else { s.p = (const float*)(F.ws + WS_WA) + (R0 - 3072); s.ld = 512; } }
    else { const int l = mat >> 1, pn = R0 >> 8, half = (R0 >> 7) & 1, i0 = R0 & 127; s.p = (half ? F.in[I_W3] : F.in[I_W1]) + (size_t)l * D * FF + 128 * pn + i0; s.ld = FF; }
    return s;
}
__device__ __forceinline__ void p1_prologue_b(Frame& F) {
    const float* mod = (const float*)(F.ws + WS_MOD);
    for (int task = F.vcu; task < 272; task += F.G) {
        int mat, nb = task; if (nb < 40) mat = 0; else if ((nb -= 40) < 88) mat = 1; else if ((nb -= 88) < 56) mat = 2; else { nb -= 56; mat = 3; }
        const int l = mat >> 1, sh = (mat & 1) ? 3072 : 0, R = nb * 64 + F.lane; const FusedSrc s = fused_src(F, mat, nb * 64);
        LAS float* sc = (LAS float*)(F.lds + RING_OFF + 8192);
        for (int i = F.tid; i < 2048; i += NWAVES * 64) sc[i] = mod[(l * 2 + (i >> 10)) * 6144 + sh + (i & 1023)];
        __syncthreads();
        float o0, o1;
        gemv64(F, [&](int k) { return s.p[(size_t)k * s.ld + F.lane]; }, [&](int b, int k) { return sc[b * 1024 + k]; }, o0, o1);
        if (F.wave == 0) { const int Ns[4] = {N_IN0, N_UP, N_IN1, N_UP}; const int offs[4] = {CV_IN0, CV_UP0, CV_IN1, CV_UP1};
            float* cv = (float*)(F.ws + WS_CV) + offs[mat]; cv[R] = o0; cv[Ns[mat] + R] = o1; }
    }
    LAS float* scr = (LAS float*)(F.lds + RING_OFF + 16384 + F.wave * 12288);
    LAS float* scl = scr + 64 * 33;
    const int gw = F.vcu * NWAVES + F.wave, NGW = F.G * NWAVES;
    constexpr int IT0 = 16 * (N_IN0 / 32), IT1 = 16 * (N_UP / 32), IT2 = 16 * (N_IN1 / 32);
    for (int it = NGW - 1 - gw; it < IT0 + 2 * IT1 + IT2; it += NGW) {
        int mat, r = it; if (r < IT0) mat = 0; else if ((r -= IT0) < IT1) mat = 1; else if ((r -= IT1) < IT2) mat = 2; else { r -= IT2; mat = 3; }
        const int Ns[4] = {N_IN0, N_UP, N_IN1, N_UP}; const size_t wso[4] = {WS_WIN0, WS_W13_0, WS_WIN1, WS_W13_1};
        const int N = Ns[mat], nblk = N / 32, kb = r / nblk, nb = r % nblk, k0 = 64 * kb, R0 = 32 * nb, l = mat >> 1;
        const FusedSrc s = fused_src(F, mat, R0);
        tile_load(s.p + (size_t)k0 * s.ld, s.ld, scr, F.lane);
        { const int k = k0 + F.lane; const float gn = (mat & 1) ? F.in[I_NFG][l * 1024 + k] : F.in[I_NMG][l * 1024 + k]; const int so = (mat & 1) ? 4096 : 1024;
          scl[F.lane] = gn * (1.0f + mod[(l * 2 + 0) * 6144 + so + k]); scl[64 + F.lane] = gn * (1.0f + mod[(l * 2 + 1) * 6144 + so + k]); }
        LDS_WAIT(); asm volatile("" ::: "memory");
        bf16* dst = (bf16*)(F.ws + wso[mat]) + (size_t)R0 * D + k0;
        float sc0[8], sc1[8];
#pragma unroll
        for (int j = 0; j < 8; ++j) { sc0[j] = scl[8 * (F.lane & 7) + j]; sc1[j] = scl[64 + 8 * (F.lane & 7) + j]; }
        const int c = F.lane & 7;
#pragma unroll
        for (int j = 0; j < 4; ++j) { const int n = (F.lane >> 3) + 8 * j; const LAS float* sp = scr + (8 * c) * 33 + n;
            float v[8];
#pragma unroll
            for (int e = 0; e < 8; ++e) v[e] = sp[e * 33];
            v4u o; o.x = pk2(v[0] * sc0[0], v[1] * sc0[1]); o.y = pk2(v[2] * sc0[2], v[3] * sc0[3]); o.z = pk2(v[4] * sc0[4], v[5] * sc0[5]); o.w = pk2(v[6] * sc0[6], v[7] * sc0[7]);
            *(GAS v4u*)(dst + (size_t)n * D + 8 * c) = o;
            o.x = pk2(v[0] * sc1[0], v[1] * sc1[1]); o.y = pk2(v[2] * sc1[2], v[3] * sc1[3]); o.z = pk2(v[4] * sc1[4], v[5] * sc1[5]); o.w = pk2(v[6] * sc1[6], v[7] * sc1[7]);
            *(GAS v4u*)(dst + (size_t)N * D + (size_t)n * D + 8 * c) = o; }
        LDS_WAIT(); asm volatile("" ::: "memory");
    }
}

__device__ __forceinline__ void s5_carry(Frame& F) {
    for (int task = F.vcu; task < 64; task += F.G) {
        const int b = task >> 5, g = task & 31, p = F.tid & 63, seg = F.tid >> 6;
        const float* X = (const float*)(F.ws + WS_XLOC) + ((size_t)g * NCH + b * 512 + seg * 64) * 128 + p;
        const float* L = (const float*)(F.ws + WS_S5LAM) + (g * 64 + p) * 2; const float lr = L[0], li = L[1];
        float ar = 0.f, ai = 0.f;
#pragma unroll 8
        for (int c = 0; c < 64; ++c) { const float xr = X[(size_t)c * 128], xi = X[(size_t)c * 128 + 64]; const float nr = lr * ar - li * ai + xr, ni = lr * ai + li * ar + xi; ar = nr; ai = ni; }
        float sr = lr, si = li;
#pragma unroll
        for (int q = 0; q < 6; ++q) { const float nr = sr * sr - si * si, ni = 2.f * sr * si; sr = nr; si = ni; }
        LAS float* agg = (LAS float*)(F.lds + RING_OFF);
        agg[(seg * 64 + p) * 2] = ar; agg[(seg * 64 + p) * 2 + 1] = ai;
        __syncthreads();
        float cr = 0.f, ci = 0.f;
        for (int s = 0; s < seg; ++s) { const float xr = agg[(s * 64 + p) * 2], xi = agg[(s * 64 + p) * 2 + 1]; const float nr = sr * cr - si * ci + xr, ni = sr * ci + si * cr + xi; cr = nr; ci = ni; }
        bf16* U = (bf16*)(F.ws + WS_UT) + ((size_t)g * NCH + b * 512 + seg * 64) * UTP + 512 + p;
#pragma unroll 8
        for (int c = 0; c < 64; ++c) { U[(size_t)c * UTP] = (bf16)f2bf(cr); U[(size_t)c * UTP + 64] = (bf16)f2bf(ci);
            const float xr = X[(size_t)c * 128], xi = X[(size_t)c * 128 + 64]; const float nr = lr * cr - li * ci + xr, ni = lr * ci + li * cr + xi; cr = nr; ci = ni; }
        __syncthreads();
    }
}

__device__ __forceinline__ void final_norm(Frame& F) {
    const int gw = F.vcu * NWAVES + F.wave, NGW = F.G * NWAVES; const float* gn = F.in[I_FNORM];
    f32x4 gv[4];
#pragma unroll
    for (int j = 0; j < 4; ++j) gv[j] = ((const f32x4*)gn)[F.lane + 64 * j];
    for (int m = gw; m < T; m += NGW) {
        GAS f32x4* xr = (GAS f32x4*)(F.out + (size_t)m * D) + F.lane; f32x4 v[4]; float s = 0.f;
#pragma unroll
        for (int j = 0; j < 4; ++j) { v[j] = xr[64 * j]; s += (v[j].x * v[j].x + v[j].y * v[j].y) + (v[j].z * v[j].z + v[j].w * v[j].w); }
        const float rs = 1.0f / sqrtf(wave_sum(s) * (1.0f / D) + EPS);
#pragma unroll
        for (int j = 0; j < 4; ++j) xr[64 * j] = v[j] * rs * gv[j];
    }
}
namespace gl {
typedef short bf16x8 __attribute__((ext_vector_type(8)));
typedef short bf16x4 __attribute__((ext_vector_type(4)));
typedef float f32x16 __attribute__((ext_vector_type(16)));
constexpr int P136 = 272, P72 = 144;
constexpr int L_QE = 0, L_QI = 17408, L_KI = 34816, L_KLT = 52224, L_VT = 70656, L_P = 107520, L_TOT = 116736, L_DEC = 120832, L_NG = 121344, L_END = 122368;
static_assert(L_END <= RING_BYTES, "mixer LDS map");
__device__ __forceinline__ bf16x8 frag16(LAS unsigned char* lds, int base, int pitch, int row, int col) { return *(const LAS bf16x8*)(lds + base + row * pitch + col * 2); }
__device__ __forceinline__ unsigned pkbf(float lo, float hi) { return pg8::cvt_pk_bf16(lo, hi); }

#define GL_BAR() do { asm volatile("s_waitcnt lgkmcnt(0)" ::: "memory"); __builtin_amdgcn_s_barrier(); asm volatile("" ::: "memory"); } while (0)
template <int DV, bool GLA, bool PASS2> struct MixPF { unsigned qv[8], kv[8], gv[8]; v4u vt[DV * 8 / 512]; };
template <int DV, bool GLA, bool PASS2>
__device__ __forceinline__ void mix_load(MixPF<DV, GLA, PASS2>& P, int t0, int tid, int w, int h, int c0, const unsigned char* wsb, unsigned zr_off, int zp, int qoff, int koff, int goff, unsigned vt_off, int dvt) {
#pragma unroll
    for (int tt = 0; tt < 8; ++tt) { const unsigned o = zr_off + ((unsigned)(t0 + 8 * w + tt) * (unsigned)zp + (unsigned)(h * 128 + c0)) * 2u;
        P.qv[tt] = PASS2 ? *(const unsigned*)(wsb + (size_t)(o + 2u * qoff)) : 0u; P.kv[tt] = *(const unsigned*)(wsb + (size_t)(o + 2u * koff)); P.gv[tt] = GLA ? *(const unsigned*)(wsb + (size_t)(o + 2u * goff)) : 0u; }
#pragma unroll
    for (int i = 0; i < DV * 8 / 512; ++i) { const int idx = tid + 512 * i, v = idx >> 3, jc = idx & 7; P.vt[i] = *(const v4u*)(wsb + (size_t)(vt_off + (((unsigned)(t0 >> 6) * (unsigned)dvt + (unsigned)(h * DV + v)) * 64u + jc * 8u) * 2u)); }
}
template <int DV, bool GLA, bool PASS2>
__device__ __forceinline__ void mix_unit(Frame& F, int bh, int seg, unsigned zr_off, int zp, int qoff, int koff, int goff, int ooff, unsigned vt_off, int dvt,
                                         float* AGG, float* DSEG, unsigned out_off, int ldo, int ocol0, const float* ng, const float* lbl) {
    const unsigned char* wsb = F.ws;
    constexpr int NV = DV / 32, SW0 = (DV == 128) ? 4 : 0, OTP = DV + 4;
    static_assert(64 * OTP * 4 <= L_VT, "O tile overlays QE..KLT");
    LAS unsigned char* lds = F.lds + RING_OFF;
    const int w = F.wave, lane = F.lane, r = lane & 31, hh = lane >> 5, b = bh >> 2, h = bh & 3, tok0 = b * SEQ + seg * 512, c0 = 2 * lane;
    LAS float* TOT = (LAS float*)(lds + L_TOT); LAS float* DEC = (LAS float*)(lds + L_DEC);
    MixPF<DV, GLA, PASS2> nxt;
    mix_load<DV, GLA, PASS2>(nxt, tok0, F.tid, w, h, c0, wsb, zr_off, zp, qoff, koff, goff, vt_off, dvt);
    float lb[2] = {0.f, 0.f};
    if (!GLA) {
#pragma unroll
        for (int e = 0; e < 2; ++e) { const int c = h * 128 + c0 + e; const float l0 = lbl[c], l1 = lbl[512 + c], l2 = lbl[1024 + c], mx = fmaxf(l0, fmaxf(l1, l2)); const float e0 = __expf(l0 - mx), e1 = __expf(l1 - mx), e2 = __expf(l2 - mx); lb[e] = e0 / (e0 + e1 + e2); } }
    f32x16 S[4];
    const size_t aggbase = ((size_t)(bh * 32 + seg) * 128) * DV;
#pragma unroll
    for (int ct = 0; ct < 4; ++ct)
#pragma unroll
        for (int rr = 0; rr < 16; ++rr) S[ct][rr] = 0.f;
    if (PASS2 && w < NV) {
#pragma unroll
        for (int ct = 0; ct < 4; ++ct)
#pragma unroll
            for (int rr = 0; rr < 16; ++rr) S[ct][rr] = AGG[aggbase + (size_t)(32 * ct + (rr & 3) + 8 * (rr >> 2) + 4 * hh) * DV + 32 * w + r];
    }
    float lsum[2] = {0.f, 0.f};
    LAS float* NG = (LAS float*)(lds + L_NG);
    if (PASS2) { if (F.tid < DV) NG[F.tid] = ng[F.tid]; }
#pragma unroll 1
    for (int ch = 0; ch < 8; ++ch) {
        const int t0 = tok0 + ch * 64;
#pragma unroll
        for (int i = 0; i < DV * 8 / 512; ++i) { const int idx = F.tid + 512 * i, v = idx >> 3, jc = idx & 7; *(LAS v4u*)(lds + L_VT + v * P72 + jc * 16) = nxt.vt[i]; }
        float cl[8][2], qq[8][2], kk[8][2]; float run[2] = {0.f, 0.f};
#pragma unroll
        for (int tt = 0; tt < 8; ++tt)
#pragma unroll
            for (int e = 0; e < 2; ++e) {
                const float kf = e ? pg8::bf_hi(nxt.kv[tt]) : pg8::bf_lo(nxt.kv[tt]), qf = e ? pg8::bf_hi(nxt.qv[tt]) : pg8::bf_lo(nxt.qv[tt]); float lg;
                if (GLA) { lg = (e ? pg8::bf_hi(nxt.gv[tt]) : pg8::bf_lo(nxt.gv[tt])) * 0.0625f; kk[tt][e] = kf; qq[tt][e] = qf; }
                else { const float sg = pg8::fsigmoid(kf), fo = lb[e] + (1.f - lb[e]) * sg; lg = __logf(fo); kk[tt][e] = (1.f - lb[e]) * (1.f - sg); qq[tt][e] = pg8::fsilu(qf); }
                run[e] += lg; cl[tt][e] = run[e]; }
        TOT[w * 128 + c0] = run[0]; TOT[w * 128 + c0 + 1] = run[1];
        GL_BAR();
        float off[2] = {0.f, 0.f}, last[2] = {0.f, 0.f}, ref[2] = {0.f, 0.f};
#pragma unroll
        for (int ww = 0; ww < 8; ++ww) { const float t0_ = TOT[ww * 128 + c0], t1_ = TOT[ww * 128 + c0 + 1];
            if (ww < w) { off[0] += t0_; off[1] += t1_; } if (ww < 4) { ref[0] += t0_; ref[1] += t1_; } last[0] += t0_; last[1] += t1_; }
        float klv[2][8];
#pragma unroll
        for (int tt = 0; tt < 8; ++tt) { float qe[2], qi[2], ki[2];
#pragma unroll
            for (int e = 0; e < 2; ++e) { const float cum = off[e] + cl[tt][e]; klv[e][tt] = kk[tt][e] * __expf(last[e] - cum);
                if (PASS2) { qe[e] = qq[tt][e] * __expf(cum); qi[e] = qq[tt][e] * __expf(cum - ref[e]); ki[e] = kk[tt][e] * __expf(ref[e] - cum); } }
            if (PASS2) { const int o = (8 * w + tt) * P136 + c0 * 2;
                *(LAS unsigned*)(lds + L_QE + o) = pkbf(qe[0], qe[1]); *(LAS unsigned*)(lds + L_QI + o) = pkbf(qi[0], qi[1]); *(LAS unsigned*)(lds + L_KI + o) = pkbf(ki[0], ki[1]); } }
#pragma unroll
        for (int e = 0; e < 2; ++e) { v4u o; o.x = pkbf(klv[e][0], klv[e][1]); o.y = pkbf(klv[e][2], klv[e][3]); o.z = pkbf(klv[e][4], klv[e][5]); o.w = pkbf(klv[e][6], klv[e][7]);
            *(LAS v4u*)(lds + L_KLT + (c0 + e) * P72 + 16 * w) = o; }
        if (w == 0) { DEC[c0] = __expf(last[0]); DEC[c0 + 1] = __expf(last[1]); lsum[0] += last[0]; lsum[1] += last[1]; }
        GL_BAR();
        if (ch + 1 < 8) mix_load<DV, GLA, PASS2>(nxt, t0 + 64, F.tid, w, h, c0, wsb, zr_off, zp, qoff, koff, goff, vt_off, dvt);
        v4u og[DV / 64];
        if (PASS2) {
#pragma unroll
            for (int q = 0; q < DV / 64; ++q) og[q] = *(const v4u*)(wsb + (size_t)(zr_off + ((unsigned)(t0 + (F.tid >> 3)) * (unsigned)zp + (unsigned)(ooff + h * DV + (F.tid & 7) * 8 + 64 * q)) * 2u)); }
        f32x16 O[2];
        if (PASS2) {
            if (w >= SW0 && w < SW0 + 3) {
                const int ti = w - SW0, jt = ti >> 1, it = (ti + 1) >> 1;
                f32x16 X;
#pragma unroll
                for (int rr = 0; rr < 16; ++rr) X[rr] = 0.f;
#pragma unroll
                for (int s = 0; s < 8; ++s) X = __builtin_amdgcn_mfma_f32_32x32x16_bf16(frag16(lds, L_KI, P136, 32 * jt + r, 16 * s + 8 * hh), frag16(lds, L_QI, P136, 32 * it + r, 16 * s + 8 * hh), X, 0, 0, 0);
#pragma unroll
                for (int g = 0; g < 4; ++g) { float x[4];
#pragma unroll
                    for (int e = 0; e < 4; ++e) { const int j = 32 * jt + 8 * g + 4 * hh + e, i = 32 * it + r; x[e] = (j <= i) ? X[4 * g + e] : 0.f; }
                    v2u o; o.x = pkbf(x[0], x[1]); o.y = pkbf(x[2], x[3]);
                    *(LAS v2u*)(lds + L_P + (32 * it + r) * P72 + (32 * jt + 8 * g + 4 * hh) * 2) = o; }
            }
            if (w < NV) {
#pragma unroll
                for (int it = 0; it < 2; ++it)
#pragma unroll
                    for (int rr = 0; rr < 16; ++rr) O[it][rr] = 0.f;
#pragma unroll
                for (int ct = 0; ct < 4; ++ct)
#pragma unroll
                    for (int s = 0; s < 2; ++s) {
                        union { bf16x8 v; unsigned u[4]; } Bs;
#pragma unroll
                        for (int p = 0; p < 4; ++p) Bs.u[p] = pkbf(S[ct][8 * s + 2 * p], S[ct][8 * s + 2 * p + 1]);
#pragma unroll
                        for (int it = 0; it < 2; ++it) { union { bf16x8 v; bf16x4 hlf[2]; } A; const int o = L_QE + (32 * it + r) * P136 + (32 * ct + 16 * s + 4 * hh) * 2;
                            A.hlf[0] = *(const LAS bf16x4*)(lds + o); A.hlf[1] = *(const LAS bf16x4*)(lds + o + 16);
                            O[it] = __builtin_amdgcn_mfma_f32_32x32x16_bf16(A.v, Bs.v, O[it], 0, 0, 0); } }
            }
            GL_BAR();
        }
        if (w < NV) {
            if (PASS2) {
#pragma unroll
                for (int it = 0; it < 2; ++it)
#pragma unroll
                    for (int jt = 0; jt <= it; ++jt)
#pragma unroll
                        for (int s = 0; s < 2; ++s)
                            O[it] = __builtin_amdgcn_mfma_f32_32x32x16_bf16(frag16(lds, L_P, P72, 32 * it + r, 32 * jt + 16 * s + 8 * hh), frag16(lds, L_VT, P72, 32 * w + r, 32 * jt + 16 * s + 8 * hh), O[it], 0, 0, 0);
            }
#pragma unroll
            for (int ct = 0; ct < 4; ++ct) {
#pragma unroll
                for (int g = 0; g < 4; ++g) { const f32x4 d4 = *(const LAS f32x4*)(DEC + 32 * ct + 8 * g + 4 * hh);
#pragma unroll
                    for (int e = 0; e < 4; ++e) S[ct][4 * g + e] *= d4[e]; }
#pragma unroll
                for (int sj = 0; sj < 4; ++sj)
                    S[ct] = __builtin_amdgcn_mfma_f32_32x32x16_bf16(frag16(lds, L_KLT, P72, 32 * ct + r, 16 * sj + 8 * hh), frag16(lds, L_VT, P72, 32 * w + r, 16 * sj + 8 * hh), S[ct], 0, 0, 0);
            }
        }
        GL_BAR();
        if (PASS2) {
            LAS float* OT = (LAS float*)lds;
            if (w < NV) {
#pragma unroll
                for (int it = 0; it < 2; ++it)
#pragma unroll
                    for (int rr = 0; rr < 16; ++rr) OT[(32 * it + (rr & 3) + 8 * (rr >> 2) + 4 * hh) * OTP + 32 * w + r] = O[it][rr];
            }
            GL_BAR();
            const int i = F.tid >> 3, sub = F.tid & 7; float ov[DV / 64][8]; float ss = 0.f;
#pragma unroll
            for (int q = 0; q < DV / 64; ++q) { const f32x4 a = *(const LAS f32x4*)(OT + i * OTP + sub * 8 + 64 * q), bq = *(const LAS f32x4*)(OT + i * OTP + sub * 8 + 64 * q + 4);
#pragma unroll
                for (int e = 0; e < 4; ++e) { ov[q][e] = a[e]; ov[q][4 + e] = bq[e]; ss += a[e] * a[e] + bq[e] * bq[e]; } }
            ss = pg8::sum8(ss);
            const float rs = 1.0f / sqrtf(ss * (1.0f / DV) + EPS);
#pragma unroll
            for (int q = 0; q < DV / 64; ++q) { const int col = sub * 8 + 64 * q; const v4u gw = og[q];
                const float g8[8] = {pg8::bf_lo(gw.x), pg8::bf_hi(gw.x), pg8::bf_lo(gw.y), pg8::bf_hi(gw.y), pg8::bf_lo(gw.z), pg8::bf_hi(gw.z), pg8::bf_lo(gw.w), pg8::bf_hi(gw.w)};
                const f32x4 n0 = *(const LAS f32x4*)(NG + col), n1 = *(const LAS f32x4*)(NG + col + 4);
                float y[8];
#pragma unroll
                for (int e = 0; e < 8; ++e) y[e] = ov[q][e] * rs * (e < 4 ? n0[e] : n1[e - 4]) * pg8::fsilu(g8[e]);
                v4u o; o.x = pkbf(y[0], y[1]); o.y = pkbf(y[2], y[3]); o.z = pkbf(y[4], y[5]); o.w = pkbf(y[6], y[7]);
                *(v4u*)(F.ws + (size_t)(out_off + ((unsigned)(t0 + i) * (unsigned)ldo + (unsigned)(ocol0 + h * DV + col)) * 2u)) = o; }
        }
    }
    if (!PASS2) {
        if (w < NV) {
#pragma unroll
            for (int ct = 0; ct < 4; ++ct)
#pragma unroll
                for (int rr = 0; rr < 16; ++rr) AGG[aggbase + (size_t)(32 * ct + (rr & 3) + 8 * (rr >> 2) + 4 * hh) * DV + 32 * w + r] = S[ct][rr];
        }
        if (w == 0) { DSEG[(bh * 32 + seg) * 128 + c0] = __expf(lsum[0]); DSEG[(bh * 32 + seg) * 128 + c0 + 1] = __expf(lsum[1]); }
    }
}
template <int DV> __device__ __forceinline__ void mix_carry(Frame& F, float* AGG, const float* DSEG) {
    constexpr int PER = 128 * DV;
    for (int idx = F.vcu * (NWAVES * 64) + F.tid; idx < 8 * PER; idx += F.G * NWAVES * 64) {
        const int bh = idx / PER, rem = idx % PER, c = rem / DV; float a[32], d[32];
#pragma unroll
        for (int s = 0; s < 32; ++s) { a[s] = AGG[(size_t)(bh * 32 + s) * PER + rem]; d[s] = DSEG[(bh * 32 + s) * 128 + c]; }
        float cur = 0.f;
#pragma unroll
        for (int s = 0; s < 32; ++s) { AGG[(size_t)(bh * 32 + s) * PER + rem] = cur; cur = d[s] * cur + a[s]; }
    }
}
}
constexpr int N_PHASES = 18;
__global__ void __launch_bounds__(NWAVES * 64, 2) mk_fwd(Args args) {
    extern __shared__ __attribute__((aligned(16))) unsigned char lds[];
    Frame F;
    F.lds = (LAS unsigned char*)lds;
    F.MISC = (volatile LAS unsigned*)(F.lds + MISC_OFF);
    F.tid = threadIdx.x; F.lane = F.tid & 63; F.wave = __builtin_amdgcn_readfirstlane(F.tid >> 6);
    F.G = gridDim.x; { const int bx = blockIdx.x; F.vcu = (F.G % 8 == 0) ? (bx % 8) * (F.G / 8) + bx / 8 : bx; }
    F.in = args.in; F.out = args.out; F.ws = args.ws;
    F.ctl = (gu32*)(args.ws + WS_CTL);
    for (int u = F.tid; u < (LDS_BYTES - LDSCTL_OFF) / 4; u += NWAVES * 64) ((LAS unsigned*)(F.lds + LDSCTL_OFF))[u] = 0u;
    __syncthreads();
    const int lo = args.ph_lo, hi = args.ph_hi;
    XcdBarrier bar; bar.bar = (unsigned*)(F.ctl + CW_BAR); bar.x = 0; bar.st = nullptr;
    if (hi - lo > 1) bar = xcd_barrier_post((unsigned*)(F.ctl + CW_BAR), F.MISC + 8);
#define IN(k) (lo <= (k) && (k) < hi)
#ifdef PROBE_BAR2
#define SEAM(k) do { if (IN(k) && IN((k) + 1)) { xcd_barrier(bar); xcd_barrier(bar); } } while (0)
#else
#define SEAM(k) do { if (IN(k) && IN((k) + 1)) xcd_barrier(bar); } while (0)
#endif
    unsigned char* ws = args.ws;
    float* rowsq = (float*)(ws + WS_ROWSQ); bf16* xb = (bf16*)(ws + WS_XB); const float* mod = (const float*)(ws + WS_MOD); const float* cv = (const float*)(ws + WS_CV);
    const int bid = (int)blockIdx.x;

    if (IN(0)) { p0_prologue_a(F); } SEAM(0);
    if (IN(1)) { p1_prologue_b(F); } SEAM(1);
    if (IN(2)) {
        pg8::Gemm g{xb, (const bf16*)(ws + WS_WIN0), D, D, D}; pg8::StaticOrder S; S.init(T, N_IN0, F.G, bid, 64, (size_t)N_IN0 * D * 2);
        pg8::EpiIn0 E{rowsq, cv + CV_IN0, (bf16*)(ws + WS_UT), (bf16*)(ws + WS_QFG), (bf16*)(ws + WS_VT0)};
        pg8::gemm_phase<pg8::EpiIn0, pg8::StaticOrder, true>(F.lds + RING_OFF, g, S, E);
    } SEAM(2);
    if (IN(3)) {
        { const int un = F.vcu; if (un < 256)
            gl::mix_unit<128, false, false>(F, un >> 5, un & 31, (unsigned)WS_QFG, 1536, 0, 512, 0, 1024, (unsigned)WS_VT0, 512, (float*)(ws + WS_HGA), (float*)(ws + WS_HGD), 0u, 0, 0, nullptr, F.in[I_LBLOG]); }
        __syncthreads();
        pg8::Gemm g{(const bf16*)(ws + WS_UT), (const bf16*)(ws + WS_S5F), UTP, 512, 512}; pg8::GroupOrder S; S.init(4, 1, S5G, F.G, F.vcu, (size_t)NCH * UTP * 2, (size_t)256 * 512 * 2);
        pg8::EpiS5X E{(float*)(ws + WS_XLOC)};
        pg8::gemm_phase<pg8::EpiS5X, pg8::GroupOrder, true>(F.lds + RING_OFF, g, S, E);
    } SEAM(3);
    if (IN(4)) { s5_carry(F); gl::mix_carry<128>(F, (float*)(ws + WS_HGA), (const float*)(ws + WS_HGD)); } SEAM(4);
    if (IN(5)) {
        { const int un = F.vcu; if (un < 256)
            gl::mix_unit<128, false, true>(F, un >> 5, un & 31, (unsigned)WS_QFG, 1536, 0, 512, 0, 1024, (unsigned)WS_VT0, 512, (float*)(ws + WS_HGA), (float*)(ws + WS_HGD), (unsigned)WS_MIXED, D, 512, F.in[I_HGNORM], F.in[I_LBLOG]); }
        __syncthreads();
        pg8::Gemm g{(const bf16*)(ws + WS_UT), (const bf16*)(ws + WS_S5T), UTP, UTP, UTP}; pg8::GroupOrder S; S.init(4, 2, S5G, F.G, F.vcu, (size_t)NCH * UTP * 2, (size_t)512 * UTP * 2);
        pg8::EpiS5Y E{(bf16*)(ws + WS_YGELU)};
        pg8::gemm_phase<pg8::EpiS5Y, pg8::GroupOrder, true>(F.lds + RING_OFF, g, S, E);
    } SEAM(5);
    if (IN(6)) {
        pg8::Gemm g{(const bf16*)(ws + WS_YGELU), (const bf16*)(ws + WS_WGLU), 512, 512, 512}; pg8::StaticOrder S; S.init(T, 512, F.G, bid, 64, 0);
        pg8::EpiGlu E{(const bf16*)(ws + WS_YGELU), F.in[I_BGLU], (bf16*)(ws + WS_MIXED), D};
        pg8::gemm_phase<pg8::EpiGlu, pg8::StaticOrder, true>(F.lds + RING_OFF, g, S, E);
    } SEAM(6);
    if (IN(7)) {
        pg8::Gemm g{(const bf16*)(ws + WS_MIXED), (const bf16*)(ws + WS_WOUT0), D, D, D}; pg8::StaticOrder S; S.init(T, D, F.G, bid, 64, 0);
        pg8::EpiResidB<false> E{xb, nullptr, rowsq, mod + 2048, 6144};
        pg8::gemm_phase<pg8::EpiResidB<false>, pg8::StaticOrder, true>(F.lds + RING_OFF, g, S, E);
    } SEAM(7);
    if (IN(8)) {
        pg8::Gemm g{xb, (const bf16*)(ws + WS_W13_0), D, D, D}; pg8::StaticOrder S; S.init(T, N_UP, F.G, bid, 64, (size_t)N_UP * D * 2);
        pg8::EpiFfnUp E{rowsq, cv + CV_UP0, (bf16*)(ws + WS_HID)};
        pg8::gemm_phase<pg8::EpiFfnUp, pg8::StaticOrder, true>(F.lds + RING_OFF, g, S, E);
    } SEAM(8);
    if (IN(9)) {
        pg8::Gemm g{(const bf16*)(ws + WS_HID), (const bf16*)(ws + WS_W2_0), FF, FF, FF}; pg8::StaticOrder S; S.init(T, D, F.G, bid, 64, 0);
        pg8::EpiResidB<false> E{xb, nullptr, rowsq, mod + 5120, 6144};
        pg8::gemm_phase<pg8::EpiResidB<false>, pg8::StaticOrder, true>(F.lds + RING_OFF, g, S, E);
    } SEAM(9);
    if (IN(10)) {
        pg8::Gemm g{xb, (const bf16*)(ws + WS_WIN1), D, D, D}; pg8::StaticOrder S; S.init(T, N_IN1, F.G, bid, 64, (size_t)N_IN1 * D * 2);
        pg8::EpiIn1 E{rowsq, cv + CV_IN1, F.in[I_ODBA], (bf16*)(ws + WS_Z1), (bf16*)(ws + WS_VT1)};
        pg8::gemm_phase<pg8::EpiIn1, pg8::StaticOrder, true>(F.lds + RING_OFF, g, S, E);
    } SEAM(10);
    if (IN(11)) {
        { const int un = F.vcu; if (un < 256)
            gl::mix_unit<256, true, false>(F, un >> 5, un & 31, (unsigned)WS_Z1, 2560, 0, 512, 2048, 1024, (unsigned)WS_VT1, 1024, (float*)(ws + WS_GLA_A), (float*)(ws + WS_GLA_D), 0u, 0, 0, nullptr, nullptr); }
    } SEAM(11);
    if (IN(12)) { gl::mix_carry<256>(F, (float*)(ws + WS_GLA_A), (const float*)(ws + WS_GLA_D)); } SEAM(12);
    if (IN(13)) {
        { const int un = F.vcu; if (un < 256)
            gl::mix_unit<256, true, true>(F, un >> 5, un & 31, (unsigned)WS_Z1, 2560, 0, 512, 2048, 1024, (unsigned)WS_VT1, 1024, (float*)(ws + WS_GLA_A), (float*)(ws + WS_GLA_D), (unsigned)WS_MIXED2, D, 0, F.in[I_GLANORM], nullptr); }
    } SEAM(13);
    if (IN(14)) {
        pg8::Gemm g{(const bf16*)(ws + WS_MIXED2), (const bf16*)(ws + WS_WOUT1), D, D, D}; pg8::StaticOrder S; S.init(T, D, F.G, bid, 64, 0);
        pg8::EpiResidB<false> E{xb, nullptr, rowsq, mod + 2 * 6144 + 2048, 6144};
        pg8::gemm_phase<pg8::EpiResidB<false>, pg8::StaticOrder, true>(F.lds + RING_OFF, g, S, E);
    } SEAM(14);
    if (IN(15)) {
        pg8::Gemm g{xb, (const bf16*)(ws + WS_W13_1), D, D, D}; pg8::StaticOrder S; S.init(T, N_UP, F.G, bid, 64, (size_t)N_UP * D * 2);
        pg8::EpiFfnUp E{rowsq, cv + CV_UP1, (bf16*)(ws + WS_HID)};
        pg8::gemm_phase<pg8::EpiFfnUp, pg8::StaticOrder, true>(F.lds + RING_OFF, g, S, E);
    } SEAM(15);
    if (IN(16)) {
        pg8::Gemm g{(const bf16*)(ws + WS_HID), (const bf16*)(ws + WS_W2_1), FF, FF, FF}; pg8::StaticOrder S; S.init(T, D, F.G, bid, 64, 0);
        pg8::EpiResidB<true> E{xb, F.out, rowsq, mod + 2 * 6144 + 5120, 6144};
        pg8::gemm_phase<pg8::EpiResidB<true>, pg8::StaticOrder, true>(F.lds + RING_OFF, g, S, E);
    } SEAM(16);
    if (IN(17)) { final_norm(F); }
#undef IN
#undef SEAM
}


extern "C" void kernel_launch(void* const* d_in, const int* in_sizes, int n_in, void* d_out, int out_size, void* d_ws, size_t ws_size, hipStream_t stream) {
    static int grid = 0;
    if (grid == 0) {
        if (n_in != 30 || in_sizes[0] != T * D || out_size != T * D || ws_size < WS_END) { fprintf(stderr, "kernel_launch: unexpected shapes: n_in %d in0 %d out %d ws %zu (need %zu)\n", n_in, n_in > 0 ? in_sizes[0] : -1, out_size, ws_size, (size_t)WS_END); grid = -1; return; }
        int dev = 0, cus = 0, per_cu = 0;
        if (hipGetDevice(&dev) != hipSuccess || hipDeviceGetAttribute(&cus, hipDeviceAttributeMultiprocessorCount, dev) != hipSuccess) { fprintf(stderr, "kernel_launch: device query failed\n"); grid = -1; return; }
        if (hipFuncSetAttribute((const void*)mk_fwd, hipFuncAttributeMaxDynamicSharedMemorySize, LDS_BYTES) != hipSuccess) { fprintf(stderr, "kernel_launch: hipFuncSetAttribute failed\n"); grid = -1; return; }
        if (hipOccupancyMaxActiveBlocksPerMultiprocessor(&per_cu, (const void*)mk_fwd, NWAVES * 64, LDS_BYTES) != hipSuccess || per_cu < 1) { fprintf(stderr, "kernel_launch: occupancy query reports %d workgroups per CU; nothing launched\n", per_cu); (void)hipGetLastError(); grid = -1; return; }
        if (cus < 256) { fprintf(stderr, "kernel_launch: this kernel needs 256 CUs (found %d); nothing launched\n", cus); grid = -1; return; }
        grid = 256;
    }
    if (grid < 0) return;
    (void)hipMemsetAsync((char*)d_ws + WS_CTL, 0, CTL_ZERO_BYTES, stream);
    Args a{};
    for (int i = 0; i < 30; ++i) a.in[i] = (const float*)d_in[i];
    a.out = (float*)d_out; a.ws = (unsigned char*)d_ws;
#ifdef PROBE_RANGES
    static const int ranges[][2] = PROBE_RANGES;
    for (unsigned i = 0; i < sizeof(ranges) / sizeof(ranges[0]); ++i) { if (i) (void)hipMemsetAsync((char*)d_ws + WS_CTL, 0, CTL_ZERO_BYTES, stream);
        a.ph_lo = ranges[i][0]; a.ph_hi = ranges[i][1]; hipLaunchKernelGGL(mk_fwd, dim3(grid), dim3(NWAVES * 64), LDS_BYTES, stream, a); }
#else
    a.ph_lo = 0; a.ph_hi = N_PHASES;
    hipLaunchKernelGGL(mk_fwd, dim3(grid), dim3(NWAVES * 64), LDS_BYTES, stream, a);
#endif
}
```
